# Optimizing an MI355X kernel written in HIP

```python
import math
import jax, jax.numpy as jnp
from jax import lax
import numpy as np

D_MODEL = 1024
BATCH = 32
SEQ = 2048
DEPTH = 2

GRID_W = 64
CTX_LEN = 256
EPS = 1e-6
N_BRANCH = 3
D_CONV_MIX = D_MODEL
SSD_D_INNER = D_MODEL
SSD_HEADDIM = 64
SSD_HEADS = SSD_D_INNER // SSD_HEADDIM
SSD_GROUPS = 2
SSD_STATE = 128
SSD_CHUNK = 128
XBC_DIM = SSD_D_INNER + 2 * SSD_GROUPS * SSD_STATE
NA_HEADS = 16
NA_HEAD_DIM = 64
NA_WIDTH = NA_HEADS * NA_HEAD_DIM
NA_KH = 8
NA_KW = 16
ROPE_BASE = 10000.0
D_FF = 4 * D_MODEL
IN_SPLITS = (D_CONV_MIX, D_CONV_MIX, D_CONV_MIX, SSD_D_INNER, XBC_DIM, 2 * SSD_HEADS, NA_WIDTH, NA_WIDTH, NA_WIDTH, N_BRANCH * D_MODEL)
IN_COLS = sum(IN_SPLITS)
IN_NAMES = ('conv_b', 'conv_c', 'conv_x', 'ssd_z', 'ssd_xbc', 'ssd_dt', 'na_q', 'na_k', 'na_v', 'gate')

kernel_name = 'hybrid_dit_conv_ssd_na_block'


def rmsnorm(x, w):
    xf = x.astype(jnp.float32)
    y = xf * lax.rsqrt(jnp.mean(xf * xf, axis=-1, keepdims=True) + EPS)
    return (y * w.astype(jnp.float32)).astype(x.dtype)


def modulate(x, shift, scale):
    return x * (1 + scale) + shift


def split_in(u):
    offs = [int(o) for o in np.cumsum(IN_SPLITS)[:-1]]
    return dict(zip(IN_NAMES, jnp.split(u, offs, axis=-1)))


def heads(t, n):
    return t.reshape(t.shape[0], t.shape[1], n, -1)


def dwconv3(x, w, b=None):
    xp = jnp.pad(x, ((0, 0), (1, 1), (0, 0)))
    y = xp[:, :-2] * w[0] + xp[:, 1:-1] * w[1] + xp[:, 2:] * w[2]
    return y if b is None else y + b


def _rev(t, d):
    return jnp.flip(t, axis=1) if d else t


def ssd_scan(X, a, Bm, Cm, h0, with_output):
    b, L, G, R, P = X.shape
    N = Bm.shape[-1]
    Q = SSD_CHUNK
    nc = L // Q
    X = X.reshape(b, nc, Q, G, R, P)
    Bm = Bm.reshape(b, nc, Q, G, N)
    Cm = Cm.reshape(b, nc, Q, G, N)
    a_cs = jnp.cumsum(a.astype(jnp.float32).reshape(b, nc, Q, G, R), axis=2)
    decay_states = jnp.exp(a_cs[:, :, -1:] - a_cs)
    states = jnp.einsum('bclgn,bclgrp->bcgrpn', Bm, X * decay_states[..., None])
    chunk_decay = jnp.exp(a_cs[:, :, -1])

    def step(h, inp):
        s_c, d_c = inp
        return h * d_c[..., None, None] + s_c, h

    h_final, h_before = lax.scan(step, h0.astype(jnp.float32), (jnp.swapaxes(states, 0, 1), jnp.swapaxes(chunk_decay, 0, 1)))
    if not with_output:
        return None, h_final
    h_before = jnp.swapaxes(h_before, 0, 1)
    seg = a_cs[:, :, :, None] - a_cs[:, :, None]
    tri = jnp.tril(jnp.ones((Q, Q), dtype=bool))[None, None, :, :, None, None]
    Lmat = jnp.exp(jnp.where(tri, seg, -jnp.inf))
    scores = jnp.einsum('bclgn,bcsgn->bclsg', Cm, Bm)
    y_diag = jnp.einsum('bclsgr,bcsgrp->bclgrp', scores[..., None] * Lmat, X)
    y_off = jnp.einsum('bclgn,bcgrpn->bclgrp', Cm, h_before) * jnp.exp(a_cs)[..., None]
    return (y_diag + y_off).reshape(b, L, G, R, P), h_final


def ssd_mix(xbc, z, dt_raw, conv_w, conv_b, a_log, dt_bias, d_skip, norm_w, h0, with_output):
    b, L, _ = xbc.shape
    G, R, P, N = SSD_GROUPS, SSD_HEADS // SSD_GROUPS, SSD_HEADDIM, SSD_STATE
    xbc = jax.nn.silu(dwconv3(xbc, conv_w, conv_b))
    xs, Bm, Cm = jnp.split(xbc, [SSD_D_INNER, SSD_D_INNER + G * N], axis=-1)
    xs = xs.reshape(b, L, G, R, P)
    Bm = Bm.reshape(b, L, G, N)
    Cm = Cm.reshape(b, L, G, N)
    dt = jax.nn.softplus(dt_raw.astype(jnp.float32).reshape(b, L, 2, G, R) + dt_bias.astype(jnp.float32).reshape(2, G, R))
    A = -jnp.exp(a_log.astype(jnp.float32)).reshape(2, G, R)
    ys, hs = [], []
    for d in range(2):
        dt_d = dt[:, :, d]
        y_d, h_d = ssd_scan(_rev(xs * dt_d[..., None], d), _rev(dt_d * A[d], d), _rev(Bm, d), _rev(Cm, d), h0[d], with_output)
        hs.append(h_d)
        if with_output:
            ys.append(_rev(y_d, d).astype(xs.dtype) + xs * d_skip[d].reshape(G, R)[:, :, None])
    if not with_output:
        return None, (hs[0], hs[1])
    y = (ys[0] + ys[1]).reshape(b, L, SSD_D_INNER) * jax.nn.silu(z)
    y = rmsnorm(y.reshape(b, L, G, -1), norm_w.reshape(G, -1)).reshape(b, L, SSD_D_INNER)
    return y, (hs[0], hs[1])


def axial_rope(L, dtype):
    t = jnp.arange(L, dtype=jnp.int32)
    row = (t // GRID_W).astype(jnp.float32)
    col = (t % GRID_W).astype(jnp.float32)
    half = NA_HEAD_DIM // 2
    inv = ROPE_BASE ** (-jnp.arange(0, half, 2, dtype=jnp.float32) / half)
    ang_r = row[:, None] * inv
    ang_c = col[:, None] * inv
    ang = jnp.concatenate([ang_r, ang_r, ang_c, ang_c], axis=-1)
    return jnp.cos(ang).astype(dtype), jnp.sin(ang).astype(dtype)


def apply_rope(x, cos, sin):
    def rot_half(u):
        u1, u2 = jnp.split(u, 2, axis=-1)
        return jnp.concatenate([-u2, u1], axis=-1)
    xr, xc = jnp.split(x, 2, axis=-1)
    rot = jnp.concatenate([rot_half(xr), rot_half(xc)], axis=-1)
    return x * cos[:, None, :] + rot * sin[:, None, :]


def na_attend(q, k, v, k_ctx, v_ctx, rpb):
    b, L, H, Dh = q.shape
    rows = L // GRID_W
    kh = min(NA_KH, rows)
    band = kh * GRID_W
    col = jnp.arange(GRID_W, dtype=jnp.int32)
    col_start = jnp.clip(col - NA_KW // 2, 0, GRID_W - NA_KW)
    col_ok = (col[None, :] >= col_start[:, None]) & (col[None, :] < col_start[:, None] + NA_KW)
    mask = jnp.broadcast_to(col_ok[:, None, :], (GRID_W, kh, GRID_W)).reshape(GRID_W, band)
    dc_idx = jnp.clip(col[None, :] - col[:, None], -(NA_KW - 1), NA_KW - 1) + NA_KW - 1
    q = q * (Dh ** -0.5)

    def one_row(r):
        r0 = jnp.clip(r - kh // 2, 0, rows - kh)
        qr = lax.dynamic_slice_in_dim(q, r * GRID_W, GRID_W, axis=1)
        kr = lax.dynamic_slice_in_dim(k, r0 * GRID_W, band, axis=1)
        vr = lax.dynamic_slice_in_dim(v, r0 * GRID_W, band, axis=1)
        dr_idx = r0 + jnp.arange(kh, dtype=jnp.int32) - r + NA_KH - 1
        bias = rpb[:, dr_idx[None, :, None], dc_idx[:, None, :]].reshape(H, GRID_W, band)
        s_lat = jnp.einsum('bqhd,bkhd->bhqk', qr, kr).astype(jnp.float32) + bias.astype(jnp.float32)[None]
        s_lat = jnp.where(mask[None, None], s_lat, -jnp.inf)
        s_ctx = jnp.einsum('bqhd,bkhd->bhqk', qr, k_ctx).astype(jnp.float32)
        p = jax.nn.softmax(jnp.concatenate([s_lat, s_ctx], axis=-1), axis=-1).astype(v.dtype)
        return jnp.einsum('bhqk,bkhd->bqhd', p[..., :band], vr) + jnp.einsum('bhqk,bkhd->bqhd', p[..., band:], v_ctx)

    out = lax.map(one_row, jnp.arange(rows, dtype=jnp.int32))
    return jnp.transpose(out, (1, 0, 2, 3, 4)).reshape(b, L, H * Dh)


def ctx_attend(q, k, v):
    b, L, H, Dh = q.shape
    s = jnp.einsum('bqhd,bkhd->bhqk', q * (Dh ** -0.5), k).astype(jnp.float32)
    p = jax.nn.softmax(s, axis=-1).astype(v.dtype)
    return jnp.einsum('bhqk,bkhd->bqhd', p, v).reshape(b, L, H * Dh)


def merge_branches(y_conv, y_ssd, y_na, gate_logits, w_br_conv, w_br_ssd, w_br_na, w_out):
    g_conv, g_ssd, g_na = jnp.split(jax.nn.sigmoid(gate_logits), N_BRANCH, axis=-1)
    merged = g_conv * (y_conv @ w_br_conv) + g_ssd * (y_ssd @ w_br_ssd) + g_na * (y_na @ w_br_na)
    return merged @ w_out


def sqrelu_mlp(x, w1, w2):
    return jnp.square(jax.nn.relu(x @ w1)) @ w2


def setup_inputs(seed: int = 0) -> dict:
    key = jax.random.key(seed)
    ks = iter(jax.random.split(key, 32))

    def nrm(shape, s):
        return jax.random.normal(next(ks), shape, jnp.float32) * s

    def gain(shape):
        return 1.0 + nrm(shape, 0.01)

    dt0 = jnp.exp(jax.random.uniform(next(ks), (DEPTH, 2, SSD_HEADS), jnp.float32) * (math.log(0.1) - math.log(0.001)) + math.log(0.001))
    return {
        'x': nrm((BATCH, SEQ, D_MODEL), 1.0),
        'c': nrm((BATCH, D_MODEL), 1.0),
        'ctx': nrm((BATCH, CTX_LEN, D_MODEL), 1.0),
        'c_ctx': nrm((D_MODEL,), 1.0),
        'w_ada': nrm((DEPTH, D_MODEL, 6 * D_MODEL), 0.5 * D_MODEL ** -0.5),
        'b_ada': nrm((DEPTH, 6 * D_MODEL), 0.01),
        'norm1_w': gain((DEPTH, D_MODEL)),
        'w_in': nrm((DEPTH, D_MODEL, IN_COLS), D_MODEL ** -0.5),
        'conv_mix_w': nrm((DEPTH, 3, D_CONV_MIX), 3 ** -0.5),
        'ssd_conv_w': nrm((DEPTH, 3, XBC_DIM), 3 ** -0.5),
        'ssd_conv_b': nrm((DEPTH, XBC_DIM), 0.01),
        'ssd_a_log': jnp.log(jax.random.uniform(next(ks), (DEPTH, 2, SSD_HEADS), jnp.float32, 1.0, 16.0)),
        'ssd_dt_bias': dt0 + jnp.log(-jnp.expm1(-dt0)),
        'ssd_d': gain((DEPTH, 2, SSD_HEADS)),
        'ssd_norm_w': gain((DEPTH, SSD_D_INNER)),
        'na_rpb': nrm((DEPTH, NA_HEADS, 2 * NA_KH - 1, 2 * NA_KW - 1), 0.02),
        'w_br_conv': nrm((DEPTH, D_CONV_MIX, D_MODEL), D_CONV_MIX ** -0.5),
        'w_br_ssd': nrm((DEPTH, SSD_D_INNER, D_MODEL), SSD_D_INNER ** -0.5),
        'w_br_na': nrm((DEPTH, NA_WIDTH, D_MODEL), NA_WIDTH ** -0.5),
        'w_out': nrm((DEPTH, D_MODEL, D_MODEL), D_MODEL ** -0.5),
        'norm2_w': gain((DEPTH, D_MODEL)),
        'w_ff1': nrm((DEPTH, D_MODEL, D_FF), D_MODEL ** -0.5),
        'w_ff2': nrm((DEPTH, D_FF, D_MODEL), D_FF ** -0.5),
        'final_norm_w': gain((D_MODEL,)),
    }


def reference(x, c, ctx, c_ctx, w_ada, b_ada, norm1_w, w_in, conv_mix_w, ssd_conv_w, ssd_conv_b, ssd_a_log, ssd_dt_bias, ssd_d, ssd_norm_w, na_rpb, w_br_conv, w_br_ssd, w_br_na, w_out, norm2_w, w_ff1, w_ff2, final_norm_w):
    b, L, _ = x.shape
    h, hc = x, ctx
    silu_c, silu_cc = jax.nn.silu(c), jax.nn.silu(c_ctx)
    cos, sin = axial_rope(L, x.dtype)
    G, R, P, N = SSD_GROUPS, SSD_HEADS // SSD_GROUPS, SSD_HEADDIM, SSD_STATE
    zero_state = jnp.zeros((b, G, R, P, N), jnp.float32)
    for l in range(DEPTH):
        last = l == DEPTH - 1
        mod = (silu_c @ w_ada[l] + b_ada[l])[:, None, :]
        mod_c = (silu_cc @ w_ada[l] + b_ada[l])[None, None, :]
        sh1, sc1, gt1, sh2, sc2, gt2 = jnp.split(mod, 6, axis=-1)
        csh1, csc1, cgt1, csh2, csc2, cgt2 = jnp.split(mod_c, 6, axis=-1)
        pl = split_in(modulate(rmsnorm(h, norm1_w[l]), sh1, sc1) @ w_in[l])
        pc = split_in(modulate(rmsnorm(hc, norm1_w[l]), csh1, csc1) @ w_in[l])
        ssd_p = (ssd_conv_w[l], ssd_conv_b[l], ssd_a_log[l], ssd_dt_bias[l], ssd_d[l], ssd_norm_w[l])
        y_ssd_c, ctx_states = ssd_mix(pc['ssd_xbc'], pc['ssd_z'], pc['ssd_dt'], *ssd_p, (zero_state, zero_state), not last)
        y_ssd, _ = ssd_mix(pl['ssd_xbc'], pl['ssd_z'], pl['ssd_dt'], *ssd_p, ctx_states, True)
        k_c, v_c = heads(pc['na_k'], NA_HEADS), heads(pc['na_v'], NA_HEADS)
        q_l = apply_rope(heads(pl['na_q'], NA_HEADS), cos, sin)
        k_l = apply_rope(heads(pl['na_k'], NA_HEADS), cos, sin)
        y_na = na_attend(q_l, k_l, heads(pl['na_v'], NA_HEADS), k_c, v_c, na_rpb[l])
        y_conv = pl['conv_b'] * dwconv3(pl['conv_c'] * pl['conv_x'], conv_mix_w[l])
        h = h + gt1 * merge_branches(y_conv, y_ssd, y_na, pl['gate'], w_br_conv[l], w_br_ssd[l], w_br_na[l], w_out[l])
        h = h + gt2 * sqrelu_mlp(modulate(rmsnorm(h, norm2_w[l]), sh2, sc2), w_ff1[l], w_ff2[l])
        if not last:
            y_conv_c = pc['conv_b'] * dwconv3(pc['conv_c'] * pc['conv_x'], conv_mix_w[l])
            y_na_c = ctx_attend(heads(pc['na_q'], NA_HEADS), k_c, v_c)
            hc = hc + cgt1 * merge_branches(y_conv_c, y_ssd_c, y_na_c, pc['gate'], w_br_conv[l], w_br_ssd[l], w_br_na[l], w_out[l])
            hc = hc + cgt2 * sqrelu_mlp(modulate(rmsnorm(hc, norm2_w[l]), csh2, csc2), w_ff1[l], w_ff2[l])
    return rmsnorm(h, final_norm_w)
```

```cpp
#include <hip/hip_runtime.h>
#include <hip/hip_cooperative_groups.h>
#include <cstdio>
namespace cg = cooperative_groups;
#ifndef PROBE_DUP
#define PROBE_DUP 0
#endif
#define DUP(n, ...) do { _Pragma("nounroll") for (int rep_ = 0; rep_ < ((PROBE_DUP == (n)) ? 2 : 1); ++rep_) { __VA_ARGS__ } } while (0)

#define LAS __attribute__((address_space(3)))
typedef unsigned short bf16_t;
typedef short bf16x8 __attribute__((ext_vector_type(8)));
typedef float f32x4 __attribute__((ext_vector_type(4)));
typedef unsigned u32x4_t __attribute__((ext_vector_type(4)));

constexpr int D = 1024, NB = 32, L = 2048, CTX = 256;
constexpr int GB = 8, NG = NB / GB, ML = GB * L, MC = GB * CTX, M = ML + MC;
constexpr int UC = 12032, IN_COLS = 11808;
constexpr int cCB = 0, cCC = 1024, cCX = 2048, cZ = 3072, cXBC = 4096, cQ = 5632, cK = 6656, cV = 7680, cGATE = 8704, cDT = 11776;
constexpr int XW = 1536, NCTX = NB * CTX;
constexpr float EPS = 1e-6f;

constexpr size_t SZ_WIN = (size_t)UC * D * 2, SZ_WBR = (size_t)3 * D * D * 2, SZ_WOUT = (size_t)D * D * 2, SZ_WFF = (size_t)4 * D * D * 2;
constexpr size_t O_WIN = 0;
constexpr size_t O_WBR = O_WIN + 2 * SZ_WIN;
constexpr size_t O_WOUT = O_WBR + 2 * SZ_WBR;
constexpr size_t O_WFF1 = O_WOUT + 2 * SZ_WOUT;
constexpr size_t O_WFF2 = O_WFF1 + 2 * SZ_WFF;
constexpr size_t O_HC = O_WFF2 + 2 * SZ_WFF;
constexpr size_t O_MOD = O_HC + (size_t)NB * CTX * D * 4;
constexpr size_t O_ROPE = O_MOD + (size_t)2 * 33 * 6144 * 4 + 256 * 3;
constexpr size_t O_AN = O_ROPE + (size_t)2048 * 64 * 4;
constexpr size_t O_U = O_AN + (size_t)M * D * 2;
constexpr size_t O_XBCS = O_U + (size_t)M * UC * 2;
constexpr size_t O_DTS = O_XBCS + (size_t)M * XW * 2;
constexpr size_t O_DECS = O_DTS + (size_t)M * 32 * 4;
constexpr size_t O_YDIR = O_DECS + (size_t)M * 32 * 4;
constexpr size_t O_YBR = O_YDIR + (size_t)2 * M * D * 2;
constexpr size_t O_MRGB = O_YBR + (size_t)3 * M * D * 2;
constexpr size_t O_VT = O_MRGB + (size_t)M * D * 2;
constexpr size_t O_BAR = O_VT + (size_t)GB * 1024 * 2304 * 2;
constexpr size_t O_YBRC = O_BAR + 16384;
constexpr size_t O_GATEC = O_YBRC + (size_t)3 * NB * CTX * D * 2;
constexpr size_t WS_END = O_GATEC + (size_t)NB * CTX * 3072 * 2;
static_assert(WS_END <= ((size_t)1 << 30), "workspace map exceeds 1 GiB");

struct Params {
    const float *x, *c, *ctx, *c_ctx, *w_ada, *b_ada, *norm1_w, *w_in, *conv_mix_w, *ssd_conv_w, *ssd_conv_b, *ssd_a_log, *ssd_dt_bias, *ssd_d, *ssd_norm_w,
        *na_rpb, *w_br_conv, *w_br_ssd, *w_br_na, *w_out, *norm2_w, *w_ff1, *w_ff2, *final_norm_w;
    float* out; unsigned char* ws;
};

typedef const __attribute__((address_space(4))) Params* CP;
__device__ __forceinline__ CP params_ptr() { unsigned long long k = (unsigned long long)__builtin_amdgcn_kernarg_segment_ptr(); asm volatile("" : "+s"(k)); return (CP)k; }
__device__ __forceinline__ int fresh_tid() { int t = threadIdx.x; asm volatile("" : "+v"(t)); return t; }
__device__ __forceinline__ float bflo(unsigned u) { return __uint_as_float(u << 16); }
__device__ __forceinline__ float bfhi(unsigned u) { return __uint_as_float(u & 0xffff0000u); }
__device__ __forceinline__ unsigned f2bf(float f) { unsigned u = __float_as_uint(f); u += 0x7FFFu + ((u >> 16) & 1u); return u >> 16; }
__device__ __forceinline__ unsigned pack2(float lo, float hi) { unsigned r; asm volatile("v_cvt_pk_bf16_f32 %0, %1, %2" : "=v"(r) : "v"(lo), "v"(hi)); return r; }
__device__ __forceinline__ void unpack8(const uint4 v, float (&f)[8]) { f[0] = bflo(v.x); f[1] = bfhi(v.x); f[2] = bflo(v.y); f[3] = bfhi(v.y); f[4] = bflo(v.z); f[5] = bfhi(v.z); f[6] = bflo(v.w); f[7] = bfhi(v.w); }
__device__ __forceinline__ uint4 pack8(const float (&f)[8]) { uint4 v; v.x = pack2(f[0], f[1]); v.y = pack2(f[2], f[3]); v.z = pack2(f[4], f[5]); v.w = pack2(f[6], f[7]); return v; }
__device__ __forceinline__ float silu_f(float v) { return v * __builtin_amdgcn_rcpf(1.f + __expf(-v)); }
__device__ __forceinline__ float sigmoid_f(float v) { return __builtin_amdgcn_rcpf(1.f + __expf(-v)); }
__device__ __forceinline__ float wave_sum(float v) { for (int o = 32; o; o >>= 1) v += __shfl_xor(v, o); return v; }

namespace pg8 {
constexpr int BM = 256, BK = 64, HALF = 128, HTB = HALF * BK * 2, STAGE_BYTES = 8 * HTB, NXCD = 8, WGM = 8;
__device__ __forceinline__ int lds_byte(int r, int c) { const int st = (r >> 4) * 2 + (c >> 5), rr = r & 15, cc = c & 31, ob = rr * 64 + cc * 2; return st * 1024 + (ob ^ (((ob >> 9) & 1) << 5)); }
__device__ __forceinline__ void stage_rc(int b, int& R, int& C) { const int st = b / 1024, sb = b % 1024, swz = sb ^ (((sb >> 9) & 1) << 5); R = (st >> 1) * 16 + swz / 64; C = (st & 1) * 32 + (swz % 64) / 2; }
__device__ __forceinline__ int perm32(int rho) { const int n = rho >> 4, i = rho & 15; return 8 * (i >> 2) + 4 * n + (i & 3); }
struct Unit { int pm, pn, z; };
struct Gemm { const bf16_t* A; const bf16_t* Bt; int M, N, K; size_t azs, bzs; };
struct StaticOrder {
    int nM, nN, nwg, G, c, nz;
    __device__ void init(int M_, int N_, int G_, int c_, int nz_) { nM = M_ / BM; nN = N_ / BM; nwg = nM * nN; G = G_; c = c_; nz = nz_; }
    __device__ bool next(int i, Unit& u) const {
        const int ti = i / nz; u.z = i - ti * nz;
        const long Lx = (long)ti * G + c; if (Lx >= nwg) return false;
        int wgid = (int)Lx; { const int q = nwg / NXCD, r = nwg % NXCD, xcd = wgid % NXCD, off = wgid / NXCD; wgid = (xcd < r ? xcd * (q + 1) : r * (q + 1) + (xcd - r) * q) + off; }
        const int nig = WGM * nN, gid = wgid / nig, fm = gid * WGM, gsz = (nM - fm) < WGM ? (nM - fm) : WGM;
        u.pm = fm + ((wgid % nig) % gsz); u.pn = (wgid % nig) / gsz; return true;
    }
};
template <class Epi>
__device__ __forceinline__ void gemm_phase(LAS unsigned char* lds, const Gemm g, const StaticOrder& S, const Epi& E) {
    const int tid = fresh_tid(), wid = __builtin_amdgcn_readfirstlane(tid >> 6), lane = tid & 63, wr = wid >> 2, wc = wid & 3, fr = lane & 15, fq = lane >> 4;
    const int K = g.K, nt = K / BK;
    unsigned voffA[2], voffB[2];
#pragma unroll
    for (int i = 0; i < 2; ++i) { int R, C; stage_rc(tid * 16 + i * 8192, R, C); const int Rb = Epi::PERM ? ((R & ~31) + perm32(R & 31)) : R;
        voffA[i] = (unsigned)(R * K + C) * 2u; voffB[i] = (unsigned)(Rb * K + C) * 2u; }
    const size_t kstep = (size_t)(BK * 2);
    const size_t hstep = (size_t)HALF * K * 2;
    const size_t tstep = 2 * hstep;
    const unsigned ldsw = (unsigned)wid * 1024u;
    const int aoff = lds_byte(wr * 64 + fr, fq * 8), boff = lds_byte(wc * 32 + fr, fq * 8);
#define PG8_SA(b, h) (((b) * 2 + (h)) * HTB)
#define PG8_SB(b, h) ((4 + (b) * 2 + (h)) * HTB)
#define PG8_STAGE(bufoff, gbase, voff) do { _Pragma("unroll") for (int _i = 0; _i < 2; ++_i) \
        __builtin_amdgcn_global_load_lds((const unsigned*)((const char*)(gbase) + (voff)[_i]), (LAS unsigned*)(lds + (bufoff) + ldsw + _i * 8192), 16, 0, 0); } while (0)
#define PG8_LDA(dst, b, h) do { _Pragma("unroll") for (int m = 0; m < 4; ++m) _Pragma("unroll") for (int k = 0; k < 2; ++k) dst[m][k] = *(const LAS bf16x8*)(lds + PG8_SA(b, h) + aoff + m * 2048 + k * 1024); } while (0)
#define PG8_LDB(dst, b, h) do { _Pragma("unroll") for (int n = 0; n < 2; ++n) _Pragma("unroll") for (int k = 0; k < 2; ++k) dst[n][k] = *(const LAS bf16x8*)(lds + PG8_SB(b, h) + boff + n * 2048 + k * 1024); } while (0)
#define PG8_MMA(ai, bj, At, Bt) do { __builtin_amdgcn_s_setprio(1); _Pragma("unroll") for (int m = 0; m < 4; ++m) _Pragma("unroll") for (int n = 0; n < 2; ++n) _Pragma("unroll") for (int k = 0; k < 2; ++k) \
        acc[ai][bj][m][n] = __builtin_amdgcn_mfma_f32_16x16x32_bf16(Bt[n][k], At[m][k], acc[ai][bj][m][n], 0, 0, 0); __builtin_amdgcn_s_setprio(0); } while (0)
#define PG8_WAIT_V(n) asm volatile("s_waitcnt vmcnt(" #n ")" ::: "memory")
#define PG8_WAIT_L(n) asm volatile("s_waitcnt lgkmcnt(" #n ")" ::: "memory")
#define PG8_BAR __builtin_amdgcn_s_barrier()
#define PG8_SCHED __builtin_amdgcn_sched_barrier(0)
    Unit cur, nxt; int ui = 0;
    if (!S.next(0, cur)) return;
    f32x4 acc[2][2][4][2];
#pragma unroll
    for (int a = 0; a < 2; ++a)
#pragma unroll
        for (int b = 0; b < 2; ++b)
#pragma unroll
            for (int m = 0; m < 4; ++m)
#pragma unroll
                for (int n = 0; n < 2; ++n) acc[a][b][m][n] = (f32x4){0.f, 0.f, 0.f, 0.f};
    bf16x8 At[4][2], B0[2][2], B1[2][2];
    const char* cA = (const char*)g.A + (size_t)cur.z * g.azs + (size_t)cur.pm * tstep; const char* cB = (const char*)g.Bt + (size_t)cur.z * g.bzs + (size_t)cur.pn * tstep;
    PG8_STAGE(PG8_SB(0, 0), cB, voffB); PG8_STAGE(PG8_SA(0, 0), cA, voffA); PG8_STAGE(PG8_SB(0, 1), cB + hstep, voffB); PG8_STAGE(PG8_SA(0, 1), cA + hstep, voffA);
    if (wr == 1) PG8_BAR;
    PG8_WAIT_V(4); PG8_BAR;
    PG8_STAGE(PG8_SB(1, 0), cB + kstep, voffB); PG8_STAGE(PG8_SA(1, 0), cA + kstep, voffA); PG8_STAGE(PG8_SB(1, 1), cB + hstep + kstep, voffB);
    PG8_WAIT_V(6); PG8_BAR;
    for (;;) {
        const bool has_next = S.next(ui + 1, nxt);
        const char* nA = has_next ? (const char*)g.A + (size_t)nxt.z * g.azs + (size_t)nxt.pm * tstep : cA; const char* nB = has_next ? (const char*)g.Bt + (size_t)nxt.z * g.bzs + (size_t)nxt.pn * tstep : cB;
        for (int t = 0; t < nt; t += 2) {
            const bool last = (t == nt - 2);
            const char* a1 = cA + (size_t)(t + 1) * kstep;
            const char* a2 = last ? nA : cA + (size_t)(t + 2) * kstep; const char* b2 = last ? nB : cB + (size_t)(t + 2) * kstep;
            const char* a3 = a2 + kstep; const char* b3 = b2 + kstep;
            PG8_LDB(B0, 0, 0); PG8_SCHED; PG8_LDA(At, 0, 0); PG8_STAGE(PG8_SA(1, 1), a1 + hstep, voffA);
            PG8_WAIT_L(8); PG8_BAR; PG8_WAIT_L(0); PG8_MMA(0, 0, At, B0); PG8_BAR; PG8_SCHED;
            PG8_LDB(B1, 0, 1); PG8_STAGE(PG8_SB(0, 0), b2, voffB);
            PG8_BAR; PG8_WAIT_L(0); PG8_MMA(0, 1, At, B1); PG8_BAR;
            PG8_LDA(At, 0, 1); PG8_STAGE(PG8_SA(0, 0), a2, voffA);
            PG8_BAR; PG8_WAIT_L(0); PG8_MMA(1, 0, At, B0); PG8_BAR; PG8_SCHED;
            PG8_STAGE(PG8_SB(0, 1), b2 + hstep, voffB);
            PG8_WAIT_V(6); PG8_BAR; PG8_MMA(1, 1, At, B1); PG8_BAR;
            PG8_LDB(B0, 1, 0); PG8_SCHED; PG8_LDA(At, 1, 0); PG8_STAGE(PG8_SA(0, 1), a2 + hstep, voffA);
            PG8_WAIT_L(8); PG8_BAR; PG8_WAIT_L(0); PG8_MMA(0, 0, At, B0); PG8_BAR; PG8_SCHED;
            PG8_LDB(B1, 1, 1); PG8_STAGE(PG8_SB(1, 0), b3, voffB);
            PG8_BAR; PG8_WAIT_L(0); PG8_MMA(0, 1, At, B1); PG8_BAR;
            PG8_LDA(At, 1, 1); PG8_STAGE(PG8_SA(1, 0), a3, voffA);
            PG8_BAR; PG8_WAIT_L(0); PG8_MMA(1, 0, At, B0); PG8_BAR; PG8_SCHED;
            PG8_STAGE(PG8_SB(1, 1), b3 + hstep, voffB);
            PG8_WAIT_V(6); PG8_BAR; PG8_MMA(1, 1, At, B1); PG8_BAR;
        }
        E(acc, cur, wr, wc, fr, fq);
        if (!has_next) break;
        if (!E.keep(cur))
#pragma unroll
        for (int a = 0; a < 2; ++a)
#pragma unroll
            for (int b = 0; b < 2; ++b)
#pragma unroll
                for (int m = 0; m < 4; ++m)
#pragma unroll
                    for (int n = 0; n < 2; ++n) acc[a][b][m][n] = (f32x4){0.f, 0.f, 0.f, 0.f};
        cur = nxt; cA = nA; cB = nB; ++ui;
    }
    PG8_WAIT_V(0);
    if (wr == 0) PG8_BAR;
    PG8_BAR;
#undef PG8_SA
#undef PG8_SB
#undef PG8_STAGE
#undef PG8_LDA
#undef PG8_LDB
#undef PG8_MMA
#undef PG8_WAIT_V
#undef PG8_WAIT_L
#undef PG8_BAR
#undef PG8_SCHED
}
}
using pg8::Unit;

struct EpiU {
    static constexpr bool PERM = true;
    __device__ __forceinline__ bool keep(const Unit&) const { return false; }
    bf16_t* U;
    __device__ __forceinline__ void operator()(f32x4 (&acc)[2][2][4][2], const Unit& u, int wr, int wc, int fr, int fq) const {
        const int row0 = u.pm * 256 + wr * 64 + fr, col0 = u.pn * 256 + wc * 32 + 8 * fq;
        const bool sg = (u.pn >= cGATE / 256) && (u.pn < cDT / 256);
#pragma unroll
        for (int ai = 0; ai < 2; ++ai)
#pragma unroll
            for (int m = 0; m < 4; ++m) { bf16_t* rowp = U + (size_t)(row0 + ai * 128 + m * 16) * UC + col0;
#pragma unroll
                for (int bj = 0; bj < 2; ++bj) { f32x4 v0 = acc[ai][bj][m][0], v1 = acc[ai][bj][m][1];
                    if (sg) {
#pragma unroll
                        for (int j = 0; j < 4; ++j) { v0[j] = sigmoid_f(v0[j]); v1[j] = sigmoid_f(v1[j]); } }
                    uint4 o; o.x = pack2(v0[0], v0[1]); o.y = pack2(v0[2], v0[3]); o.z = pack2(v1[0], v1[1]); o.w = pack2(v1[2], v1[3]);
                    *(uint4*)(rowp + bj * 128) = o; } }
    }
};
struct EpiMerge {
    static constexpr bool PERM = true;
    const bf16_t* G; int gld; bf16_t* MB;
    __device__ __forceinline__ bool keep(const Unit& u) const { return u.z < 2; }
    __device__ __forceinline__ void operator()(f32x4 (&acc)[2][2][4][2], const Unit& u, int wr, int wc, int fr, int fq) const {
        const int row0 = u.pm * 256 + wr * 64 + fr, col0 = u.pn * 256 + wc * 32 + 8 * fq;
#pragma unroll
        for (int ai = 0; ai < 2; ++ai) {
            uint4 g0[4][2], g1[4][2];
#pragma unroll
            for (int m = 0; m < 4; ++m)
#pragma unroll
                for (int bj = 0; bj < 2; ++bj) { const bf16_t* gp = G + (size_t)(row0 + ai * 128 + m * 16) * gld + u.z * 1024 + col0 + bj * 128;
                    g0[m][bj] = *(const uint4*)gp; g1[m][bj] = (u.z < 2) ? *(const uint4*)(gp + 1024) : g0[m][bj]; }
#pragma unroll
            for (int m = 0; m < 4; ++m) { const size_t row = (size_t)(row0 + ai * 128 + m * 16);
#pragma unroll
                for (int bj = 0; bj < 2; ++bj) { const int col = col0 + bj * 128;
                    float gz[8]; unpack8(g0[m][bj], gz);
                    if (u.z < 2) { float gn[8]; unpack8(g1[m][bj], gn);
#pragma unroll
                        for (int j = 0; j < 8; ++j) { const float rt = fmaxf(gz[j], 1e-20f) * __builtin_amdgcn_rcpf(fmaxf(gn[j], 1e-20f)); acc[ai][bj][m][j >> 2][j & 3] *= rt; } }
                    else { f32x4 v0 = acc[ai][bj][m][0], v1 = acc[ai][bj][m][1];
#pragma unroll
                        for (int j = 0; j < 4; ++j) { v0[j] *= fmaxf(gz[j], 1e-20f); v1[j] *= fmaxf(gz[4 + j], 1e-20f); }
                        uint4 o; o.x = pack2(v0[0], v0[1]); o.y = pack2(v0[2], v0[3]); o.z = pack2(v1[0], v1[1]); o.w = pack2(v1[2], v1[3]); *(uint4*)(MB + row * D + col) = o; } } }
        }
    }
};
struct EpiRes {
    static constexpr bool PERM = false;
    __device__ __forceinline__ bool keep(const Unit&) const { return false; }
    float* hl; float* hc; const float* gate;
    int g; float gs; int allctx; long rdel;
    __device__ __forceinline__ void operator()(f32x4 (&acc)[2][2][4][2], const Unit& u, int wr, int wc, int fr, int fq) const {
        const int lr0 = u.pm * 256; const bool isctx = allctx || lr0 >= ML;
        float* base = allctx ? hc + (size_t)lr0 * D : (isctx ? hc + (size_t)(lr0 - ML) * D : hl + (size_t)lr0 * D);
        const float* rbase = base + rdel;
        const float* gp = gate + (size_t)(isctx ? 32 : g * GB + (lr0 >> 11)) * 6144;
        const int r0 = wr * 64 + fr, col0 = u.pn * 256 + wc * 32 + 4 * fq;
        f32x4 gv[2][2];
#pragma unroll
        for (int bj = 0; bj < 2; ++bj)
#pragma unroll
            for (int n = 0; n < 2; ++n) gv[bj][n] = *(const f32x4*)(gp + col0 + bj * 128 + n * 16) * gs;
#pragma unroll
        for (int ai = 0; ai < 2; ++ai) {
            f32x4 hv[4][2][2];
#pragma unroll
            for (int m = 0; m < 4; ++m)
#pragma unroll
                for (int bj = 0; bj < 2; ++bj)
#pragma unroll
                    for (int n = 0; n < 2; ++n) hv[m][bj][n] = *(const f32x4*)(rbase + (size_t)(r0 + ai * 128 + m * 16) * D + col0 + bj * 128 + n * 16);
#pragma unroll
            for (int m = 0; m < 4; ++m)
#pragma unroll
                for (int bj = 0; bj < 2; ++bj)
#pragma unroll
                    for (int n = 0; n < 2; ++n) *(f32x4*)(base + (size_t)(r0 + ai * 128 + m * 16) * D + col0 + bj * 128 + n * 16) = hv[m][bj][n] + gv[bj][n] * acc[ai][bj][m][n];
        }
    }
};
struct EpiFF1 {
    static constexpr bool PERM = true;
    __device__ __forceinline__ bool keep(const Unit&) const { return false; }
    bf16_t* H;
    __device__ __forceinline__ void operator()(f32x4 (&acc)[2][2][4][2], const Unit& u, int wr, int wc, int fr, int fq) const {
        const int row0 = u.pm * 256 + wr * 64 + fr, col0 = u.pn * 256 + wc * 32 + 8 * fq;
#pragma unroll
        for (int ai = 0; ai < 2; ++ai)
#pragma unroll
            for (int m = 0; m < 4; ++m) { bf16_t* rowp = H + (size_t)(row0 + ai * 128 + m * 16) * 4096 + col0;
#pragma unroll
                for (int bj = 0; bj < 2; ++bj) { f32x4 v0 = acc[ai][bj][m][0], v1 = acc[ai][bj][m][1];
#pragma unroll
                    for (int j = 0; j < 4; ++j) { const float a = fmaxf(v0[j], 0.f), b = fmaxf(v1[j], 0.f); v0[j] = a * a; v1[j] = b * b; }
                    uint4 o; o.x = pack2(v0[0], v0[1]); o.y = pack2(v0[2], v0[3]); o.z = pack2(v1[0], v1[1]); o.w = pack2(v1[2], v1[3]);
                    *(uint4*)(rowp + bj * 128) = o; } }
    }
};

__device__ __forceinline__ int w_in_src_col(int j) { return j < 5632 ? j : (j < 11776 ? j + 32 : (j < 11808 ? j - 11776 + 5632 : -1)); }

__device__ void transpose_weight(const float* __restrict__ W, int ld, int Kd, int Nout, bool mapped, bf16_t* __restrict__ Wt, float* lds) {
    const int tid = fresh_tid(); const int tn = Nout / 256, tk = Kd / 64;
    constexpr int P = 257;
    for (int t = blockIdx.x; t < tn * tk; t += gridDim.x) {
        const int n0 = (t % tn) * 256, k0 = (t / tn) * 64;
        __syncthreads();
#pragma unroll
        for (int i = 0; i < 8; ++i) { const int idx = i * 512 + tid, kk = idx >> 6, nn = (idx & 63) * 4; const int sc = mapped ? w_in_src_col(n0 + nn) : n0 + nn;
            const float4 v = sc >= 0 ? *(const float4*)(W + (size_t)(k0 + kk) * ld + sc) : make_float4(0.f, 0.f, 0.f, 0.f);
            float* d = lds + kk * P + nn; d[0] = v.x; d[1] = v.y; d[2] = v.z; d[3] = v.w; }
        __syncthreads();
#pragma unroll
        for (int i = 0; i < 4; ++i) { const int idx = i * 512 + tid, nn = idx >> 3, kp = (idx & 7) * 8;
            float f[8];
#pragma unroll
            for (int j = 0; j < 8; ++j) f[j] = lds[(kp + j) * P + nn];
            *(uint4*)(Wt + (size_t)(n0 + nn) * Kd + k0 + kp) = pack8(f); }
    }
}

__device__ void phase_prep(CP p, float* lds) {
    unsigned char* ws = p->ws; const int tid = fresh_tid();
    for (int l = 0; l < 2; ++l) {
        transpose_weight(p->w_in + (size_t)l * D * IN_COLS, IN_COLS, D, UC, true, (bf16_t*)(ws + O_WIN + l * SZ_WIN), lds);
        transpose_weight(p->w_br_conv + (size_t)l * D * D, D, D, D, false, (bf16_t*)(ws + O_WBR + l * SZ_WBR), lds);
        transpose_weight(p->w_br_ssd + (size_t)l * D * D, D, D, D, false, (bf16_t*)(ws + O_WBR + l * SZ_WBR) + (size_t)D * D, lds);
        transpose_weight(p->w_br_na + (size_t)l * D * D, D, D, D, false, (bf16_t*)(ws + O_WBR + l * SZ_WBR) + (size_t)2 * D * D, lds);
        transpose_weight(p->w_out + (size_t)l * D * D, D, D, D, false, (bf16_t*)(ws + O_WOUT + l * SZ_WOUT), lds);
        transpose_weight(p->w_ff1 + (size_t)l * D * 4096, 4096, D, 4096, false, (bf16_t*)(ws + O_WFF1 + l * SZ_WFF), lds);
        transpose_weight(p->w_ff2 + (size_t)l * 4096 * D, D, 4096, D, false, (bf16_t*)(ws + O_WFF2 + l * SZ_WFF), lds);
    }
    {
        float* tab = (float*)(ws + O_ROPE);
        for (int i = blockIdx.x * 512 + tid; i < 2048 * 32; i += gridDim.x * 512) {
            const int t = i >> 5, j = i & 31, ii = j & 15; const int pos = (j < 16) ? (t >> 6) : (t & 63);
            const float inv = powf(10000.0f, -(float)(2 * ii) / 32.0f); const float ang = (float)pos * inv;
            tab[t * 64 + j] = cosf(ang); tab[t * 64 + 32 + j] = sinf(ang);
        }
    }
    float* mod = (float*)(ws + O_MOD);
    for (int job = blockIdx.x; job < 2 * 96; job += gridDim.x) {
        const int l = job / 96, j0 = (job % 96) * 64;
        __syncthreads();
        for (int i = tid; i < 32 * 1024; i += 512) lds[i] = silu_f(p->c[i]);
        __syncthreads();
        const int col = tid & 63, kp = tid >> 6;
        float acc[33];
#pragma unroll
        for (int r = 0; r < 33; ++r) acc[r] = 0.f;
        const float* wp = p->w_ada + (size_t)l * D * 6144 + j0 + col;
        for (int k = kp * 128; k < kp * 128 + 128; ++k) {
            const float wv = wp[(size_t)k * 6144];
#pragma unroll
            for (int r = 0; r < 32; ++r) acc[r] += lds[r * 1024 + k] * wv;
            acc[32] += silu_f(p->c_ctx[k]) * wv;
        }
        __syncthreads();
#pragma unroll
        for (int r = 0; r < 33; ++r) lds[(kp * 33 + r) * 64 + col] = acc[r];
        __syncthreads();
        for (int i = tid; i < 33 * 64; i += 512) { const int r = i >> 6, cc = i & 63; float s = 0.f;
#pragma unroll
            for (int q = 0; q < 8; ++q) s += lds[(q * 33 + r) * 64 + cc];
            mod[((size_t)l * 33 + r) * 6144 + j0 + cc] = s + p->b_ada[l * 6144 + j0 + cc]; }
    }
}

__device__ void phase_norm(CP p, int g, int l, int which, int Mrows, bool ctxall) {
    unsigned char* ws = p->ws; const int tid_ = fresh_tid(); const int lane = tid_ & 63, gw = blockIdx.x * 8 + (tid_ >> 6), nw = gridDim.x * 8;
    const bool first = (l == 0 && which == 0);
    const float* nwt = (which ? p->norm2_w : p->norm1_w) + l * D;
    const float* mod = (const float*)(ws + O_MOD) + (size_t)l * 33 * 6144 + which * 3072;
    bf16_t* AN = (bf16_t*)(ws + O_AN);
    float4 wv[4];
#pragma unroll
    for (int j = 0; j < 4; ++j) wv[j] = *(const float4*)(nwt + j * 256 + lane * 4);
    auto src_of = [&](int lr) -> const float* {
        const bool isctx = ctxall || lr >= ML;
        const size_t grow = ctxall ? (size_t)lr : (isctx ? (size_t)g * MC + (lr - ML) : (size_t)g * ML + lr);
        return (first ? (isctx ? p->ctx : p->x) : (isctx ? (const float*)(ws + O_HC) : (const float*)p->out)) + grow * D;
    };
    float4 v[4], nx[4];
    if (gw < Mrows) { const float* src = src_of(gw);
#pragma unroll
        for (int j = 0; j < 4; ++j) v[j] = *(const float4*)(src + j * 256 + lane * 4); }
    for (int lr = gw; lr < Mrows; lr += nw) {
        if (lr + nw < Mrows) { const float* src = src_of(lr + nw);
#pragma unroll
            for (int j = 0; j < 4; ++j) nx[j] = *(const float4*)(src + j * 256 + lane * 4); }
        const bool isctx = ctxall || lr >= ML;
        const float* mr = mod + (size_t)(isctx ? 32 : g * GB + (lr >> 11)) * 6144;
        float ss = 0.f;
#pragma unroll
        for (int j = 0; j < 4; ++j) ss += v[j].x * v[j].x + v[j].y * v[j].y + v[j].z * v[j].z + v[j].w * v[j].w;
        ss = wave_sum(ss);
        const float rs = rsqrtf(ss * (1.f / 1024.f) + EPS);
#pragma unroll
        for (int j = 0; j < 4; ++j) {
            const int col = j * 256 + lane * 4;
            const float4 w = wv[j], sh = *(const float4*)(mr + col), sc = *(const float4*)(mr + 1024 + col);
            uint2 o; o.x = pack2(v[j].x * rs * w.x * (1.f + sc.x) + sh.x, v[j].y * rs * w.y * (1.f + sc.y) + sh.y);
            o.y = pack2(v[j].z * rs * w.z * (1.f + sc.z) + sh.z, v[j].w * rs * w.w * (1.f + sc.w) + sh.w);
            *(uint2*)(AN + (size_t)lr * D + col) = o;
        }
#pragma unroll
        for (int j = 0; j < 4; ++j) v[j] = nx[j];
    }
}

__device__ void phase_mixprep(CP p, int g, int l, bool last, bool do_qk) {
    unsigned char* ws = p->ws; const int tid_ = fresh_tid(); const int lane = tid_ & 63, gw = blockIdx.x * 8 + (tid_ >> 6), nw = gridDim.x * 8;
    bf16_t* U = (bf16_t*)(ws + O_U); bf16_t* XB = (bf16_t*)(ws + O_XBCS); float* DTS = (float*)(ws + O_DTS); float* DECS = (float*)(ws + O_DECS);
    bf16_t* YC = (bf16_t*)(ws + O_YBR); const float* tab = (const float*)(ws + O_ROPE);
    const float* cw = p->conv_mix_w + (size_t)l * 3 * D; const float* sw = p->ssd_conv_w + (size_t)l * 3 * XW; const float* sb = p->ssd_conv_b + (size_t)l * XW;
    const int RP = (M + nw - 1) / nw; const int lr0 = gw * RP, lr1 = min(lr0 + RP, M);
    {
        float wv[2][3][8], pcx[2][8], ccx[2][8], ncx[2][8];
#pragma unroll
        for (int j = 0; j < 2; ++j)
#pragma unroll
            for (int k = 0; k < 3; ++k)
#pragma unroll
                for (int i = 0; i < 8; ++i) wv[j][k][i] = cw[k * D + (lane + 64 * j) * 8 + i];
        auto load_cx = [&](int lr, float (&cx)[2][8]) {
            if (lr < 0 || lr >= M) {
#pragma unroll
                for (int i = 0; i < 8; ++i) { cx[0][i] = 0.f; cx[1][i] = 0.f; }
                return; }
            const bf16_t* u = U + (size_t)lr * UC;
#pragma unroll
            for (int j = 0; j < 2; ++j) { const int ch = (lane + 64 * j) * 8; float c8[8], x8[8]; unpack8(*(const uint4*)(u + cCC + ch), c8); unpack8(*(const uint4*)(u + cCX + ch), x8);
#pragma unroll
                for (int i = 0; i < 8; ++i) cx[j][i] = c8[i] * x8[i]; }
        };
        if (lr0 < M) { load_cx(lr0 - 1, pcx); load_cx(lr0, ccx); }
        for (int lr = lr0; lr < lr1; ++lr) {
            load_cx(lr + 1, ncx);
            const bool isctx = lr >= ML; const int t = isctx ? ((lr - ML) & 255) : (lr & 2047); const int Ls = isctx ? 256 : 2048;
            const float mp = t > 0 ? 1.f : 0.f, mn = t < Ls - 1 ? 1.f : 0.f;
            if (!(isctx && last)) {
                const bf16_t* u0 = U + (size_t)lr * UC;
#pragma unroll
                for (int j = 0; j < 2; ++j) { const int ch = (lane + 64 * j) * 8;
                    float cb[8]; unpack8(*(const uint4*)(u0 + cCB + ch), cb);
                    float o[8];
#pragma unroll
                    for (int i = 0; i < 8; ++i) o[i] = cb[i] * (wv[j][0][i] * (pcx[j][i] * mp) + wv[j][1][i] * ccx[j][i] + wv[j][2][i] * (ncx[j][i] * mn));
                    bf16_t* yo = isctx ? (bf16_t*)(ws + O_YBRC) + ((size_t)g * MC + (lr - ML)) * D : YC + (size_t)lr * D;
                    *(uint4*)(yo + ch) = pack8(o); }
            }
#pragma unroll
            for (int i = 0; i < 8; ++i)
#pragma unroll
                for (int j = 0; j < 2; ++j) { pcx[j][i] = ccx[j][i]; ccx[j][i] = ncx[j][i]; }
        }
    }
    float sv[3][4][8], pxb[3][8], cxb[3][8], nxb[3][8];
#pragma unroll
    for (int j = 0; j < 3; ++j)
#pragma unroll
        for (int i = 0; i < 8; ++i) { const int ch = (lane + 64 * j) * 8 + i; sv[j][0][i] = sw[ch]; sv[j][1][i] = sw[XW + ch]; sv[j][2][i] = sw[2 * XW + ch]; sv[j][3][i] = sb[ch]; }
    auto load_xb = [&](int lr, float (&xb)[3][8]) {
        if (lr < 0 || lr >= M) {
#pragma unroll
            for (int i = 0; i < 8; ++i) { xb[0][i] = 0.f; xb[1][i] = 0.f; xb[2][i] = 0.f; }
            return; }
        const bf16_t* u = U + (size_t)lr * UC;
#pragma unroll
        for (int j = 0; j < 3; ++j) unpack8(*(const uint4*)(u + cXBC + (lane + 64 * j) * 8), xb[j]);
    };
    if (lr0 < M) { load_xb(lr0 - 1, pxb); load_xb(lr0, cxb); }
    for (int lr = lr0; lr < lr1; ++lr) {
        load_xb(lr + 1, nxb);
        const bool isctx = lr >= ML; const int t = isctx ? ((lr - ML) & 255) : (lr & 2047); const int Ls = isctx ? 256 : 2048;
        const float mp = t > 0 ? 1.f : 0.f, mn = t < Ls - 1 ? 1.f : 0.f;
        bf16_t* u0 = U + (size_t)lr * UC;
#pragma unroll
        for (int j = 0; j < 3; ++j) { const int ch = (lane + 64 * j) * 8; float o[8];
#pragma unroll
            for (int i = 0; i < 8; ++i) o[i] = silu_f(sv[j][3][i] + sv[j][0][i] * (pxb[j][i] * mp) + sv[j][1][i] * cxb[j][i] + sv[j][2][i] * (nxb[j][i] * mn));
            *(uint4*)(XB + (size_t)lr * XW + ch) = pack8(o); }
#pragma unroll
        for (int i = 0; i < 8; ++i)
#pragma unroll
            for (int j = 0; j < 3; ++j) { pxb[j][i] = cxb[j][i]; cxb[j][i] = nxb[j][i]; }
        if (lane < 32) {
            const float raw = bflo((unsigned)u0[cDT + lane]) + p->ssd_dt_bias[l * 32 + lane];
            const float dt = fmaxf(raw, 0.f) + log1pf(__expf(-fabsf(raw)));
            const float A = -__expf(p->ssd_a_log[l * 32 + lane]);
            DTS[(size_t)lr * 32 + lane] = dt; DECS[(size_t)lr * 32 + lane] = dt * A;
        }
        if (do_qk) {
            const bool isk = lane >= 32; const int hd = (lane & 31) >> 1, i0 = (lane & 1) * 8;
            if (!(isk && isctx)) {
                bf16_t* base = u0 + (isk ? cK : cQ) + hd * 64 + i0; const float scl = isk ? 1.f : 0.125f;
                float a[8], b[8], c2[8], d2[8];
                unpack8(*(const uint4*)(base), a); unpack8(*(const uint4*)(base + 16), b); unpack8(*(const uint4*)(base + 32), c2); unpack8(*(const uint4*)(base + 48), d2);
                float cr[8], cc[8], sr[8], sc[8];
                if (!isctx) { const float* tb = tab + t * 64 + i0;
#pragma unroll
                    for (int i = 0; i < 8; ++i) { cr[i] = tb[i]; cc[i] = tb[16 + i]; sr[i] = tb[32 + i]; sc[i] = tb[48 + i]; } }
                else {
#pragma unroll
                    for (int i = 0; i < 8; ++i) { cr[i] = 1.f; cc[i] = 1.f; sr[i] = 0.f; sc[i] = 0.f; } }
                float oa[8], ob[8], oc[8], od[8];
#pragma unroll
                for (int i = 0; i < 8; ++i) { oa[i] = (a[i] * cr[i] - b[i] * sr[i]) * scl; ob[i] = (b[i] * cr[i] + a[i] * sr[i]) * scl;
                    oc[i] = (c2[i] * cc[i] - d2[i] * sc[i]) * scl; od[i] = (d2[i] * cc[i] + c2[i] * sc[i]) * scl; }
                *(uint4*)(base) = pack8(oa); *(uint4*)(base + 16) = pack8(ob); *(uint4*)(base + 32) = pack8(oc); *(uint4*)(base + 48) = pack8(od);
            }
        }
    }
}

__device__ void phase_scan(CP p, bool ctx_out, unsigned char* ldsb) {
    unsigned char* ws = p->ws; const int tid = fresh_tid(); const int lane = tid & 63, w = tid >> 6, fr = lane & 15, fq = lane >> 4;
    const int lt = w < 4 ? w : 11 - w;
    const bf16_t* XB = (const bf16_t*)(ws + O_XBCS); const float* DTS = (const float*)(ws + O_DTS); const float* AS = (const float*)(ws + O_DECS);
    bf16_t* YD = (bf16_t*)(ws + O_YDIR);
    constexpr int PT = 136;
    bf16_t* XT = (bf16_t*)ldsb; bf16_t* BT = XT + 64 * PT; bf16_t* HL = BT + 128 * PT; bf16_t* BR = HL + 64 * PT; float* CUM = (float*)(BR + 128 * PT);
    typedef unsigned u32x4 __attribute__((ext_vector_type(4)));
    for (int item = blockIdx.x; item < GB * 32; item += gridDim.x) {
        const int dir = item & 1, head = (item >> 1) & 15, bl = item >> 5, grp = head >> 3;
        auto row_of = [&](int s) -> int { return s < 256 ? (ML + bl * 256 + (dir ? 255 - s : s)) : (bl * 2048 + (dir ? 2047 - (s - 256) : (s - 256))); };
        f32x4 hacc[4];
#pragma unroll
        for (int i = 0; i < 4; ++i) hacc[i] = (f32x4){0.f, 0.f, 0.f, 0.f};
        __syncthreads();
        for (int i = tid; i < 64 * PT / 2; i += 512) ((unsigned*)HL)[i] = 0u;
        uint4 rx[2], rb[4]; float rdt[2], ra[2];
        auto load_chunk = [&](int ch) {
#pragma unroll
            for (int q = 0; q < 2; ++q) { const int lr = row_of(ch * 128 + 2 * lane + q); const bf16_t* row = XB + (size_t)lr * XW;
                rx[q] = *(const uint4*)(row + head * 64 + w * 8); rb[2 * q] = *(const uint4*)(row + 1024 + grp * 128 + w * 16); rb[2 * q + 1] = *(const uint4*)(row + 1024 + grp * 128 + w * 16 + 8);
                rdt[q] = DTS[(size_t)lr * 32 + dir * 16 + head]; ra[q] = AS[(size_t)lr * 32 + dir * 16 + head]; }
        };
        load_chunk(0);
        for (int ch = 0; ch < 18; ++ch) {
            const bool doy = ctx_out || ch >= 2;
            const int lrl = row_of(ch * 128 + 16 * lt + fr);
            bf16x8 cf[4];
            if (doy) { const bf16_t* cp = XB + (size_t)lrl * XW + 1280 + grp * 128 + fq * 8;
#pragma unroll
                for (int k = 0; k < 4; ++k) cf[k] = *(const bf16x8*)(cp + k * 32); }
            const float ps = ra[0] + ra[1]; float incl = ps;
#pragma unroll
            for (int o = 1; o < 64; o <<= 1) { const float t = __shfl_up(incl, o); if (lane >= o) incl += t; }
            const float c0 = incl - ra[1], c1 = incl, total = __shfl(incl, 63);
            const float w0 = __expf(total - c0), w1 = __expf(total - c1), dec_total = __expf(total);
            if (w == 0) { CUM[2 * lane] = c0; CUM[2 * lane + 1] = c1; }
            { float x0[8], x1[8]; unpack8(rx[0], x0); unpack8(rx[1], x1);
#pragma unroll
              for (int i = 0; i < 8; ++i) ((unsigned*)(XT + (w * 8 + i) * PT))[lane] = pack2(x0[i] * rdt[0], x1[i] * rdt[1]); }
#pragma unroll
            for (int q = 0; q < 2; ++q) { *(uint4*)(BR + (2 * lane + q) * PT + w * 16) = rb[2 * q]; *(uint4*)(BR + (2 * lane + q) * PT + w * 16 + 8) = rb[2 * q + 1]; }
#pragma unroll
            for (int hh = 0; hh < 2; ++hh) { float b0[8], b1[8]; unpack8(rb[hh], b0); unpack8(rb[2 + hh], b1);
#pragma unroll
                for (int i = 0; i < 8; ++i) ((unsigned*)(BT + (w * 16 + hh * 8 + i) * PT))[lane] = pack2(b0[i] * w0, b1[i] * w1); }
            __syncthreads();
            if (ch + 1 < 18) load_chunk(ch + 1);
            if (doy) {
                const float cl = CUM[16 * lt + fr]; const float ecl = __expf(cl);
                f32x4 yacc[4];
#pragma unroll
                for (int pt = 0; pt < 4; ++pt) { f32x4 acc = (f32x4){0.f, 0.f, 0.f, 0.f};
#pragma unroll
                    for (int k = 0; k < 4; ++k) acc = __builtin_amdgcn_mfma_f32_16x16x32_bf16(*(const bf16x8*)(HL + (pt * 16 + fr) * PT + k * 32 + fq * 8), cf[k], acc, 0, 0, 0);
                    yacc[pt] = acc * ecl; }
                const int lidx = 16 * lt + fr;
#pragma unroll
                for (int sb = 0; sb < 4; ++sb) if (sb <= (lt >> 1)) {
                    f32x4 gt[2];
#pragma unroll
                    for (int t = 0; t < 2; ++t) { const int srow = sb * 32 + (fr >> 2) * 8 + t * 4 + (fr & 3);
                        const bf16_t* bp = BR + srow * PT + fq * 8; f32x4 acc = (f32x4){0.f, 0.f, 0.f, 0.f};
#pragma unroll
                        for (int k = 0; k < 4; ++k) acc = __builtin_amdgcn_mfma_f32_16x16x32_bf16(*(const bf16x8*)(bp + k * 32), cf[k], acc, 0, 0, 0);
                        gt[t] = acc; }
                    const float4 cs0 = *(const float4*)(CUM + sb * 32 + fq * 8), cs1 = *(const float4*)(CUM + sb * 32 + fq * 8 + 4);
                    const float csv[8] = {cs0.x, cs0.y, cs0.z, cs0.w, cs1.x, cs1.y, cs1.z, cs1.w};
                    float e[8];
#pragma unroll
                    for (int i = 0; i < 8; ++i) { const int sidx = sb * 32 + fq * 8 + i; e[i] = sidx <= lidx ? gt[i >> 2][i & 3] * __expf(fminf(cl - csv[i], 0.f)) : 0.f; }
                    const u32x4 pk = {pack2(e[0], e[1]), pack2(e[2], e[3]), pack2(e[4], e[5]), pack2(e[6], e[7])};
                    const bf16x8 pb = __builtin_bit_cast(bf16x8, pk);
#pragma unroll
                    for (int pt = 0; pt < 4; ++pt) yacc[pt] = __builtin_amdgcn_mfma_f32_16x16x32_bf16(*(const bf16x8*)(XT + (pt * 16 + fr) * PT + sb * 32 + fq * 8), pb, yacc[pt], 0, 0, 0);
                }
                bf16_t* op = YD + ((size_t)dir * M + lrl) * D + head * 64 + fq * 4;
#pragma unroll
                for (int pt = 0; pt < 4; ++pt) *(uint2*)(op + pt * 16) = make_uint2(pack2(yacc[pt][0], yacc[pt][1]), pack2(yacc[pt][2], yacc[pt][3]));
            }
            if (ch == 17) break;
#pragma unroll
            for (int pt = 0; pt < 4; ++pt) hacc[pt] *= dec_total;
#pragma unroll
            for (int k = 0; k < 4; ++k) { const bf16x8 bfr = *(const bf16x8*)(BT + (16 * w + fr) * PT + k * 32 + fq * 8);
#pragma unroll
                for (int pt = 0; pt < 4; ++pt) hacc[pt] = __builtin_amdgcn_mfma_f32_16x16x32_bf16(*(const bf16x8*)(XT + (pt * 16 + fr) * PT + k * 32 + fq * 8), bfr, hacc[pt], 0, 0, 0); }
            __syncthreads();
#pragma unroll
            for (int pt = 0; pt < 4; ++pt)
#pragma unroll
                for (int j = 0; j < 4; ++j) HL[(pt * 16 + fq * 4 + j) * PT + 16 * w + fr] = (bf16_t)f2bf(hacc[pt][j]);
        }
    }
}

__device__ void phase_vtrans(CP p, unsigned* lds) {
    unsigned char* ws = p->ws; const int tid = fresh_tid();
    const bf16_t* U = (const bf16_t*)(ws + O_U); bf16_t* VT = (bf16_t*)(ws + O_VT);
    constexpr int P = 130;
    uint4 tv[4];
    auto tile_load = [&](int tile) {
        const int cg4 = tile & 3, tt = (tile >> 2) % 36, bl = tile / 144;
        const int row0 = tt < 32 ? bl * 2048 + tt * 64 : ML + bl * 256 + (tt - 32) * 64;
#pragma unroll
        for (int i = 0; i < 4; ++i) { const int idx = i * 512 + tid, rr = idx >> 5, ck = idx & 31; tv[i] = *(const uint4*)(U + (size_t)(row0 + rr) * UC + cV + cg4 * 256 + ck * 8); }
    };
    if ((int)blockIdx.x < GB * 36 * 4) tile_load(blockIdx.x);
    for (int tile = blockIdx.x; tile < GB * 36 * 4; tile += gridDim.x) {
        const int cg4 = tile & 3, tt = (tile >> 2) % 36, bl = tile / 144;
        __syncthreads();
#pragma unroll
        for (int i = 0; i < 4; ++i) { const int idx = i * 512 + tid, rr = idx >> 5, ck = idx & 31; const uint4 v = tv[i];
            *(uint2*)(lds + rr * P + ck * 4) = make_uint2(v.x, v.y); *(uint2*)(lds + rr * P + ck * 4 + 2) = make_uint2(v.z, v.w); }
        __syncthreads();
        if (tile + (int)gridDim.x < GB * 36 * 4) tile_load(tile + gridDim.x);
        const unsigned short* l16 = (const unsigned short*)lds;
#pragma unroll
        for (int k = 0; k < 4; ++k) { const int col = (tid >> 3) + 64 * k, tg = tid & 7;
            unsigned w[4];
#pragma unroll
            for (int i = 0; i < 4; ++i) { const unsigned lo = l16[(tg * 8 + 2 * i) * (2 * P) + col], hi = l16[(tg * 8 + 2 * i + 1) * (2 * P) + col]; w[i] = lo | (hi << 16); }
            const int head = cg4 * 4 + (col >> 6), d = col & 63;
            *(uint4*)(VT + ((size_t)((bl * 16 + head) * 64 + d)) * 2304 + tt * 64 + tg * 8) = make_uint4(w[0], w[1], w[2], w[3]); }
    }
}

constexpr int ATT_KP = 72, ATT_VP = 264;
constexpr int ATT_LK = 0, ATT_LV = ATT_LK + 256 * ATT_KP * 2, ATT_LB = ATT_LV + 64 * ATT_VP * 2;
constexpr int ATT_KB = 72704;
constexpr int ATT_LDS_END = ATT_KB + 9 * 64 * 128;
__device__ __forceinline__ int att_kb_off(int key, int c) { const int f = ((key >> 1) & 1) | (((key >> 3) & 3) << 1); return key * 128 + ((c ^ f) << 4); }

template <bool MASK>
__device__ __forceinline__ void attn_chunk(const bf16x8 (&kc)[2][2][2], const bf16x8 (&vv)[2][4], const bf16x8 q0, const bf16x8 q1, f32x4 (&oacc)[4], float& mrun, float& lrun,
                                           const float* rpl, int dr0, int w0, int c, int cs, int fq) {
    f32x4 sc[2][2];
#pragma unroll
    for (int b = 0; b < 2; ++b) {
#pragma unroll
        for (int t = 0; t < 2; ++t) { f32x4 a = (f32x4){0.f, 0.f, 0.f, 0.f};
            a = __builtin_amdgcn_mfma_f32_16x16x32_bf16(kc[b][t][0], q0, a, 0, 0, 0);
            a = __builtin_amdgcn_mfma_f32_16x16x32_bf16(kc[b][t][1], q1, a, 0, 0, 0);
            sc[b][t] = a; }
        if (MASK) {
            const int dr = dr0 + b * 31;
#pragma unroll
            for (int t = 0; t < 2; ++t)
#pragma unroll
                for (int j = 0; j < 4; ++j) { const int kcol = w0 + fq * 8 + t * 4 + j; const bool ok = (unsigned)(kcol - cs) < 16u; const int dci = ok ? kcol - c + 15 : 15;
                    const float bias = rpl[dr + dci]; sc[b][t][j] = ok ? sc[b][t][j] + bias : -1e30f; }
        }
    }
    float mx = -1e30f;
#pragma unroll
    for (int b = 0; b < 2; ++b)
#pragma unroll
        for (int t = 0; t < 2; ++t)
#pragma unroll
            for (int j = 0; j < 4; ++j) mx = fmaxf(mx, sc[b][t][j]);
    mx = fmaxf(mx, __shfl_xor(mx, 16)); mx = fmaxf(mx, __shfl_xor(mx, 32));
    if (!__all(mx - mrun <= 8.f)) {
        const float mnew = fmaxf(mrun, mx), corr = __expf(mrun - mnew);
        lrun *= corr; mrun = mnew;
#pragma unroll
        for (int i = 0; i < 4; ++i) oacc[i] *= corr;
    }
    const float mnew = mrun;
#pragma unroll
    for (int b = 0; b < 2; ++b) {
        float e[8];
#pragma unroll
        for (int t = 0; t < 2; ++t)
#pragma unroll
            for (int j = 0; j < 4; ++j) { e[t * 4 + j] = __expf(sc[b][t][j] - mnew); lrun += e[t * 4 + j]; }
        const u32x4_t pk = {pack2(e[0], e[1]), pack2(e[2], e[3]), pack2(e[4], e[5]), pack2(e[6], e[7])};
        const bf16x8 pb = __builtin_bit_cast(bf16x8, pk);
#pragma unroll
        for (int dt = 0; dt < 4; ++dt) oacc[dt] = __builtin_amdgcn_mfma_f32_16x16x32_bf16(vv[b][dt], pb, oacc[dt], 0, 0, 0);
    }
}

template <bool LAT>
__device__ __forceinline__ void attn_wave_item(const bf16_t* __restrict__ U, const bf16_t* __restrict__ VT, bf16_t* __restrict__ YN, const unsigned char* ldsb,
                                               int bl, int head, int r, int jq, int lane, int rb0) {
    const int fr = lane & 15, fq = lane >> 4;
    const float* rpl = (const float*)(ldsb + ATT_LB);
    int lrq0, r0 = 0, w0 = 0, c = 0, cs = 0;
    if (LAT) { lrq0 = bl * 2048 + r * 64 + jq * 16; r0 = min(max(r - 4, 0), 24); w0 = jq == 0 ? 0 : (jq == 1 ? 8 : (jq == 2 ? 24 : 32)); c = jq * 16 + fr; cs = min(max(c - 8, 0), 48); }
    else lrq0 = ML + bl * 256 + jq * 16;
    const bf16_t* qp = U + (size_t)(lrq0 + fr) * UC + cQ + head * 64 + fq * 8;
    const bf16x8 q0 = *(const bf16x8*)qp, q1 = *(const bf16x8*)(qp + 32);
    f32x4 oacc[4];
#pragma unroll
    for (int i = 0; i < 4; ++i) oacc[i] = (f32x4){0.f, 0.f, 0.f, 0.f};
    float mrun = -1e30f, lrun = 0.f;
    const int kapl = (fr >> 2) * 8 + (fr & 3);
    bf16x8 kc[2][2][2], vv[2][4];
    if (LAT) {
        const bf16_t* Vh = VT + (size_t)(bl * 16 + head) * 64 * 2304;
        unsigned vov[4];
#pragma unroll
        for (int dt = 0; dt < 4; ++dt) vov[dt] = (unsigned)((fr + 16 * dt) * 2304 + fq * 8);
        unsigned vto = (unsigned)(r0 * 64 + w0);
        const unsigned vstep = 64u;
        const unsigned char* KB = ldsb + ATT_KB;
#pragma unroll 1
        for (int ch = 0; ch < 4; ++ch) {
#pragma unroll
            for (int b = 0; b < 2; ++b)
#pragma unroll
                for (int dt = 0; dt < 4; ++dt) vv[b][dt] = *(const bf16x8*)(Vh + (vto + b * vstep + vov[dt]));
            vto += 2 * vstep;
#pragma unroll
            for (int b = 0; b < 2; ++b)
#pragma unroll
                for (int t = 0; t < 2; ++t) { const int key = (r0 - rb0 + ch * 2 + b) * 64 + w0 + kapl + 4 * t;
                    kc[b][t][0] = *(const bf16x8*)(KB + att_kb_off(key, fq)); kc[b][t][1] = *(const bf16x8*)(KB + att_kb_off(key, fq + 4)); }
            attn_chunk<true>(kc, vv, q0, q1, oacc, mrun, lrun, rpl, (r0 + ch * 2 - r + 7) * 31, w0, c, cs, fq);
        }
    }
    const bf16_t* LK = (const bf16_t*)(ldsb + ATT_LK) + kapl * ATT_KP + fq * 8;
    const bf16_t* LV = (const bf16_t*)(ldsb + ATT_LV) + fr * ATT_VP + fq * 8;
#pragma unroll 1
    for (int ch = 0; ch < 4; ++ch) {
#pragma unroll
        for (int b = 0; b < 2; ++b) {
#pragma unroll
            for (int t = 0; t < 2; ++t) { const bf16_t* kp = LK + ((ch * 2 + b) * 32 + 4 * t) * ATT_KP; kc[b][t][0] = *(const bf16x8*)kp; kc[b][t][1] = *(const bf16x8*)(kp + 32); }
#pragma unroll
            for (int dt = 0; dt < 4; ++dt) vv[b][dt] = *(const bf16x8*)(LV + dt * 16 * ATT_VP + (ch * 2 + b) * 32);
        }
        attn_chunk<false>(kc, vv, q0, q1, oacc, mrun, lrun, rpl, 0, 0, 0, 0, fq);
    }
    lrun += __shfl_xor(lrun, 16); lrun += __shfl_xor(lrun, 32);
    const float inv = 1.f / lrun;
    bf16_t* op = YN + (size_t)(lrq0 + fr) * D + head * 64 + fq * 4;
#pragma unroll
    for (int dt = 0; dt < 4; ++dt) *(uint2*)(op + dt * 16) = make_uint2(pack2(oacc[dt][0] * inv, oacc[dt][1] * inv), pack2(oacc[dt][2] * inv, oacc[dt][3] * inv));
}

__device__ void phase_attn(CP p, int g, int l, bool do_ctx, unsigned char* ldsb) {
    unsigned char* ws = p->ws; const int tid = fresh_tid(); const int lane = tid & 63, wid = tid >> 6;
    const bf16_t* U = (const bf16_t*)(ws + O_U); const bf16_t* VT = (const bf16_t*)(ws + O_VT); bf16_t* YN = (bf16_t*)(ws + O_YBR) + (size_t)2 * M * D;
    const int G = gridDim.x, cb = blockIdx.x;
    const int nlat = GB * 16 * 16, nctx = do_ctx ? GB * 16 * 2 : 0;
    const int perl = (nlat + G - 1) / G, perc = (nctx + G - 1) / G;
    int cur = -1;
    for (int k = 0; k < perl + perc; ++k) {
        const bool lat = k < perl;
        const int item = lat ? cb * perl + k : cb * perc + (k - perl);
        if (item >= (lat ? nlat : nctx)) continue;
        const int bh = lat ? (item >> 4) : (item >> 1);
        const int bl = bh >> 4, head = bh & 15;
        if (bh != cur) {
            cur = bh;
            __syncthreads();
#pragma unroll
            for (int i = 0; i < 4; ++i) { const int idx = i * 512 + tid;
                { const int key = idx >> 3, part = idx & 7;
                  *(uint4*)((bf16_t*)(ldsb + ATT_LK) + key * ATT_KP + part * 8) = *(const uint4*)(U + (size_t)(ML + bl * 256 + key) * UC + cK + head * 64 + part * 8); }
                { const int d = idx >> 5, part = idx & 31;
                  *(uint4*)((bf16_t*)(ldsb + ATT_LV) + d * ATT_VP + part * 8) = *(const uint4*)(VT + ((size_t)(bh * 64 + d)) * 2304 + 2048 + part * 8); } }
            if (tid < 465) ((float*)(ldsb + ATT_LB))[tid] = p->na_rpb[(size_t)(l * 16 + head) * 465 + tid];
            __syncthreads();
        }
        if (lat) {
            const int rp = item & 15, rb0 = min(max(2 * rp - 4, 0), 24);
            __syncthreads();
#pragma unroll
            for (int i = 0; i < 9; ++i) { const int idx = i * 512 + tid, key = idx >> 3, cc = idx & 7; const int brow = rb0 + (key >> 6);
                if (brow < 32) *(uint4*)(ldsb + ATT_KB + att_kb_off(key, cc)) = *(const uint4*)(U + (size_t)(bl * 2048 + brow * 64 + (key & 63)) * UC + cK + head * 64 + cc * 8); }
            __syncthreads();
            attn_wave_item<true>(U, VT, YN, ldsb, bl, head, rp * 2 + (wid >> 2), wid & 3, lane, rb0);
        }
        else attn_wave_item<false>(U, VT, (bf16_t*)(ws + O_YBRC) + ((size_t)2 * NCTX + (size_t)g * MC) * D - (size_t)ML * D, ldsb, bl, head, 0, (item & 1) * 8 + wid, lane, 0);
    }
}

__device__ void phase_ssdfin(CP p, int g, int l, int Mrows) {
    unsigned char* ws = p->ws; const int tid_ = fresh_tid(); const int lane = tid_ & 63, gw = blockIdx.x * 8 + (tid_ >> 6), nw = gridDim.x * 8;
    const bf16_t* U = (const bf16_t*)(ws + O_U); const bf16_t* XB = (const bf16_t*)(ws + O_XBCS); const bf16_t* YD = (const bf16_t*)(ws + O_YDIR);
    bf16_t* YS = (bf16_t*)(ws + O_YBR) + (size_t)M * D;
    const int head = lane >> 2; const float dsum = p->ssd_d[l * 32 + head] + p->ssd_d[l * 32 + 16 + head];
    float nwr[16];
#pragma unroll
    for (int i = 0; i < 16; ++i) nwr[i] = p->ssd_norm_w[l * D + lane * 16 + i];
    uint4 cu[2][4], nx[2][4];
    auto load_in = [&](int lr, uint4 (&d)[2][4]) {
#pragma unroll
        for (int j = 0; j < 2; ++j) { const int ch = lane * 16 + j * 8;
            d[j][0] = *(const uint4*)(YD + (size_t)lr * D + ch); d[j][1] = *(const uint4*)(YD + ((size_t)M + lr) * D + ch);
            d[j][2] = *(const uint4*)(XB + (size_t)lr * XW + ch); d[j][3] = *(const uint4*)(U + (size_t)lr * UC + cZ + ch); }
    };
    if (gw < Mrows) load_in(gw, cu);
    for (int lr = gw; lr < Mrows; lr += nw) {
        if (lr + nw < Mrows) load_in(lr + nw, nx);
        float v[16]; float ss = 0.f;
#pragma unroll
        for (int j = 0; j < 2; ++j) {
            float y0[8], y1[8], xs[8], z[8];
            unpack8(cu[j][0], y0); unpack8(cu[j][1], y1); unpack8(cu[j][2], xs); unpack8(cu[j][3], z);
#pragma unroll
            for (int i = 0; i < 8; ++i) { const float t = (y0[i] + y1[i] + xs[i] * dsum) * silu_f(z[i]); v[j * 8 + i] = t; ss += t * t; } }
#pragma unroll
        for (int o = 16; o; o >>= 1) ss += __shfl_xor(ss, o);
        const float rs = rsqrtf(ss * (1.f / 512.f) + EPS);
#pragma unroll
        for (int j = 0; j < 2; ++j) { const int ch = lane * 16 + j * 8; float o8[8];
#pragma unroll
            for (int i = 0; i < 8; ++i) o8[i] = v[j * 8 + i] * rs * nwr[j * 8 + i];
            bf16_t* yo = lr >= ML ? (bf16_t*)(ws + O_YBRC) + ((size_t)NCTX + (size_t)g * MC + (lr - ML)) * D : YS + (size_t)lr * D;
            *(uint4*)(yo + ch) = pack8(o8); }
        if (lr >= ML) {
            const bf16_t* gs_ = U + (size_t)lr * UC + cGATE; bf16_t* gd = (bf16_t*)(ws + O_GATEC) + ((size_t)g * MC + (lr - ML)) * 3072;
#pragma unroll
            for (int j = 0; j < 6; ++j) *(uint4*)(gd + (j * 64 + lane) * 8) = *(const uint4*)(gs_ + (j * 64 + lane) * 8);
        }
#pragma unroll
        for (int j = 0; j < 2; ++j)
#pragma unroll
            for (int k = 0; k < 4; ++k) cu[j][k] = nx[j][k];
    }
}

__device__ void phase_final(CP p, int g) {
    const int tid_ = fresh_tid(); const int lane = tid_ & 63, gw = blockIdx.x * 8 + (tid_ >> 6), nw = gridDim.x * 8;
    float4 wv[4], v[4], nx[4];
#pragma unroll
    for (int j = 0; j < 4; ++j) wv[j] = *(const float4*)(p->final_norm_w + j * 256 + lane * 4);
    float* base = p->out + (size_t)g * ML * D;
    if (gw < ML) {
#pragma unroll
        for (int j = 0; j < 4; ++j) v[j] = *(const float4*)(base + (size_t)gw * D + j * 256 + lane * 4); }
    for (int lr = gw; lr < ML; lr += nw) {
        float* hrow = base + (size_t)lr * D;
        if (lr + nw < ML) {
#pragma unroll
            for (int j = 0; j < 4; ++j) nx[j] = *(const float4*)(hrow + (size_t)nw * D + j * 256 + lane * 4); }
        float ss = 0.f;
#pragma unroll
        for (int j = 0; j < 4; ++j) ss += v[j].x * v[j].x + v[j].y * v[j].y + v[j].z * v[j].z + v[j].w * v[j].w;
        ss = wave_sum(ss);
        const float rs = rsqrtf(ss * (1.f / 1024.f) + EPS);
#pragma unroll
        for (int j = 0; j < 4; ++j) { const int col = j * 256 + lane * 4; const float4 w = wv[j];
            *(float4*)(hrow + col) = make_float4(v[j].x * rs * w.x, v[j].y * rs * w.y, v[j].z * rs * w.z, v[j].w * rs * w.w); }
#pragma unroll
        for (int j = 0; j < 4; ++j) v[j] = nx[j];
    }
}

#define XB_TMO      128
#define XB_XCNT(j)  (256  + 64 * (j))
#define XB_XSUB(j)  (1280 + 64 * (j))
#define XB_XGEN(j)  (2304 + 64 * (j))
#define XB_TOP      3328
#define XB_TOPGEN   3392
#define XCD_BAR_WORDS 3456
#define XB_SPIN_CAP (1u << 20)
__device__ __forceinline__ unsigned xb_ld(unsigned* p)              { return __hip_atomic_load(p, __ATOMIC_RELAXED, __HIP_MEMORY_SCOPE_AGENT); }
__device__ __forceinline__ unsigned xb_add(unsigned* p, unsigned v) { return __hip_atomic_fetch_add(p, v, __ATOMIC_RELAXED, __HIP_MEMORY_SCOPE_AGENT); }
__device__ __forceinline__ unsigned xb_xcc_id() { return (unsigned)__builtin_amdgcn_s_getreg((3 << 11) | 20) & 0xFu; }
#define XB_SPIN(cond, bar) do { unsigned _sp = 0; while (cond) { __builtin_amdgcn_s_sleep(1); \
    if ((++_sp & 255u) == 0u) { if (xb_ld(&(bar)[XB_TMO])) break; if (_sp > XB_SPIN_CAP) { atomicAdd(&(bar)[XB_TMO], 1u); break; } } } } while (0)
struct XcdBarrier { unsigned* bar; unsigned x; volatile LAS unsigned* st; };
__device__ __forceinline__ XcdBarrier xcd_barrier_post(unsigned* bar, volatile LAS unsigned* st) {
    XcdBarrier b; b.bar = bar; b.x = xb_xcc_id(); b.st = st;
    if (threadIdx.x == 0) (void)xb_add(&bar[XB_XCNT(b.x)], 1u);
    return b;
}
__device__ __forceinline__ void xcd_barrier_complete(unsigned* bar, unsigned x, unsigned& nloc, unsigned& nx) {
    const unsigned G = gridDim.x * gridDim.y * gridDim.z;
    unsigned sum, cnt, mine, sp = 0u;
    for (;;) {
        sum = 0u; cnt = 0u; mine = 0u;
#pragma unroll
        for (unsigned j = 0; j < 16; ++j) { const unsigned c = xb_ld(&bar[XB_XCNT(j)]); sum += c; cnt += (c > 0u) ? 1u : 0u; mine = (j == x) ? c : mine; }
        if (sum == G) break;
        __builtin_amdgcn_s_sleep(1);
        if ((++sp & 255u) == 0u) { if (xb_ld(&bar[XB_TMO])) break; if (sp > XB_SPIN_CAP) { atomicAdd(&bar[XB_TMO], 1u); break; } }
    }
    nloc = mine > 0u ? mine : 1u; nx = cnt > 0u ? cnt : 1u;
}
__device__ __forceinline__ void xcd_barrier(const XcdBarrier& b) {
    asm volatile("s_waitcnt vmcnt(0)" ::: "memory");
    __syncthreads();
    if (threadIdx.x == 0) {
        unsigned* bar = b.bar;
        __builtin_amdgcn_s_waitcnt(0);
        unsigned nloc = b.st[0], nx = b.st[1];
        if (nloc == 0u) { xcd_barrier_complete(bar, b.x, nloc, nx); b.st[0] = nloc; b.st[1] = nx; }
        const unsigned old = xb_add(&bar[XB_XSUB(b.x)], 1u);
        const unsigned gen = old / nloc;
        if (old + 1u == (gen + 1u) * nloc) {
            __builtin_amdgcn_fence(__ATOMIC_RELEASE, "agent");
            asm volatile("s_waitcnt vmcnt(0)" ::: "memory");
            const unsigned og = xb_add(&bar[XB_TOP], 1u);
            const unsigned tg = og / nx;
            if (og + 1u == (tg + 1u) * nx) xb_add(&bar[XB_TOPGEN], 1u);
            else XB_SPIN(xb_ld(&bar[XB_TOPGEN]) == tg, bar);
            __builtin_amdgcn_fence(__ATOMIC_ACQUIRE, "agent");
            xb_add(&bar[XB_XGEN(b.x)], 1u);
            asm volatile("s_waitcnt vmcnt(0)" ::: "memory");
        } else {
            XB_SPIN(xb_ld(&bar[XB_XGEN(b.x)]) == gen, bar);
            __builtin_amdgcn_fence(__ATOMIC_ACQUIRE, "agent");
            asm volatile("s_waitcnt vmcnt(0)" ::: "memory");
        }
    }
    __syncthreads();
}
#define GSYNC() do { xcd_barrier(xb); if (PROBE_DUP == 20) xcd_barrier(xb); } while (0)
__global__ void __launch_bounds__(512, 2) fwd_megakernel(Params p_unused) {
    extern __shared__ __attribute__((aligned(16))) unsigned char shm[];
    cg::grid_group grid = cg::this_grid();
    float* ldsf = (float*)shm; LAS unsigned char* ldsg = (LAS unsigned char*)shm;
    __shared__ uint4 xb_words;
    if (threadIdx.x == 0) xb_words = make_uint4(0u, 0u, 0u, 0u);
    __syncthreads();
    const XcdBarrier xb = xcd_barrier_post((unsigned*)(params_ptr()->ws + O_BAR), (volatile LAS unsigned*)&xb_words);
    DUP(1, phase_prep(params_ptr(), ldsf););
    grid.sync();
    for (int l = 0; l < 2; ++l) {
        const bool last = (l == 1);
        for (int g = 0; g < NG + (last ? 0 : 1); ++g) {
            const bool cchain = (g == NG);
            if (!cchain) {
                DUP(2, phase_norm(params_ptr(), g, l, 0, M, false););
                GSYNC();
                DUP(3, { CP p = params_ptr(); unsigned char* ws = p->ws; const int G = gridDim.x, cb = blockIdx.x;
                  pg8::Gemm gm{(const bf16_t*)(ws + O_AN), (const bf16_t*)(ws + O_WIN + l * SZ_WIN), M, UC, D, 0, 0};
                  pg8::StaticOrder S; S.init(M, UC, G, cb, 1); EpiU E{(bf16_t*)(ws + O_U)}; pg8::gemm_phase(ldsg, gm, S, E); });
                GSYNC();
                DUP(12, phase_mixprep(params_ptr(), g, l, last, rep_ == 0););
                DUP(4, phase_vtrans(params_ptr(), (unsigned*)shm););
                GSYNC();
                DUP(5, phase_scan(params_ptr(), !last, shm););
                DUP(6, phase_attn(params_ptr(), g, l, !last, shm););
                GSYNC();
                DUP(7, phase_ssdfin(params_ptr(), g, l, last ? ML : M););
                GSYNC();
            }
            const int Mr = cchain ? NCTX : ML;
            DUP(8, { CP p = params_ptr(); unsigned char* ws = p->ws; const int G = gridDim.x, cb = blockIdx.x;
              pg8::Gemm gm{(const bf16_t*)(ws + (cchain ? O_YBRC : O_YBR)), (const bf16_t*)(ws + O_WBR + l * SZ_WBR), Mr, D, D, (size_t)(cchain ? NCTX : M) * D * 2, (size_t)D * D * 2};
              pg8::StaticOrder S; S.init(Mr, D, G, cb, 3);
              EpiMerge E{cchain ? (const bf16_t*)(ws + O_GATEC) : (const bf16_t*)(ws + O_U) + cGATE, cchain ? 3072 : UC, (bf16_t*)(ws + O_MRGB)}; pg8::gemm_phase(ldsg, gm, S, E); });
            GSYNC();
            DUP(9, { CP p = params_ptr(); unsigned char* ws = p->ws; const int G = gridDim.x, cb = blockIdx.x;
              const float* modl = (const float*)(ws + O_MOD) + (size_t)l * 33 * 6144;
              float* hl = p->out + (size_t)g * ML * D; float* hc = (float*)(ws + O_HC) + (cchain ? (size_t)0 : (size_t)g * MC * D);
              pg8::Gemm gm{(const bf16_t*)(ws + O_MRGB), (const bf16_t*)(ws + O_WOUT + l * SZ_WOUT), Mr, D, D, 0, 0};
              pg8::StaticOrder S; S.init(Mr, D, G, cb, 1); EpiRes E{hl, hc, modl + 2048, g, rep_ == 0 ? 1.f : 0.f, cchain ? 1 : 0, (l == 0 && rep_ == 0) ? (cchain ? (long)(p->ctx - hc) : (long)((p->x + (size_t)g * ML * D) - hl)) : 0L}; pg8::gemm_phase(ldsg, gm, S, E); });
            GSYNC();
            DUP(10, phase_norm(params_ptr(), g, l, 1, Mr, cchain););
            GSYNC();
            DUP(11, { CP p = params_ptr(); unsigned char* ws = p->ws; const int G = gridDim.x, cb = blockIdx.x;
              pg8::Gemm gm{(const bf16_t*)(ws + O_AN), (const bf16_t*)(ws + O_WFF1 + l * SZ_WFF), Mr, 4096, D, 0, 0};
              pg8::StaticOrder S; S.init(Mr, 4096, G, cb, 1); EpiFF1 E{(bf16_t*)(ws + O_U)}; pg8::gemm_phase(ldsg, gm, S, E); });
            GSYNC();
            DUP(13, { CP p = params_ptr(); unsigned char* ws = p->ws; const int G = gridDim.x, cb = blockIdx.x;
              const float* modl = (const float*)(ws + O_MOD) + (size_t)l * 33 * 6144;
              float* hl = p->out + (size_t)g * ML * D; float* hc = (float*)(ws + O_HC) + (cchain ? (size_t)0 : (size_t)g * MC * D);
              pg8::Gemm gm{(const bf16_t*)(ws + O_U), (const bf16_t*)(ws + O_WFF2 + l * SZ_WFF), Mr, D, 4096, 0, 0};
              pg8::StaticOrder S; S.init(Mr, D, G, cb, 1); EpiRes E{hl, hc, modl + 5120, g, rep_ == 0 ? 1.f : 0.f, cchain ? 1 : 0, 0L}; pg8::gemm_phase(ldsg, gm, S, E); });
            GSYNC();
        }
    }
    for (int g = 0; g < NG; ++g) phase_final(params_ptr(), g);
}

extern "C" void kernel_launch(void* const* d_in, const int* in_sizes, int n_in, void* d_out, int out_size, void* d_ws, size_t ws_size, hipStream_t stream) {
    constexpr size_t kDynLds = 155648;
    static_assert(ATT_LDS_END <= 155648, "attention LDS image too large");
    static int grid_blocks = 0;
    if (grid_blocks == 0) {
        if (n_in != 24 || ws_size < WS_END) { fprintf(stderr, "kernel_launch: need 24 inputs and %zu bytes of workspace, got %d / %zu\n", (size_t)WS_END, n_in, ws_size); grid_blocks = -1; return; }
        int dev = 0, cus = 0, per_cu = 0;
        (void)hipGetDevice(&dev);
        (void)hipDeviceGetAttribute(&cus, hipDeviceAttributeMultiprocessorCount, dev);
        (void)hipFuncSetAttribute((const void*)fwd_megakernel, hipFuncAttributeMaxDynamicSharedMemorySize, (int)kDynLds);
        (void)hipOccupancyMaxActiveBlocksPerMultiprocessor(&per_cu, (const void*)fwd_megakernel, 512, kDynLds);
        if (per_cu < 1) per_cu = 1;
        grid_blocks = cus * per_cu;
        (void)hipGetLastError();
    }
    if (grid_blocks < 0) return;
    Params p{};
    const float** pp = (const float**)&p;
    for (int i = 0; i < 24; ++i) pp[i] = (const float*)d_in[i];
    p.out = (float*)d_out; p.ws = (unsigned char*)d_ws;
    (void)hipMemsetAsync((unsigned char*)d_ws + O_BAR, 0, 16384, stream);
    void* args[] = {&p};
    hipError_t e = hipLaunchCooperativeKernel((void*)fwd_megakernel, dim3(grid_blocks), dim3(512), args, kDynLds, stream);
    if (e != hipSuccess) fprintf(stderr, "cooperative launch failed: %s (grid %d)\n", hipGetErrorString(e), grid_blocks);
}
```

```cpp
#include <hip/hip_runtime.h>
#include <hip/hip_cooperative_groups.h>
#include <cstdio>
namespace cg = cooperative_groups;
#ifndef PROBE_DUP
#define PROBE_DUP 0
#endif
#define DUP(n, ...) do { _Pragma("nounroll") for (int rep_ = 0; rep_ < ((PROBE_DUP == (n)) ? 2 : 1); ++rep_) { __VA_ARGS__ } } while (0)

#define LAS __attribute__((address_space(3)))
typedef unsigned short bf16_t;
typedef short bf16x8 __attribute__((ext_vector_type(8)));
typedef float f32x4 __attribute__((ext_vector_type(4)));
typedef unsigned u32x4_t __attribute__((ext_vector_type(4)));

constexpr int D = 1024, NB = 32, L = 2048, CTX = 256;
constexpr int GB = 8, NG = NB / GB, ML = GB * L, MC = GB * CTX, M = ML + MC;
constexpr int UC = 12032, IN_COLS = 11808;
constexpr int cCB = 0, cCC = 1024, cCX = 2048, cZ = 3072, cXBC = 4096, cQ = 5632, cK = 6656, cV = 7680, cGATE = 8704, cDT = 11776;
constexpr int XW = 1536, NCTX = NB * CTX;
constexpr float EPS = 1e-6f;

constexpr size_t SZ_WIN = (size_t)UC * D * 2, SZ_WBR = (size_t)3 * D * D * 2, SZ_WOUT = (size_t)D * D * 2, SZ_WFF = (size_t)4 * D * D * 2;
constexpr size_t O_WIN = 0;
constexpr size_t O_WBR = O_WIN + 2 * SZ_WIN;
constexpr size_t O_WOUT = O_WBR + 2 * SZ_WBR;
constexpr size_t O_WFF1 = O_WOUT + 2 * SZ_WOUT;
constexpr size_t O_WFF2 = O_WFF1 + 2 * SZ_WFF;
constexpr size_t O_HC = O_WFF2 + 2 * SZ_WFF;
constexpr size_t O_MOD = O_HC + (size_t)NB * CTX * D * 4;
constexpr size_t O_ROPE = O_MOD + (size_t)2 * 33 * 6144 * 4 + 256 * 3;
constexpr size_t O_AN = O_ROPE + (size_t)2048 * 64 * 4;
constexpr size_t O_U = O_AN + (size_t)M * D * 2;
constexpr size_t O_XBCS = O_U + (size_t)M * UC * 2;
constexpr size_t O_DTS = O_XBCS + (size_t)M * XW * 2;
constexpr size_t O_DECS = O_DTS + (size_t)M * 32 * 4;
constexpr size_t O_YDIR = O_DECS + (size_t)M * 32 * 4;
constexpr size_t O_YBR = O_YDIR + (size_t)2 * M * D * 2;
constexpr size_t O_MRGB = O_YBR + (size_t)3 * M * D * 2;
constexpr size_t O_VT = O_MRGB + (size_t)M * D * 2;
constexpr size_t O_BAR = O_VT + (size_t)GB * 1024 * 2304 * 2;
constexpr size_t O_YBRC = O_BAR + 16384;
constexpr size_t O_GATEC = O_YBRC + (size_t)3 * NB * CTX * D * 2;
constexpr size_t WS_END = O_GATEC + (size_t)NB * CTX * 3072 * 2;
static_assert(WS_END <= ((size_t)1 << 30), "workspace map exceeds 1 GiB");

struct Params {
    const float *x, *c, *ctx, *c_ctx, *w_ada, *b_ada, *norm1_w, *w_in, *conv_mix_w, *ssd_conv_w, *ssd_conv_b, *ssd_a_log, *ssd_dt_bias, *ssd_d, *ssd_norm_w,
        *na_rpb, *w_br_conv, *w_br_ssd, *w_br_na, *w_out, *norm2_w, *w_ff1, *w_ff2, *final_norm_w;
    float* out; unsigned char* ws;
};

typedef const __attribute__((address_space(4))) Params* CP;
__device__ __forceinline__ CP params_ptr() { unsigned long long k = (unsigned long long)__builtin_amdgcn_kernarg_segment_ptr(); asm volatile("" : "+s"(k)); return (CP)k; }
__device__ __forceinline__ int fresh_tid() { int t = threadIdx.x; asm volatile("" : "+v"(t)); return t; }
__device__ __forceinline__ float bflo(unsigned u) { return __uint_as_float(u << 16); }
__device__ __forceinline__ float bfhi(unsigned u) { return __uint_as_float(u & 0xffff0000u); }
__device__ __forceinline__ unsigned f2bf(float f) { unsigned u = __float_as_uint(f); u += 0x7FFFu + ((u >> 16) & 1u); return u >> 16; }
__device__ __forceinline__ unsigned pack2(float lo, float hi) { unsigned r; asm volatile("v_cvt_pk_bf16_f32 %0, %1, %2" : "=v"(r) : "v"(lo), "v"(hi)); return r; }
__device__ __forceinline__ void unpack8(const uint4 v, float (&f)[8]) { f[0] = bflo(v.x); f[1] = bfhi(v.x); f[2] = bflo(v.y); f[3] = bfhi(v.y); f[4] = bflo(v.z); f[5] = bfhi(v.z); f[6] = bflo(v.w); f[7] = bfhi(v.w); }
__device__ __forceinline__ uint4 pack8(const float (&f)[8]) { uint4 v; v.x = pack2(f[0], f[1]); v.y = pack2(f[2], f[3]); v.z = pack2(f[4], f[5]); v.w = pack2(f[6], f[7]); return v; }
__device__ __forceinline__ float silu_f(float v) { return v * __builtin_amdgcn_rcpf(1.f + __expf(-v)); }
__device__ __forceinline__ float sigmoid_f(float v) { return __builtin_amdgcn_rcpf(1.f + __expf(-v)); }
__device__ __forceinline__ float wave_sum(float v) { for (int o = 32; o; o >>= 1) v += __shfl_xor(v, o); return v; }

namespace pg8 {
constexpr int BM = 256, BK = 64, HALF = 128, HTB = HALF * BK * 2, STAGE_BYTES = 8 * HTB, NXCD = 8, WGM = 8;
__device__ __forceinline__ int lds_byte(int r, int c) { const int st = (r >> 4) * 2 + (c >> 5), rr = r & 15, cc = c & 31, ob = rr * 64 + cc * 2; return st * 1024 + (ob ^ (((ob >> 9) & 1) << 5)); }
__device__ __forceinline__ void stage_rc(int b, int& R, int& C) { const int st = b / 1024, sb = b % 1024, swz = sb ^ (((sb >> 9) & 1) << 5); R = (st >> 1) * 16 + swz / 64; C = (st & 1) * 32 + (swz % 64) / 2; }
__device__ __forceinline__ int perm32(int rho) { const int n = rho >> 4, i = rho & 15; return 8 * (i >> 2) + 4 * n + (i & 3); }
struct Unit { int pm, pn, z; };
struct Gemm { const bf16_t* A; const bf16_t* Bt; int M, N, K; size_t azs, bzs; };
struct StaticOrder {
    int nM, nN, nwg, G, c, nz;
    __device__ void init(int M_, int N_, int G_, int c_, int nz_) { nM = M_ / BM; nN = N_ / BM; nwg = nM * nN; G = G_; c = c_; nz = nz_; }
    __device__ bool next(int i, Unit& u) const {
        const int ti = i / nz; u.z = i - ti * nz;
        const long Lx = (long)ti * G + c; if (Lx >= nwg) return false;
        int wgid = (int)Lx; { const int q = nwg / NXCD, r = nwg % NXCD, xcd = wgid % NXCD, off = wgid / NXCD; wgid = (xcd < r ? xcd * (q + 1) : r * (q + 1) + (xcd - r) * q) + off; }
        const int nig = WGM * nN, gid = wgid / nig, fm = gid * WGM, gsz = (nM - fm) < WGM ? (nM - fm) : WGM;
        u.pm = fm + ((wgid % nig) % gsz); u.pn = (wgid % nig) / gsz; return true;
    }
};
template <class Epi>
__device__ __forceinline__ void gemm_phase(LAS unsigned char* lds, const Gemm g, const StaticOrder& S, const Epi& E) {
    const int tid = fresh_tid(), wid = __builtin_amdgcn_readfirstlane(tid >> 6), lane = tid & 63, wr = wid >> 2, wc = wid & 3, fr = lane & 15, fq = lane >> 4;
    const int K = g.K, nt = K / BK;
    unsigned voffA[2], voffB[2];
#pragma unroll
    for (int i = 0; i < 2; ++i) { int R, C; stage_rc(tid * 16 + i * 8192, R, C); const int Rb = Epi::PERM ? ((R & ~31) + perm32(R & 31)) : R;
        voffA[i] = (unsigned)(R * K + C) * 2u; voffB[i] = (unsigned)(Rb * K + C) * 2u; }
    const size_t kstep = (size_t)(BK * 2);
    const size_t hstep = (size_t)HALF * K * 2;
    const size_t tstep = 2 * hstep;
    const unsigned ldsw = (unsigned)wid * 1024u;
    const int aoff = lds_byte(wr * 64 + fr, fq * 8), boff = lds_byte(wc * 32 + fr, fq * 8);
#define PG8_SA(b, h) (((b) * 2 + (h)) * HTB)
#define PG8_SB(b, h) ((4 + (b) * 2 + (h)) * HTB)
#define PG8_STAGE(bufoff, gbase, voff) do { _Pragma("unroll") for (int _i = 0; _i < 2; ++_i) \
        __builtin_amdgcn_global_load_lds((const unsigned*)((const char*)(gbase) + (voff)[_i]), (LAS unsigned*)(lds + (bufoff) + ldsw + _i * 8192), 16, 0, 0); } while (0)
#define PG8_LDA(dst, b, h) do { _Pragma("unroll") for (int m = 0; m < 4; ++m) _Pragma("unroll") for (int k = 0; k < 2; ++k) dst[m][k] = *(const LAS bf16x8*)(lds + PG8_SA(b, h) + aoff + m * 2048 + k * 1024); } while (0)
#define PG8_LDB(dst, b, h) do { _Pragma("unroll") for (int n = 0; n < 2; ++n) _Pragma("unroll") for (int k = 0; k < 2; ++k) dst[n][k] = *(const LAS bf16x8*)(lds + PG8_SB(b, h) + boff + n * 2048 + k * 1024); } while (0)
#define PG8_MMA(ai, bj, At, Bt) do { __builtin_amdgcn_s_setprio(1); _Pragma("unroll") for (int m = 0; m < 4; ++m) _Pragma("unroll") for (int n = 0; n < 2; ++n) _Pragma("unroll") for (int k = 0; k < 2; ++k) \
        acc[ai][bj][m][n] = __builtin_amdgcn_mfma_f32_16x16x32_bf16(Bt[n][k], At[m][k], acc[ai][bj][m][n], 0, 0, 0); __builtin_amdgcn_s_setprio(0); } while (0)
#define PG8_WAIT_V(n) asm volatile("s_waitcnt vmcnt(" #n ")" ::: "memory")
#define PG8_WAIT_L(n) asm volatile("s_waitcnt lgkmcnt(" #n ")" ::: "memory")
#define PG8_BAR __builtin_amdgcn_s_barrier()
#define PG8_SCHED __builtin_amdgcn_sched_barrier(0)
    Unit cur, nxt; int ui = 0;
    if (!S.next(0, cur)) return;
    f32x4 acc[2][2][4][2];
#pragma unroll
    for (int a = 0; a < 2; ++a)
#pragma unroll
        for (int b = 0; b < 2; ++b)
#pragma unroll
            for (int m = 0; m < 4; ++m)
#pragma unroll
                for (int n = 0; n < 2; ++n) acc[a][b][m][n] = (f32x4){0.f, 0.f, 0.f, 0.f};
    bf16x8 At[4][2], B0[2][2], B1[2][2];
    const char* cA = (const char*)g.A + (size_t)cur.z * g.azs + (size_t)cur.pm * tstep; const char* cB = (const char*)g.Bt + (size_t)cur.z * g.bzs + (size_t)cur.pn * tstep;
    PG8_STAGE(PG8_SB(0, 0), cB, voffB); PG8_STAGE(PG8_SA(0, 0), cA, voffA); PG8_STAGE(PG8_SB(0, 1), cB + hstep, voffB); PG8_STAGE(PG8_SA(0, 1), cA + hstep, voffA);
    if (wr == 1) PG8_BAR;
    PG8_WAIT_V(4); PG8_BAR;
    PG8_STAGE(PG8_SB(1, 0), cB + kstep, voffB); PG8_STAGE(PG8_SA(1, 0), cA + kstep, voffA); PG8_STAGE(PG8_SB(1, 1), cB + hstep + kstep, voffB);
    PG8_WAIT_V(6); PG8_BAR;
    for (;;) {
        const bool has_next = S.next(ui + 1, nxt);
        const char* nA = has_next ? (const char*)g.A + (size_t)nxt.z * g.azs + (size_t)nxt.pm * tstep : cA; const char* nB = has_next ? (const char*)g.Bt + (size_t)nxt.z * g.bzs + (size_t)nxt.pn * tstep : cB;
        for (int t = 0; t < nt; t += 2) {
            const bool last = (t == nt - 2);
            const char* a1 = cA + (size_t)(t + 1) * kstep;
            const char* a2 = last ? nA : cA + (size_t)(t + 2) * kstep; const char* b2 = last ? nB : cB + (size_t)(t + 2) * kstep;
            const char* a3 = a2 + kstep; const char* b3 = b2 + kstep;
            PG8_LDB(B0, 0, 0); PG8_SCHED; PG8_LDA(At, 0, 0); PG8_STAGE(PG8_SA(1, 1), a1 + hstep, voffA);
            PG8_WAIT_L(8); PG8_BAR; PG8_WAIT_L(0); PG8_MMA(0, 0, At, B0); PG8_BAR; PG8_SCHED;
            PG8_LDB(B1, 0, 1); PG8_STAGE(PG8_SB(0, 0), b2, voffB);
            PG8_BAR; PG8_WAIT_L(0); PG8_MMA(0, 1, At, B1); PG8_BAR;
            PG8_LDA(At, 0, 1); PG8_STAGE(PG8_SA(0, 0), a2, voffA);
            PG8_BAR; PG8_WAIT_L(0); PG8_MMA(1, 0, At, B0); PG8_BAR; PG8_SCHED;
            PG8_STAGE(PG8_SB(0, 1), b2 + hstep, voffB);
            PG8_WAIT_V(6); PG8_BAR; PG8_MMA(1, 1, At, B1); PG8_BAR;
            PG8_LDB(B0, 1, 0); PG8_SCHED; PG8_LDA(At, 1, 0); PG8_STAGE(PG8_SA(0, 1), a2 + hstep, voffA);
            PG8_WAIT_L(8); PG8_BAR; PG8_WAIT_L(0); PG8_MMA(0, 0, At, B0); PG8_BAR; PG8_SCHED;
            PG8_LDB(B1, 1, 1); PG8_STAGE(PG8_SB(1, 0), b3, voffB);
            PG8_BAR; PG8_WAIT_L(0); PG8_MMA(0, 1, At, B1); PG8_BAR;
            PG8_LDA(At, 1, 1); PG8_STAGE(PG8_SA(1, 0), a3, voffA);
            PG8_BAR; PG8_WAIT_L(0); PG8_MMA(1, 0, At, B0); PG8_BAR; PG8_SCHED;
            PG8_STAGE(PG8_SB(1, 1), b3 + hstep, voffB);
            PG8_WAIT_V(6); PG8_BAR; PG8_MMA(1, 1, At, B1); PG8_BAR;
        }
        E(acc, cur, wr, wc, fr, fq);
        if (!has_next) break;
        if (!E.keep(cur))
#pragma unroll
        for (int a = 0; a < 2; ++a)
#pragma unroll
            for (int b = 0; b < 2; ++b)
#pragma unroll
                for (int m = 0; m < 4; ++m)
#pragma unroll
                    for (int n = 0; n < 2; ++n) acc[a][b][m][n] = (f32x4){0.f, 0.f, 0.f, 0.f};
        cur = nxt; cA = nA; cB = nB; ++ui;
    }
    PG8_WAIT_V(0);
    if (wr == 0) PG8_BAR;
    PG8_BAR;
#undef PG8_SA
#undef PG8_SB
#undef PG8_STAGE
#undef PG8_LDA
#undef PG8_LDB
#undef PG8_MMA
#undef PG8_WAIT_V
#undef PG8_WAIT_L
#undef PG8_BAR
#undef PG8_SCHED
}
}
using pg8::Unit;

struct EpiU {
    static constexpr bool PERM = true;
    __device__ __forceinline__ bool keep(const Unit&) const { return false; }
    bf16_t* U;
    __device__ __forceinline__ void operator()(f32x4 (&acc)[2][2][4][2], const Unit& u, int wr, int wc, int fr, int fq) const {
        const int row0 = u.pm * 256 + wr * 64 + fr, col0 = u.pn * 256 + wc * 32 + 8 * fq;
        const bool sg = (u.pn >= cGATE / 256) && (u.pn < cDT / 256);
#pragma unroll
        for (int ai = 0; ai < 2; ++ai)
#pragma unroll
            for (int m = 0; m < 4; ++m) { bf16_t* rowp = U + (size_t)(row0 + ai * 128 + m * 16) * UC + col0;
#pragma unroll
                for (int bj = 0; bj < 2; ++bj) { f32x4 v0 = acc[ai][bj][m][0], v1 = acc[ai][bj][m][1];
                    if (sg) {
#pragma unroll
                        for (int j = 0; j < 4; ++j) { v0[j] = sigmoid_f(v0[j]); v1[j] = sigmoid_f(v1[j]); } }
                    uint4 o; o.x = pack2(v0[0], v0[1]); o.y = pack2(v0[2], v0[3]); o.z = pack2(v1[0], v1[1]); o.w = pack2(v1[2], v1[3]);
                    *(uint4*)(rowp + bj * 128) = o; } }
    }
};
struct EpiMerge {
    static constexpr bool PERM = true;
    const bf16_t* G; int gld; bf16_t* MB;
    __device__ __forceinline__ bool keep(const Unit& u) const { return u.z < 2; }
    __device__ __forceinline__ void operator()(f32x4 (&acc)[2][2][4][2], const Unit& u, int wr, int wc, int fr, int fq) const {
        const int row0 = u.pm * 256 + wr * 64 + fr, col0 = u.pn * 256 + wc * 32 + 8 * fq;
#pragma unroll
        for (int ai = 0; ai < 2; ++ai) {
            uint4 g0[4][2], g1[4][2];
#pragma unroll
            for (int m = 0; m < 4; ++m)
#pragma unroll
                for (int bj = 0; bj < 2; ++bj) { const bf16_t* gp = G + (size_t)(row0 + ai * 128 + m * 16) * gld + u.z * 1024 + col0 + bj * 128;
                    g0[m][bj] = *(const uint4*)gp; g1[m][bj] = (u.z < 2) ? *(const uint4*)(gp + 1024) : g0[m][bj]; }
#pragma unroll
            for (int m = 0; m < 4; ++m) { const size_t row = (size_t)(row0 + ai * 128 + m * 16);
#pragma unroll
                for (int bj = 0; bj < 2; ++bj) { const int col = col0 + bj * 128;
                    float gz[8]; unpack8(g0[m][bj], gz);
                    if (u.z < 2) { float gn[8]; unpack8(g1[m][bj], gn);
#pragma unroll
                        for (int j = 0; j < 8; ++j) { const float rt = fmaxf(gz[j], 1e-20f) * __builtin_amdgcn_rcpf(fmaxf(gn[j], 1e-20f)); acc[ai][bj][m][j >> 2][j & 3] *= rt; } }
                    else { f32x4 v0 = acc[ai][bj][m][0], v1 = acc[ai][bj][m][1];
#pragma unroll
                        for (int j = 0; j < 4; ++j) { v0[j] *= fmaxf(gz[j], 1e-20f); v1[j] *= fmaxf(gz[4 + j], 1e-20f); }
                        uint4 o; o.x = pack2(v0[0], v0[1]); o.y = pack2(v0[2], v0[3]); o.z = pack2(v1[0], v1[1]); o.w = pack2(v1[2], v1[3]); *(uint4*)(MB + row * D + col) = o; } } }
        }
    }
};
struct EpiRes {
    static constexpr bool PERM = false;
    __device__ __forceinline__ bool keep(const Unit&) const { return false; }
    float* hl; float* hc; const float* gate;
    int g; float gs; int allctx; long rdel;
    __device__ __forceinline__ void operator()(f32x4 (&acc)[2][2][4][2], const Unit& u, int wr, int wc, int fr, int fq) const {
        const int lr0 = u.pm * 256; const bool isctx = allctx || lr0 >= ML;
        float* base = allctx ? hc + (size_t)lr0 * D : (isctx ? hc + (size_t)(lr0 - ML) * D : hl + (size_t)lr0 * D);
        const float* rbase = base + rdel;
        const float* gp = gate + (size_t)(isctx ? 32 : g * GB + (lr0 >> 11)) * 6144;
        const int r0 = wr * 64 + fr, col0 = u.pn * 256 + wc * 32 + 4 * fq;
        f32x4 gv[2][2];
#pragma unroll
        for (int bj = 0; bj < 2; ++bj)
#pragma unroll
            for (int n = 0; n < 2; ++n) gv[bj][n] = *(const f32x4*)(gp + col0 + bj * 128 + n * 16) * gs;
#pragma unroll
        for (int ai = 0; ai < 2; ++ai) {
            f32x4 hv[4][2][2];
#pragma unroll
            for (int m = 0; m < 4; ++m)
#pragma unroll
                for (int bj = 0; bj < 2; ++bj)
#pragma unroll
                    for (int n = 0; n < 2; ++n) hv[m][bj][n] = *(const f32x4*)(rbase + (size_t)(r0 + ai * 128 + m * 16) * D + col0 + bj * 128 + n * 16);
#pragma unroll
            for (int m = 0; m < 4; ++m)
#pragma unroll
                for (int bj = 0; bj < 2; ++bj)
#pragma unroll
                    for (int n = 0; n < 2; ++n) *(f32x4*)(base + (size_t)(r0 + ai * 128 + m * 16) * D + col0 + bj * 128 + n * 16) = hv[m][bj][n] + gv[bj][n] * acc[ai][bj][m][n];
        }
    }
};
struct EpiFF1 {
    static constexpr bool PERM = true;
    __device__ __forceinline__ bool keep(const Unit&) const { return false; }
    bf16_t* H;
    __device__ __forceinline__ void operator()(f32x4 (&acc)[2][2][4][2], const Unit& u, int wr, int wc, int fr, int fq) const {
        const int row0 = u.pm * 256 + wr * 64 + fr, col0 = u.pn * 256 + wc * 32 + 8 * fq;
#pragma unroll
        for (int ai = 0; ai < 2; ++ai)
#pragma unroll
            for (int m = 0; m < 4; ++m) { bf16_t* rowp = H + (size_t)(row0 + ai * 128 + m * 16) * 4096 + col0;
#pragma unroll
                for (int bj = 0; bj < 2; ++bj) { f32x4 v0 = acc[ai][bj][m][0], v1 = acc[ai][bj][m][1];
#pragma unroll
                    for (int j = 0; j < 4; ++j) { const float a = fmaxf(v0[j], 0.f), b = fmaxf(v1[j], 0.f); v0[j] = a * a; v1[j] = b * b; }
                    uint4 o; o.x = pack2(v0[0], v0[1]); o.y = pack2(v0[2], v0[3]); o.z = pack2(v1[0], v1[1]); o.w = pack2(v1[2], v1[3]);
                    *(uint4*)(rowp + bj * 128) = o; } }
    }
};

__device__ __forceinline__ int w_in_src_col(int j) { return j < 5632 ? j : (j < 11776 ? j + 32 : (j < 11808 ? j - 11776 + 5632 : -1)); }

__device__ void transpose_weight(const float* __restrict__ W, int ld, int Kd, int Nout, bool mapped, bf16_t* __restrict__ Wt, float* lds) {
    const int tid = fresh_tid(); const int tn = Nout / 256, tk = Kd / 64;
    constexpr int P = 257;
    for (int t = blockIdx.x; t < tn * tk; t += gridDim.x) {
        const int n0 = (t % tn) * 256, k0 = (t / tn) * 64;
        __syncthreads();
#pragma unroll
        for (int i = 0; i < 8; ++i) { const int idx = i * 512 + tid, kk = idx >> 6, nn = (idx & 63) * 4; const int sc = mapped ? w_in_src_col(n0 + nn) : n0 + nn;
            const float4 v = sc >= 0 ? *(const float4*)(W + (size_t)(k0 + kk) * ld + sc) : make_float4(0.f, 0.f, 0.f, 0.f);
            float* d = lds + kk * P + nn; d[0] = v.x; d[1] = v.y; d[2] = v.z; d[3] = v.w; }
        __syncthreads();
#pragma unroll
        for (int i = 0; i < 4; ++i) { const int idx = i * 512 + tid, nn = idx >> 3, kp = (idx & 7) * 8;
            float f[8];
#pragma unroll
            for (int j = 0; j < 8; ++j) f[j] = lds[(kp + j) * P + nn];
            *(uint4*)(Wt + (size_t)(n0 + nn) * Kd + k0 + kp) = pack8(f); }
    }
}

__device__ void phase_prep(CP p, float* lds) {
    unsigned char* ws = p->ws; const int tid = fresh_tid();
    for (int l = 0; l < 2; ++l) {
        transpose_weight(p->w_in + (size_t)l * D * IN_COLS, IN_COLS, D, UC, true, (bf16_t*)(ws + O_WIN + l * SZ_WIN), lds);
        transpose_weight(p->w_br_conv + (size_t)l * D * D, D, D, D, false, (bf16_t*)(ws + O_WBR + l * SZ_WBR), lds);
        transpose_weight(p->w_br_ssd + (size_t)l * D * D, D, D, D, false, (bf16_t*)(ws + O_WBR + l * SZ_WBR) + (size_t)D * D, lds);
        transpose_weight(p->w_br_na + (size_t)l * D * D, D, D, D, false, (bf16_t*)(ws + O_WBR + l * SZ_WBR) + (size_t)2 * D * D, lds);
        transpose_weight(p->w_out + (size_t)l * D * D, D, D, D, false, (bf16_t*)(ws + O_WOUT + l * SZ_WOUT), lds);
        transpose_weight(p->w_ff1 + (size_t)l * D * 4096, 4096, D, 4096, false, (bf16_t*)(ws + O_WFF1 + l * SZ_WFF), lds);
        transpose_weight(p->w_ff2 + (size_t)l * 4096 * D, D, 4096, D, false, (bf16_t*)(ws + O_WFF2 + l * SZ_WFF), lds);
    }
    {
        float* tab = (float*)(ws + O_ROPE);
        for (int i = blockIdx.x * 512 + tid; i < 2048 * 32; i += gridDim.x * 512) {
            const int t = i >> 5, j = i & 31, ii = j & 15; const int pos = (j < 16) ? (t >> 6) : (t & 63);
            const float inv = powf(10000.0f, -(float)(2 * ii) / 32.0f); const float ang = (float)pos * inv;
            tab[t * 64 + j] = cosf(ang); tab[t * 64 + 32 + j] = sinf(ang);
        }
    }
    float* mod = (float*)(ws + O_MOD);
    for (int job = blockIdx.x; job < 2 * 96; job += gridDim.x) {
        const int l = job / 96, j0 = (job % 96) * 64;
        __syncthreads();
        for (int i = tid; i < 32 * 1024; i += 512) lds[i] = silu_f(p->c[i]);
        __syncthreads();
        const int col = tid & 63, kp = tid >> 6;
        float acc[33];
#pragma unroll
        for (int r = 0; r < 33; ++r) acc[r] = 0.f;
        const float* wp = p->w_ada + (size_t)l * D * 6144 + j0 + col;
        for (int k = kp * 128; k < kp * 128 + 128; ++k) {
            const float wv = wp[(size_t)k * 6144];
#pragma unroll
            for (int r = 0; r < 32; ++r) acc[r] += lds[r * 1024 + k] * wv;
            acc[32] += silu_f(p->c_ctx[k]) * wv;
        }
        __syncthreads();
#pragma unroll
        for (int r = 0; r < 33; ++r) lds[(kp * 33 + r) * 64 + col] = acc[r];
        __syncthreads();
        for (int i = tid; i < 33 * 64; i += 512) { const int r = i >> 6, cc = i & 63; float s = 0.f;
#pragma unroll
            for (int q = 0; q < 8; ++q) s += lds[(q * 33 + r) * 64 + cc];
            mod[((size_t)l * 33 + r) * 6144 + j0 + cc] = s + p->b_ada[l * 6144 + j0 + cc]; }
    }
}

__device__ void phase_norm(CP p, int g, int l, int which, int Mrows, bool ctxall) {
    unsigned char* ws = p->ws; const int tid_ = fresh_tid(); const int lane = tid_ & 63, gw = blockIdx.x * 8 + (tid_ >> 6), nw = gridDim.x * 8;
    const bool first = (l == 0 && which == 0);
    const float* nwt = (which ? p->norm2_w : p->norm1_w) + l * D;
    const float* mod = (const float*)(ws + O_MOD) + (size_t)l * 33 * 6144 + which * 3072;
    bf16_t* AN = (bf16_t*)(ws + O_AN);
    float4 wv[4];
#pragma unroll
    for (int j = 0; j < 4; ++j) wv[j] = *(const float4*)(nwt + j * 256 + lane * 4);
    auto src_of = [&](int lr) -> const float* {
        const bool isctx = ctxall || lr >= ML;
        const size_t grow = ctxall ? (size_t)lr : (isctx ? (size_t)g * MC + (lr - ML) : (size_t)g * ML + lr);
        return (first ? (isctx ? p->ctx : p->x) : (isctx ? (const float*)(ws + O_HC) : (const float*)p->out)) + grow * D;
    };
    float4 v[4], nx[4];
    if (gw < Mrows) { const float* src = src_of(gw);
#pragma unroll
        for (int j = 0; j < 4; ++j) v[j] = *(const float4*)(src + j * 256 + lane * 4); }
    for (int lr = gw; lr < Mrows; lr += nw) {
        if (lr + nw < Mrows) { const float* src = src_of(lr + nw);
#pragma unroll
            for (int j = 0; j < 4; ++j) nx[j] = *(const float4*)(src + j * 256 + lane * 4); }
        const bool isctx = ctxall || lr >= ML;
        const float* mr = mod + (size_t)(isctx ? 32 : g * GB + (lr >> 11)) * 6144;
        float ss = 0.f;
#pragma unroll
        for (int j = 0; j < 4; ++j) ss += v[j].x * v[j].x + v[j].y * v[j].y + v[j].z * v[j].z + v[j].w * v[j].w;
        ss = wave_sum(ss);
        const float rs = rsqrtf(ss * (1.f / 1024.f) + EPS);
#pragma unroll
        for (int j = 0; j < 4; ++j) {
            const int col = j * 256 + lane * 4;
            const float4 w = wv[j], sh = *(const float4*)(mr + col), sc = *(const float4*)(mr + 1024 + col);
            uint2 o; o.x = pack2(v[j].x * rs * w.x * (1.f + sc.x) + sh.x, v[j].y * rs * w.y * (1.f + sc.y) + sh.y);
            o.y = pack2(v[j].z * rs * w.z * (1.f + sc.z) + sh.z, v[j].w * rs * w.w * (1.f + sc.w) + sh.w);
            *(uint2*)(AN + (size_t)lr * D + col) = o;
        }
#pragma unroll
        for (int j = 0; j < 4; ++j) v[j] = nx[j];
    }
}

__device__ void phase_mixprep(CP p, int g, int l, bool last, bool do_qk) {
    unsigned char* ws = p->ws; const int tid_ = fresh_tid(); const int lane = tid_ & 63, gw = blockIdx.x * 8 + (tid_ >> 6), nw = gridDim.x * 8;
    bf16_t* U = (bf16_t*)(ws + O_U); bf16_t* XB = (bf16_t*)(ws + O_XBCS); float* DTS = (float*)(ws + O_DTS); float* DECS = (float*)(ws + O_DECS);
    bf16_t* YC = (bf16_t*)(ws + O_YBR); const float* tab = (const float*)(ws + O_ROPE);
    const float* cw = p->conv_mix_w + (size_t)l * 3 * D; const float* sw = p->ssd_conv_w + (size_t)l * 3 * XW; const float* sb = p->ssd_conv_b + (size_t)l * XW;
    const int RP = (M + nw - 1) / nw; const int lr0 = gw * RP, lr1 = min(lr0 + RP, M);
    {
        float wv[2][3][8], pcx[2][8], ccx[2][8], ncx[2][8];
#pragma unroll
        for (int j = 0; j < 2; ++j)
#pragma unroll
            for (int k = 0; k < 3; ++k)
#pragma unroll
                for (int i = 0; i < 8; ++i) wv[j][k][i] = cw[k * D + (lane + 64 * j) * 8 + i];
        auto load_cx = [&](int lr, float (&cx)[2][8]) {
            if (lr < 0 || lr >= M) {
#pragma unroll
                for (int i = 0; i < 8; ++i) { cx[0][i] = 0.f; cx[1][i] = 0.f; }
                return; }
            const bf16_t* u = U + (size_t)lr * UC;
#pragma unroll
            for (int j = 0; j < 2; ++j) { const int ch = (lane + 64 * j) * 8; float c8[8], x8[8]; unpack8(*(const uint4*)(u + cCC + ch), c8); unpack8(*(const uint4*)(u + cCX + ch), x8);
#pragma unroll
                for (int i = 0; i < 8; ++i) cx[j][i] = c8[i] * x8[i]; }
        };
        if (lr0 < M) { load_cx(lr0 - 1, pcx); load_cx(lr0, ccx); }
        for (int lr = lr0; lr < lr1; ++lr) {
            load_cx(lr + 1, ncx);
            const bool isctx = lr >= ML; const int t = isctx ? ((lr - ML) & 255) : (lr & 2047); const int Ls = isctx ? 256 : 2048;
            const float mp = t > 0 ? 1.f : 0.f, mn = t < Ls - 1 ? 1.f : 0.f;
            if (!(isctx && last)) {
                const bf16_t* u0 = U + (size_t)lr * UC;
#pragma unroll
                for (int j = 0; j < 2; ++j) { const int ch = (lane + 64 * j) * 8;
                    float cb[8]; unpack8(*(const uint4*)(u0 + cCB + ch), cb);
                    float o[8];
#pragma unroll
                    for (int i = 0; i < 8; ++i) o[i] = cb[i] * (wv[j][0][i] * (pcx[j][i] * mp) + wv[j][1][i] * ccx[j][i] + wv[j][2][i] * (ncx[j][i] * mn));
                    bf16_t* yo = isctx ? (bf16_t*)(ws + O_YBRC) + ((size_t)g * MC + (lr - ML)) * D : YC + (size_t)lr * D;
                    *(uint4*)(yo + ch) = pack8(o); }
            }
#pragma unroll
            for (int i = 0; i < 8; ++i)
#pragma unroll
                for (int j = 0; j < 2; ++j) { pcx[j][i] = ccx[j][i]; ccx[j][i] = ncx[j][i]; }
        }
    }
    float sv[3][4][8], pxb[3][8], cxb[3][8], nxb[3][8];
#pragma unroll
    for (int j = 0; j < 3; ++j)
#pragma unroll
        for (int i = 0; i < 8; ++i) { const int ch = (lane + 64 * j) * 8 + i; sv[j][0][i] = sw[ch]; sv[j][1][i] = sw[XW + ch]; sv[j][2][i] = sw[2 * XW + ch]; sv[j][3][i] = sb[ch]; }
    auto load_xb = [&](int lr, float (&xb)[3][8]) {
        if (lr < 0 || lr >= M) {
#pragma unroll
            for (int i = 0; i < 8; ++i) { xb[0][i] = 0.f; xb[1][i] = 0.f; xb[2][i] = 0.f; }
            return; }
        const bf16_t* u = U + (size_t)lr * UC;
#pragma unroll
        for (int j = 0; j < 3; ++j) unpack8(*(const uint4*)(u + cXBC + (lane + 64 * j) * 8), xb[j]);
    };
    if (lr0 < M) { load_xb(lr0 - 1, pxb); load_xb(lr0, cxb); }
    for (int lr = lr0; lr < lr1; ++lr) {
        load_xb(lr + 1, nxb);
        const bool isctx = lr >= ML; const int t = isctx ? ((lr - ML) & 255) : (lr & 2047); const int Ls = isctx ? 256 : 2048;
        const float mp = t > 0 ? 1.f : 0.f, mn = t < Ls - 1 ? 1.f : 0.f;
        bf16_t* u0 = U + (size_t)lr * UC;
#pragma unroll
        for (int j = 0; j < 3; ++j) { const int ch = (lane + 64 * j) * 8; float o[8];
#pragma unroll
            for (int i = 0; i < 8; ++i) o[i] = silu_f(sv[j][3][i] + sv[j][0][i] * (pxb[j][i] * mp) + sv[j][1][i] * cxb[j][i] + sv[j][2][i] * (nxb[j][i] * mn));
            *(uint4*)(XB + (size_t)lr * XW + ch) = pack8(o); }
#pragma unroll
        for (int i = 0; i < 8; ++i)
#pragma unroll
            for (int j = 0; j < 3; ++j) { pxb[j][i] = cxb[j][i]; cxb[j][i] = nxb[j][i]; }
        if (lane < 32) {
            const float raw = bflo((unsigned)u0[cDT + lane]) + p->ssd_dt_bias[l * 32 + lane];
            const float dt = fmaxf(raw, 0.f) + log1pf(__expf(-fabsf(raw)));
            const float A = -__expf(p->ssd_a_log[l * 32 + lane]);
            DTS[(size_t)lr * 32 + lane] = dt; DECS[(size_t)lr * 32 + lane] = dt * A;
        }
        if (do_qk) {
            const int hd = lane >> 2, i0 = (lane & 3) * 4;
            float cr[4], cc[4], sr[4], sc[4];
#pragma unroll
            for (int i = 0; i < 4; ++i) { cr[i] = 1.f; cc[i] = 1.f; sr[i] = 0.f; sc[i] = 0.f; }
            if (!isctx) { const float* tb = tab + t * 64;
#pragma unroll
                for (int i = 0; i < 4; ++i) { cr[i] = tb[i0 + i]; cc[i] = tb[16 + i0 + i]; sr[i] = tb[32 + i0 + i]; sc[i] = tb[48 + i0 + i]; } }
#pragma unroll
            for (int qk = 0; qk < 2; ++qk) {
                if (qk == 1 && isctx) break;
                bf16_t* base = u0 + (qk ? cK : cQ) + hd * 64 + i0; const float scl = qk ? 1.f : 0.125f;
                const uint2 v0 = *(const uint2*)(base), v1 = *(const uint2*)(base + 16), v2 = *(const uint2*)(base + 32), v3 = *(const uint2*)(base + 48);
                const float a[4] = {bflo(v0.x), bfhi(v0.x), bflo(v0.y), bfhi(v0.y)}, b[4] = {bflo(v1.x), bfhi(v1.x), bflo(v1.y), bfhi(v1.y)};
                const float c2[4] = {bflo(v2.x), bfhi(v2.x), bflo(v2.y), bfhi(v2.y)}, d2[4] = {bflo(v3.x), bfhi(v3.x), bflo(v3.y), bfhi(v3.y)};
                float oa[4], ob[4], oc[4], od[4];
#pragma unroll
                for (int i = 0; i < 4; ++i) { oa[i] = (a[i] * cr[i] - b[i] * sr[i]) * scl; ob[i] = (b[i] * cr[i] + a[i] * sr[i]) * scl;
                    oc[i] = (c2[i] * cc[i] - d2[i] * sc[i]) * scl; od[i] = (d2[i] * cc[i] + c2[i] * sc[i]) * scl; }
                *(uint2*)(base) = make_uint2(pack2(oa[0], oa[1]), pack2(oa[2], oa[3])); *(uint2*)(base + 16) = make_uint2(pack2(ob[0], ob[1]), pack2(ob[2], ob[3]));
                *(uint2*)(base + 32) = make_uint2(pack2(oc[0], oc[1]), pack2(oc[2], oc[3])); *(uint2*)(base + 48) = make_uint2(pack2(od[0], od[1]), pack2(od[2], od[3]));
            }
        }
    }
}

__device__ void phase_scan(CP p, bool ctx_out, unsigned char* ldsb) {
    unsigned char* ws = p->ws; const int tid = fresh_tid(); const int lane = tid & 63, w = tid >> 6, fr = lane & 15, fq = lane >> 4;
    const int lt = w < 4 ? w : 11 - w;
    const bf16_t* XB = (const bf16_t*)(ws + O_XBCS); const float* DTS = (const float*)(ws + O_DTS); const float* AS = (const float*)(ws + O_DECS);
    bf16_t* YD = (bf16_t*)(ws + O_YDIR);
    constexpr int PT = 136;
    bf16_t* XT = (bf16_t*)ldsb; bf16_t* BT = XT + 64 * PT; bf16_t* HL = BT + 128 * PT; bf16_t* BR = HL + 64 * PT; float* CUM = (float*)(BR + 128 * PT);
    typedef unsigned u32x4 __attribute__((ext_vector_type(4)));
    for (int item = blockIdx.x; item < GB * 32; item += gridDim.x) {
        const int dir = item & 1, head = (item >> 1) & 15, bl = item >> 5, grp = head >> 3;
        auto row_of = [&](int s) -> int { return s < 256 ? (ML + bl * 256 + (dir ? 255 - s : s)) : (bl * 2048 + (dir ? 2047 - (s - 256) : (s - 256))); };
        f32x4 hacc[4];
#pragma unroll
        for (int i = 0; i < 4; ++i) hacc[i] = (f32x4){0.f, 0.f, 0.f, 0.f};
        __syncthreads();
        for (int i = tid; i < 64 * PT / 2; i += 512) ((unsigned*)HL)[i] = 0u;
        uint4 rx[2], rb[4]; float rdt[2], ra[2];
        auto load_chunk = [&](int ch) {
#pragma unroll
            for (int q = 0; q < 2; ++q) { const int lr = row_of(ch * 128 + 2 * lane + q); const bf16_t* row = XB + (size_t)lr * XW;
                rx[q] = *(const uint4*)(row + head * 64 + w * 8); rb[2 * q] = *(const uint4*)(row + 1024 + grp * 128 + w * 16); rb[2 * q + 1] = *(const uint4*)(row + 1024 + grp * 128 + w * 16 + 8);
                rdt[q] = DTS[(size_t)lr * 32 + dir * 16 + head]; ra[q] = AS[(size_t)lr * 32 + dir * 16 + head]; }
        };
        load_chunk(0);
        for (int ch = 0; ch < 18; ++ch) {
            const bool doy = ctx_out || ch >= 2;
            const int lrl = row_of(ch * 128 + 16 * lt + fr);
            bf16x8 cf[4];
            if (doy) { const bf16_t* cp = XB + (size_t)lrl * XW + 1280 + grp * 128 + fq * 8;
#pragma unroll
                for (int k = 0; k < 4; ++k) cf[k] = *(const bf16x8*)(cp + k * 32); }
            const float ps = ra[0] + ra[1]; float incl = ps;
#pragma unroll
            for (int o = 1; o < 64; o <<= 1) { const float t = __shfl_up(incl, o); if (lane >= o) incl += t; }
            const float c0 = incl - ra[1], c1 = incl, total = __shfl(incl, 63);
            const float w0 = __expf(total - c0), w1 = __expf(total - c1), dec_total = __expf(total);
            if (w == 0) { CUM[2 * lane] = c0; CUM[2 * lane + 1] = c1; }
            { float x0[8], x1[8]; unpack8(rx[0], x0); unpack8(rx[1], x1);
#pragma unroll
              for (int i = 0; i < 8; ++i) ((unsigned*)(XT + (w * 8 + i) * PT))[lane] = pack2(x0[i] * rdt[0], x1[i] * rdt[1]); }
#pragma unroll
            for (int q = 0; q < 2; ++q) { *(uint4*)(BR + (2 * lane + q) * PT + w * 16) = rb[2 * q]; *(uint4*)(BR + (2 * lane + q) * PT + w * 16 + 8) = rb[2 * q + 1]; }
#pragma unroll
            for (int hh = 0; hh < 2; ++hh) { float b0[8], b1[8]; unpack8(rb[hh], b0); unpack8(rb[2 + hh], b1);
#pragma unroll
                for (int i = 0; i < 8; ++i) ((unsigned*)(BT + (w * 16 + hh * 8 + i) * PT))[lane] = pack2(b0[i] * w0, b1[i] * w1); }
            __syncthreads();
            if (ch + 1 < 18) load_chunk(ch + 1);
            if (doy) {
                const float cl = CUM[16 * lt + fr]; const float ecl = __expf(cl);
                f32x4 yacc[4];
#pragma unroll
                for (int pt = 0; pt < 4; ++pt) { f32x4 acc = (f32x4){0.f, 0.f, 0.f, 0.f};
#pragma unroll
                    for (int k = 0; k < 4; ++k) acc = __builtin_amdgcn_mfma_f32_16x16x32_bf16(*(const bf16x8*)(HL + (pt * 16 + fr) * PT + k * 32 + fq * 8), cf[k], acc, 0, 0, 0);
                    yacc[pt] = acc * ecl; }
                const int lidx = 16 * lt + fr;
#pragma unroll
                for (int sb = 0; sb < 4; ++sb) if (sb <= (lt >> 1)) {
                    f32x4 gt[2];
#pragma unroll
                    for (int t = 0; t < 2; ++t) { const int srow = sb * 32 + (fr >> 2) * 8 + t * 4 + (fr & 3);
                        const bf16_t* bp = BR + srow * PT + fq * 8; f32x4 acc = (f32x4){0.f, 0.f, 0.f, 0.f};
#pragma unroll
                        for (int k = 0; k < 4; ++k) acc = __builtin_amdgcn_mfma_f32_16x16x32_bf16(*(const bf16x8*)(bp + k * 32), cf[k], acc, 0, 0, 0);
                        gt[t] = acc; }
                    const float4 cs0 = *(const float4*)(CUM + sb * 32 + fq * 8), cs1 = *(const float4*)(CUM + sb * 32 + fq * 8 + 4);
                    const float csv[8] = {cs0.x, cs0.y, cs0.z, cs0.w, cs1.x, cs1.y, cs1.z, cs1.w};
                    float e[8];
#pragma unroll
                    for (int i = 0; i < 8; ++i) { const int sidx = sb * 32 + fq * 8 + i; e[i] = sidx <= lidx ? gt[i >> 2][i & 3] * __expf(fminf(cl - csv[i], 0.f)) : 0.f; }
                    const u32x4 pk = {pack2(e[0], e[1]), pack2(e[2], e[3]), pack2(e[4], e[5]), pack2(e[6], e[7])};
                    const bf16x8 pb = __builtin_bit_cast(bf16x8, pk);
#pragma unroll
                    for (int pt = 0; pt < 4; ++pt) yacc[pt] = __builtin_amdgcn_mfma_f32_16x16x32_bf16(*(const bf16x8*)(XT + (pt * 16 + fr) * PT + sb * 32 + fq * 8), pb, yacc[pt], 0, 0, 0);
                }
                bf16_t* op = YD + ((size_t)dir * M + lrl) * D + head * 64 + fq * 4;
#pragma unroll
                for (int pt = 0; pt < 4; ++pt) *(uint2*)(op + pt * 16) = make_uint2(pack2(yacc[pt][0], yacc[pt][1]), pack2(yacc[pt][2], yacc[pt][3]));
            }
#pragma unroll
            for (int pt = 0; pt < 4; ++pt) hacc[pt] *= dec_total;
#pragma unroll
            for (int k = 0; k < 4; ++k) { const bf16x8 bfr = *(const bf16x8*)(BT + (16 * w + fr) * PT + k * 32 + fq * 8);
#pragma unroll
                for (int pt = 0; pt < 4; ++pt) hacc[pt] = __builtin_amdgcn_mfma_f32_16x16x32_bf16(*(const bf16x8*)(XT + (pt * 16 + fr) * PT + k * 32 + fq * 8), bfr, hacc[pt], 0, 0, 0); }
            __syncthreads();
#pragma unroll
            for (int pt = 0; pt < 4; ++pt)
#pragma unroll
                for (int j = 0; j < 4; ++j) HL[(pt * 16 + fq * 4 + j) * PT + 16 * w + fr] = (bf16_t)f2bf(hacc[pt][j]);
        }
    }
}

__device__ void phase_vtrans(CP p, unsigned* lds) {
    unsigned char* ws = p->ws; const int tid = fresh_tid();
    const bf16_t* U = (const bf16_t*)(ws + O_U); bf16_t* VT = (bf16_t*)(ws + O_VT);
    constexpr int P = 130;
    uint4 tv[4];
    auto tile_load = [&](int tile) {
        const int cg4 = tile & 3, tt = (tile >> 2) % 36, bl = tile / 144;
        const int row0 = tt < 32 ? bl * 2048 + tt * 64 : ML + bl * 256 + (tt - 32) * 64;
#pragma unroll
        for (int i = 0; i < 4; ++i) { const int idx = i * 512 + tid, rr = idx >> 5, ck = idx & 31; tv[i] = *(const uint4*)(U + (size_t)(row0 + rr) * UC + cV + cg4 * 256 + ck * 8); }
    };
    if ((int)blockIdx.x < GB * 36 * 4) tile_load(blockIdx.x);
    for (int tile = blockIdx.x; tile < GB * 36 * 4; tile += gridDim.x) {
        const int cg4 = tile & 3, tt = (tile >> 2) % 36, bl = tile / 144;
        __syncthreads();
#pragma unroll
        for (int i = 0; i < 4; ++i) { const int idx = i * 512 + tid, rr = idx >> 5, ck = idx & 31; const uint4 v = tv[i];
            *(uint2*)(lds + rr * P + ck * 4) = make_uint2(v.x, v.y); *(uint2*)(lds + rr * P + ck * 4 + 2) = make_uint2(v.z, v.w); }
        __syncthreads();
        if (tile + (int)gridDim.x < GB * 36 * 4) tile_load(tile + gridDim.x);
        const unsigned short* l16 = (const unsigned short*)lds;
#pragma unroll
        for (int k = 0; k < 4; ++k) { const int col = (tid >> 3) + 64 * k, tg = tid & 7;
            unsigned w[4];
#pragma unroll
            for (int i = 0; i < 4; ++i) { const unsigned lo = l16[(tg * 8 + 2 * i) * (2 * P) + col], hi = l16[(tg * 8 + 2 * i + 1) * (2 * P) + col]; w[i] = lo | (hi << 16); }
            const int head = cg4 * 4 + (col >> 6), d = col & 63;
            *(uint4*)(VT + ((size_t)((bl * 16 + head) * 64 + d)) * 2304 + tt * 64 + tg * 8) = make_uint4(w[0], w[1], w[2], w[3]); }
    }
}

constexpr int ATT_KP = 72, ATT_VP = 264;
constexpr int ATT_LK = 0, ATT_LV = ATT_LK + 256 * ATT_KP * 2, ATT_LB = ATT_LV + 64 * ATT_VP * 2;
constexpr int ATT_KB = 72704;
constexpr int ATT_LDS_END = ATT_KB + 9 * 64 * 128;
__device__ __forceinline__ int att_kb_off(int key, int c) { const int f = ((key >> 1) & 1) | (((key >> 3) & 3) << 1); return key * 128 + ((c ^ f) << 4); }

template <bool MASK>
__device__ __forceinline__ void attn_chunk(const bf16x8 (&kc)[2][2][2], const bf16x8 (&vv)[2][4], const bf16x8 q0, const bf16x8 q1, f32x4 (&oacc)[4], float& mrun, float& lrun,
                                           const float* rpl, int dr0, int w0, int c, int cs, int fq) {
    f32x4 sc[2][2];
#pragma unroll
    for (int b = 0; b < 2; ++b) {
#pragma unroll
        for (int t = 0; t < 2; ++t) { f32x4 a = (f32x4){0.f, 0.f, 0.f, 0.f};
            a = __builtin_amdgcn_mfma_f32_16x16x32_bf16(kc[b][t][0], q0, a, 0, 0, 0);
            a = __builtin_amdgcn_mfma_f32_16x16x32_bf16(kc[b][t][1], q1, a, 0, 0, 0);
            sc[b][t] = a; }
        if (MASK) {
            const int dr = dr0 + b * 31;
#pragma unroll
            for (int t = 0; t < 2; ++t)
#pragma unroll
                for (int j = 0; j < 4; ++j) { const int kcol = w0 + fq * 8 + t * 4 + j; const bool ok = (unsigned)(kcol - cs) < 16u; const int dci = ok ? kcol - c + 15 : 15;
                    const float bias = rpl[dr + dci]; sc[b][t][j] = ok ? sc[b][t][j] + bias : -1e30f; }
        }
    }
    float mx = -1e30f;
#pragma unroll
    for (int b = 0; b < 2; ++b)
#pragma unroll
        for (int t = 0; t < 2; ++t)
#pragma unroll
            for (int j = 0; j < 4; ++j) mx = fmaxf(mx, sc[b][t][j]);
    mx = fmaxf(mx, __shfl_xor(mx, 16)); mx = fmaxf(mx, __shfl_xor(mx, 32));
    const float mnew = fmaxf(mrun, mx), corr = __expf(mrun - mnew);
    lrun *= corr; mrun = mnew;
#pragma unroll
    for (int i = 0; i < 4; ++i) oacc[i] *= corr;
#pragma unroll
    for (int b = 0; b < 2; ++b) {
        float e[8];
#pragma unroll
        for (int t = 0; t < 2; ++t)
#pragma unroll
            for (int j = 0; j < 4; ++j) { e[t * 4 + j] = __expf(sc[b][t][j] - mnew); lrun += e[t * 4 + j]; }
        const u32x4_t pk = {pack2(e[0], e[1]), pack2(e[2], e[3]), pack2(e[4], e[5]), pack2(e[6], e[7])};
        const bf16x8 pb = __builtin_bit_cast(bf16x8, pk);
#pragma unroll
        for (int dt = 0; dt < 4; ++dt) oacc[dt] = __builtin_amdgcn_mfma_f32_16x16x32_bf16(vv[b][dt], pb, oacc[dt], 0, 0, 0);
    }
}

template <bool LAT>
__device__ __forceinline__ void attn_wave_item(const bf16_t* __restrict__ U, const bf16_t* __restrict__ VT, bf16_t* __restrict__ YN, const unsigned char* ldsb,
                                               int bl, int head, int r, int jq, int lane, int rb0) {
    const int fr = lane & 15, fq = lane >> 4;
    const float* rpl = (const float*)(ldsb + ATT_LB);
    int lrq0, r0 = 0, w0 = 0, c = 0, cs = 0;
    if (LAT) { lrq0 = bl * 2048 + r * 64 + jq * 16; r0 = min(max(r - 4, 0), 24); w0 = jq == 0 ? 0 : (jq == 1 ? 8 : (jq == 2 ? 24 : 32)); c = jq * 16 + fr; cs = min(max(c - 8, 0), 48); }
    else lrq0 = ML + bl * 256 + jq * 16;
    const bf16_t* qp = U + (size_t)(lrq0 + fr) * UC + cQ + head * 64 + fq * 8;
    const bf16x8 q0 = *(const bf16x8*)qp, q1 = *(const bf16x8*)(qp + 32);
    f32x4 oacc[4];
#pragma unroll
    for (int i = 0; i < 4; ++i) oacc[i] = (f32x4){0.f, 0.f, 0.f, 0.f};
    float mrun = -1e30f, lrun = 0.f;
    const int kapl = (fr >> 2) * 8 + (fr & 3);
    bf16x8 kc[2][2][2], vv[2][4];
    if (LAT) {
        const bf16_t* Vh = VT + (size_t)(bl * 16 + head) * 64 * 2304;
        unsigned vov[4];
#pragma unroll
        for (int dt = 0; dt < 4; ++dt) vov[dt] = (unsigned)((fr + 16 * dt) * 2304 + fq * 8);
        unsigned vto = (unsigned)(r0 * 64 + w0);
        const unsigned vstep = 64u;
        const unsigned char* KB = ldsb + ATT_KB;
#pragma unroll 1
        for (int ch = 0; ch < 4; ++ch) {
#pragma unroll
            for (int b = 0; b < 2; ++b)
#pragma unroll
                for (int dt = 0; dt < 4; ++dt) vv[b][dt] = *(const bf16x8*)(Vh + (vto + b * vstep + vov[dt]));
            vto += 2 * vstep;
#pragma unroll
            for (int b = 0; b < 2; ++b)
#pragma unroll
                for (int t = 0; t < 2; ++t) { const int key = (r0 - rb0 + ch * 2 + b) * 64 + w0 + kapl + 4 * t;
                    kc[b][t][0] = *(const bf16x8*)(KB + att_kb_off(key, fq)); kc[b][t][1] = *(const bf16x8*)(KB + att_kb_off(key, fq + 4)); }
            attn_chunk<true>(kc, vv, q0, q1, oacc, mrun, lrun, rpl, (r0 + ch * 2 - r + 7) * 31, w0, c, cs, fq);
        }
    }
    const bf16_t* LK = (const bf16_t*)(ldsb + ATT_LK) + kapl * ATT_KP + fq * 8;
    const bf16_t* LV = (const bf16_t*)(ldsb + ATT_LV) + fr * ATT_VP + fq * 8;
#pragma unroll 1
    for (int ch = 0; ch < 4; ++ch) {
#pragma unroll
        for (int b = 0; b < 2; ++b) {
#pragma unroll
            for (int t = 0; t < 2; ++t) { const bf16_t* kp = LK + ((ch * 2 + b) * 32 + 4 * t) * ATT_KP; kc[b][t][0] = *(const bf16x8*)kp; kc[b][t][1] = *(const bf16x8*)(kp + 32); }
#pragma unroll
            for (int dt = 0; dt < 4; ++dt) vv[b][dt] = *(const bf16x8*)(LV + dt * 16 * ATT_VP + (ch * 2 + b) * 32);
        }
        attn_chunk<false>(kc, vv, q0, q1, oacc, mrun, lrun, rpl, 0, 0, 0, 0, fq);
    }
    lrun += __shfl_xor(lrun, 16); lrun += __shfl_xor(lrun, 32);
    const float inv = 1.f / lrun;
    bf16_t* op = YN + (size_t)(lrq0 + fr) * D + head * 64 + fq * 4;
#pragma unroll
    for (int dt = 0; dt < 4; ++dt) *(uint2*)(op + dt * 16) = make_uint2(pack2(oacc[dt][0] * inv, oacc[dt][1] * inv), pack2(oacc[dt][2] * inv, oacc[dt][3] * inv));
}

__device__ void phase_attn(CP p, int g, int l, bool do_ctx, unsigned char* ldsb) {
    unsigned char* ws = p->ws; const int tid = fresh_tid(); const int lane = tid & 63, wid = tid >> 6;
    const bf16_t* U = (const bf16_t*)(ws + O_U); const bf16_t* VT = (const bf16_t*)(ws + O_VT); bf16_t* YN = (bf16_t*)(ws + O_YBR) + (size_t)2 * M * D;
    const int G = gridDim.x, cb = blockIdx.x;
    const int nlat = GB * 16 * 16, nctx = do_ctx ? GB * 16 * 2 : 0;
    const int perl = (nlat + G - 1) / G, perc = (nctx + G - 1) / G;
    int cur = -1;
    for (int k = 0; k < perl + perc; ++k) {
        const bool lat = k < perl;
        const int item = lat ? cb * perl + k : cb * perc + (k - perl);
        if (item >= (lat ? nlat : nctx)) continue;
        const int bh = lat ? (item >> 4) : (item >> 1);
        const int bl = bh >> 4, head = bh & 15;
        if (bh != cur) {
            cur = bh;
            __syncthreads();
#pragma unroll
            for (int i = 0; i < 4; ++i) { const int idx = i * 512 + tid;
                { const int key = idx >> 3, part = idx & 7;
                  *(uint4*)((bf16_t*)(ldsb + ATT_LK) + key * ATT_KP + part * 8) = *(const uint4*)(U + (size_t)(ML + bl * 256 + key) * UC + cK + head * 64 + part * 8); }
                { const int d = idx >> 5, part = idx & 31;
                  *(uint4*)((bf16_t*)(ldsb + ATT_LV) + d * ATT_VP + part * 8) = *(const uint4*)(VT + ((size_t)(bh * 64 + d)) * 2304 + 2048 + part * 8); } }
            if (tid < 465) ((float*)(ldsb + ATT_LB))[tid] = p->na_rpb[(size_t)(l * 16 + head) * 465 + tid];
            __syncthreads();
        }
        if (lat) {
            const int rp = item & 15, rb0 = min(max(2 * rp - 4, 0), 24);
            __syncthreads();
#pragma unroll
            for (int i = 0; i < 9; ++i) { const int idx = i * 512 + tid, key = idx >> 3, cc = idx & 7; const int brow = rb0 + (key >> 6);
                if (brow < 32) *(uint4*)(ldsb + ATT_KB + att_kb_off(key, cc)) = *(const uint4*)(U + (size_t)(bl * 2048 + brow * 64 + (key & 63)) * UC + cK + head * 64 + cc * 8); }
            __syncthreads();
            attn_wave_item<true>(U, VT, YN, ldsb, bl, head, rp * 2 + (wid >> 2), wid & 3, lane, rb0);
        }
        else attn_wave_item<false>(U, VT, (bf16_t*)(ws + O_YBRC) + ((size_t)2 * NCTX + (size_t)g * MC) * D - (size_t)ML * D, ldsb, bl, head, 0, (item & 1) * 8 + wid, lane, 0);
    }
}

__device__ void phase_ssdfin(CP p, int g, int l, int Mrows) {
    unsigned char* ws = p->ws; const int tid_ = fresh_tid(); const int lane = tid_ & 63, gw = blockIdx.x * 8 + (tid_ >> 6), nw = gridDim.x * 8;
    const bf16_t* U = (const bf16_t*)(ws + O_U); const bf16_t* XB = (const bf16_t*)(ws + O_XBCS); const bf16_t* YD = (const bf16_t*)(ws + O_YDIR);
    bf16_t* YS = (bf16_t*)(ws + O_YBR) + (size_t)M * D;
    const int head = lane >> 2; const float dsum = p->ssd_d[l * 32 + head] + p->ssd_d[l * 32 + 16 + head];
    float nwr[16];
#pragma unroll
    for (int i = 0; i < 16; ++i) nwr[i] = p->ssd_norm_w[l * D + lane * 16 + i];
    uint4 cu[2][4], nx[2][4];
    auto load_in = [&](int lr, uint4 (&d)[2][4]) {
#pragma unroll
        for (int j = 0; j < 2; ++j) { const int ch = lane * 16 + j * 8;
            d[j][0] = *(const uint4*)(YD + (size_t)lr * D + ch); d[j][1] = *(const uint4*)(YD + ((size_t)M + lr) * D + ch);
            d[j][2] = *(const uint4*)(XB + (size_t)lr * XW + ch); d[j][3] = *(const uint4*)(U + (size_t)lr * UC + cZ + ch); }
    };
    if (gw < Mrows) load_in(gw, cu);
    for (int lr = gw; lr < Mrows; lr += nw) {
        if (lr + nw < Mrows) load_in(lr + nw, nx);
        float v[16]; float ss = 0.f;
#pragma unroll
        for (int j = 0; j < 2; ++j) {
            float y0[8], y1[8], xs[8], z[8];
            unpack8(cu[j][0], y0); unpack8(cu[j][1], y1); unpack8(cu[j][2], xs); unpack8(cu[j][3], z);
#pragma unroll
            for (int i = 0; i < 8; ++i) { const float t = (y0[i] + y1[i] + xs[i] * dsum) * silu_f(z[i]); v[j * 8 + i] = t; ss += t * t; } }
#pragma unroll
        for (int o = 16; o; o >>= 1) ss += __shfl_xor(ss, o);
        const float rs = rsqrtf(ss * (1.f / 512.f) + EPS);
#pragma unroll
        for (int j = 0; j < 2; ++j) { const int ch = lane * 16 + j * 8; float o8[8];
#pragma unroll
            for (int i = 0; i < 8; ++i) o8[i] = v[j * 8 + i] * rs * nwr[j * 8 + i];
            bf16_t* yo = lr >= ML ? (bf16_t*)(ws + O_YBRC) + ((size_t)NCTX + (size_t)g * MC + (lr - ML)) * D : YS + (size_t)lr * D;
            *(uint4*)(yo + ch) = pack8(o8); }
        if (lr >= ML) {
            const bf16_t* gs_ = U + (size_t)lr * UC + cGATE; bf16_t* gd = (bf16_t*)(ws + O_GATEC) + ((size_t)g * MC + (lr - ML)) * 3072;
#pragma unroll
            for (int j = 0; j < 6; ++j) *(uint4*)(gd + (j * 64 + lane) * 8) = *(const uint4*)(gs_ + (j * 64 + lane) * 8);
        }
#pragma unroll
        for (int j = 0; j < 2; ++j)
#pragma unroll
            for (int k = 0; k < 4; ++k) cu[j][k] = nx[j][k];
    }
}

__device__ void phase_final(CP p, int g) {
    const int tid_ = fresh_tid(); const int lane = tid_ & 63, gw = blockIdx.x * 8 + (tid_ >> 6), nw = gridDim.x * 8;
    float4 wv[4], v[4], nx[4];
#pragma unroll
    for (int j = 0; j < 4; ++j) wv[j] = *(const float4*)(p->final_norm_w + j * 256 + lane * 4);
    float* base = p->out + (size_t)g * ML * D;
    if (gw < ML) {
#pragma unroll
        for (int j = 0; j < 4; ++j) v[j] = *(const float4*)(base + (size_t)gw * D + j * 256 + lane * 4); }
    for (int lr = gw; lr < ML; lr += nw) {
        float* hrow = base + (size_t)lr * D;
        if (lr + nw < ML) {
#pragma unroll
            for (int j = 0; j < 4; ++j) nx[j] = *(const float4*)(hrow + (size_t)nw * D + j * 256 + lane * 4); }
        float ss = 0.f;
#pragma unroll
        for (int j = 0; j < 4; ++j) ss += v[j].x * v[j].x + v[j].y * v[j].y + v[j].z * v[j].z + v[j].w * v[j].w;
        ss = wave_sum(ss);
        const float rs = rsqrtf(ss * (1.f / 1024.f) + EPS);
#pragma unroll
        for (int j = 0; j < 4; ++j) { const int col = j * 256 + lane * 4; const float4 w = wv[j];
            *(float4*)(hrow + col) = make_float4(v[j].x * rs * w.x, v[j].y * rs * w.y, v[j].z * rs * w.z, v[j].w * rs * w.w); }
#pragma unroll
        for (int j = 0; j < 4; ++j) v[j] = nx[j];
    }
}

#define XB_TMO      128
#define XB_XCNT(j)  (256  + 64 * (j))
#define XB_XSUB(j)  (1280 + 64 * (j))
#define XB_XGEN(j)  (2304 + 64 * (j))
#define XB_TOP      3328
#define XB_TOPGEN   3392
#define XCD_BAR_WORDS 3456
#define XB_SPIN_CAP (1u << 20)
__device__ __forceinline__ unsigned xb_ld(unsigned* p)              { return __hip_atomic_load(p, __ATOMIC_RELAXED, __HIP_MEMORY_SCOPE_AGENT); }
__device__ __forceinline__ unsigned xb_add(unsigned* p, unsigned v) { return __hip_atomic_fetch_add(p, v, __ATOMIC_RELAXED, __HIP_MEMORY_SCOPE_AGENT); }
__device__ __forceinline__ unsigned xb_xcc_id() { return (unsigned)__builtin_amdgcn_s_getreg((3 << 11) | 20) & 0xFu; }
#define XB_SPIN(cond, bar) do { unsigned _sp = 0; while (cond) { __builtin_amdgcn_s_sleep(1); \
    if ((++_sp & 255u) == 0u) { if (xb_ld(&(bar)[XB_TMO])) break; if (_sp > XB_SPIN_CAP) { atomicAdd(&(bar)[XB_TMO], 1u); break; } } } } while (0)
struct XcdBarrier { unsigned* bar; unsigned x; volatile LAS unsigned* st; };
__device__ __forceinline__ XcdBarrier xcd_barrier_post(unsigned* bar, volatile LAS unsigned* st) {
    XcdBarrier b; b.bar = bar; b.x = xb_xcc_id(); b.st = st;
    if (threadIdx.x == 0) (void)xb_add(&bar[XB_XCNT(b.x)], 1u);
    return b;
}
__device__ __forceinline__ void xcd_barrier_complete(unsigned* bar, unsigned x, unsigned& nloc, unsigned& nx) {
    const unsigned G = gridDim.x * gridDim.y * gridDim.z;
    unsigned sum, cnt, mine, sp = 0u;
    for (;;) {
        sum = 0u; cnt = 0u; mine = 0u;
#pragma unroll
        for (unsigned j = 0; j < 16; ++j) { const unsigned c = xb_ld(&bar[XB_XCNT(j)]); sum += c; cnt += (c > 0u) ? 1u : 0u; mine = (j == x) ? c : mine; }
        if (sum == G) break;
        __builtin_amdgcn_s_sleep(1);
        if ((++sp & 255u) == 0u) { if (xb_ld(&bar[XB_TMO])) break; if (sp > XB_SPIN_CAP) { atomicAdd(&bar[XB_TMO], 1u); break; } }
    }
    nloc = mine > 0u ? mine : 1u; nx = cnt > 0u ? cnt : 1u;
}
__device__ __forceinline__ void xcd_barrier(const XcdBarrier& b) {
    asm volatile("s_waitcnt vmcnt(0)" ::: "memory");
    __syncthreads();
    if (threadIdx.x == 0) {
        unsigned* bar = b.bar;
        __builtin_amdgcn_s_waitcnt(0);
        unsigned nloc = b.st[0], nx = b.st[1];
        if (nloc == 0u) { xcd_barrier_complete(bar, b.x, nloc, nx); b.st[0] = nloc; b.st[1] = nx; }
        const unsigned old = xb_add(&bar[XB_XSUB(b.x)], 1u);
        const unsigned gen = old / nloc;
        if (old + 1u == (gen + 1u) * nloc) {
            __builtin_amdgcn_fence(__ATOMIC_RELEASE, "agent");
            asm volatile("s_waitcnt vmcnt(0)" ::: "memory");
            const unsigned og = xb_add(&bar[XB_TOP], 1u);
            const unsigned tg = og / nx;
            if (og + 1u == (tg + 1u) * nx) xb_add(&bar[XB_TOPGEN], 1u);
            else XB_SPIN(xb_ld(&bar[XB_TOPGEN]) == tg, bar);
            __builtin_amdgcn_fence(__ATOMIC_ACQUIRE, "agent");
            xb_add(&bar[XB_XGEN(b.x)], 1u);
            asm volatile("s_waitcnt vmcnt(0)" ::: "memory");
        } else {
            XB_SPIN(xb_ld(&bar[XB_XGEN(b.x)]) == gen, bar);
            __builtin_amdgcn_fence(__ATOMIC_ACQUIRE, "agent");
            asm volatile("s_waitcnt vmcnt(0)" ::: "memory");
        }
    }
    __syncthreads();
}
#define GSYNC() do { xcd_barrier(xb); if (PROBE_DUP == 20) xcd_barrier(xb); } while (0)
__global__ void __launch_bounds__(512, 2) fwd_megakernel(Params p_unused) {
    extern __shared__ __attribute__((aligned(16))) unsigned char shm[];
    cg::grid_group grid = cg::this_grid();
    float* ldsf = (float*)shm; LAS unsigned char* ldsg = (LAS unsigned char*)shm;
    __shared__ uint4 xb_words;
    if (threadIdx.x == 0) xb_words = make_uint4(0u, 0u, 0u, 0u);
    __syncthreads();
    const XcdBarrier xb = xcd_barrier_post((unsigned*)(params_ptr()->ws + O_BAR), (volatile LAS unsigned*)&xb_words);
    DUP(1, phase_prep(params_ptr(), ldsf););
    grid.sync();
    for (int l = 0; l < 2; ++l) {
        const bool last = (l == 1);
        for (int g = 0; g < NG + (last ? 0 : 1); ++g) {
            const bool cchain = (g == NG);
            if (!cchain) {
                if (g == 0) {
                    DUP(2, phase_norm(params_ptr(), g, l, 0, M, false););
                    GSYNC();
                }
                DUP(3, { CP p = params_ptr(); unsigned char* ws = p->ws; const int G = gridDim.x, cb = blockIdx.x;
                  pg8::Gemm gm{(const bf16_t*)(ws + O_AN), (const bf16_t*)(ws + O_WIN + l * SZ_WIN), M, UC, D, 0, 0};
                  pg8::StaticOrder S; S.init(M, UC, G, cb, 1); EpiU E{(bf16_t*)(ws + O_U)}; pg8::gemm_phase(ldsg, gm, S, E); });
                GSYNC();
                DUP(12, phase_mixprep(params_ptr(), g, l, last, rep_ == 0););
                DUP(4, phase_vtrans(params_ptr(), (unsigned*)shm););
                GSYNC();
                DUP(5, phase_scan(params_ptr(), !last, shm););
                DUP(6, phase_attn(params_ptr(), g, l, !last, shm););
                GSYNC();
                DUP(7, phase_ssdfin(params_ptr(), g, l, last ? ML : M););
                GSYNC();
            }
            const int Mr = cchain ? NCTX : ML;
            DUP(8, { CP p = params_ptr(); unsigned char* ws = p->ws; const int G = gridDim.x, cb = blockIdx.x;
              pg8::Gemm gm{(const bf16_t*)(ws + (cchain ? O_YBRC : O_YBR)), (const bf16_t*)(ws + O_WBR + l * SZ_WBR), Mr, D, D, (size_t)(cchain ? NCTX : M) * D * 2, (size_t)D * D * 2};
              pg8::StaticOrder S; S.init(Mr, D, G, cb, 3);
              EpiMerge E{cchain ? (const bf16_t*)(ws + O_GATEC) : (const bf16_t*)(ws + O_U) + cGATE, cchain ? 3072 : UC, (bf16_t*)(ws + O_MRGB)}; pg8::gemm_phase(ldsg, gm, S, E); });
            GSYNC();
            DUP(9, { CP p = params_ptr(); unsigned char* ws = p->ws; const int G = gridDim.x, cb = blockIdx.x;
              const float* modl = (const float*)(ws + O_MOD) + (size_t)l * 33 * 6144;
              float* hl = p->out + (size_t)g * ML * D; float* hc = (float*)(ws + O_HC) + (cchain ? (size_t)0 : (size_t)g * MC * D);
              pg8::Gemm gm{(const bf16_t*)(ws + O_MRGB), (const bf16_t*)(ws + O_WOUT + l * SZ_WOUT), Mr, D, D, 0, 0};
              pg8::StaticOrder S; S.init(Mr, D, G, cb, 1); EpiRes E{hl, hc, modl + 2048, g, rep_ == 0 ? 1.f : 0.f, cchain ? 1 : 0, (l == 0 && rep_ == 0) ? (cchain ? (long)(p->ctx - hc) : (long)((p->x + (size_t)g * ML * D) - hl)) : 0L}; pg8::gemm_phase(ldsg, gm, S, E); });
            GSYNC();
            DUP(10, phase_norm(params_ptr(), g, l, 1, Mr, cchain););
            GSYNC();
            DUP(11, { CP p = params_ptr(); unsigned char* ws = p->ws; const int G = gridDim.x, cb = blockIdx.x;
              pg8::Gemm gm{(const bf16_t*)(ws + O_AN), (const bf16_t*)(ws + O_WFF1 + l * SZ_WFF), Mr, 4096, D, 0, 0};
              pg8::StaticOrder S; S.init(Mr, 4096, G, cb, 1); EpiFF1 E{(bf16_t*)(ws + O_U)}; pg8::gemm_phase(ldsg, gm, S, E); });
            GSYNC();
            DUP(13, { CP p = params_ptr(); unsigned char* ws = p->ws; const int G = gridDim.x, cb = blockIdx.x;
              const float* modl = (const float*)(ws + O_MOD) + (size_t)l * 33 * 6144;
              float* hl = p->out + (size_t)g * ML * D; float* hc = (float*)(ws + O_HC) + (cchain ? (size_t)0 : (size_t)g * MC * D);
              pg8::Gemm gm{(const bf16_t*)(ws + O_U), (const bf16_t*)(ws + O_WFF2 + l * SZ_WFF), Mr, D, 4096, 0, 0};
              pg8::StaticOrder S; S.init(Mr, D, G, cb, 1); EpiRes E{hl, hc, modl + 5120, g, rep_ == 0 ? 1.f : 0.f, cchain ? 1 : 0, 0L}; pg8::gemm_phase(ldsg, gm, S, E); });
            if (g + 1 < NG) phase_norm(params_ptr(), g + 1, l, 0, M, false);
            GSYNC();
        }
    }
    for (int g = 0; g < NG; ++g) phase_final(params_ptr(), g);
}

extern "C" void kernel_launch(void* const* d_in, const int* in_sizes, int n_in, void* d_out, int out_size, void* d_ws, size_t ws_size, hipStream_t stream) {
    constexpr size_t kDynLds = 155648;
    static_assert(ATT_LDS_END <= 155648, "attention LDS image too large");
    static int grid_blocks = 0;
    if (grid_blocks == 0) {
        if (n_in != 24 || ws_size < WS_END) { fprintf(stderr, "kernel_launch: need 24 inputs and %zu bytes of workspace, got %d / %zu\n", (size_t)WS_END, n_in, ws_size); grid_blocks = -1; return; }
        int dev = 0, cus = 0, per_cu = 0;
        (void)hipGetDevice(&dev);
        (void)hipDeviceGetAttribute(&cus, hipDeviceAttributeMultiprocessorCount, dev);
        (void)hipFuncSetAttribute((const void*)fwd_megakernel, hipFuncAttributeMaxDynamicSharedMemorySize, (int)kDynLds);
        (void)hipOccupancyMaxActiveBlocksPerMultiprocessor(&per_cu, (const void*)fwd_megakernel, 512, kDynLds);
        if (per_cu < 1) per_cu = 1;
        grid_blocks = cus * per_cu;
        (void)hipGetLastError();
    }
    if (grid_blocks < 0) return;
    Params p{};
    const float** pp = (const float**)&p;
    for (int i = 0; i < 24; ++i) pp[i] = (const float*)d_in[i];
    p.out = (float*)d_out; p.ws = (unsigned char*)d_ws;
    (void)hipMemsetAsync((unsigned char*)d_ws + O_BAR, 0, 16384, stream);
    void* args[] = {&p};
    hipError_t e = hipLaunchCooperativeKernel((void*)fwd_megakernel, dim3(grid_blocks), dim3(512), args, kDynLds, stream);
    if (e != hipSuccess) fprintf(stderr, "cooperative launch failed: %s (grid %d)\n", hipGetErrorString(e), grid_blocks);
}
```

```cpp
#include <hip/hip_runtime.h>
#include <hip/hip_cooperative_groups.h>
#include <cstdio>
namespace cg = cooperative_groups;
#ifndef PROBE_DUP
#define PROBE_DUP 0
#endif
#define DUP(n, ...) do { _Pragma("nounroll") for (int rep_ = 0; rep_ < ((PROBE_DUP == (n)) ? 2 : 1); ++rep_) { __VA_ARGS__ } } while (0)

#define LAS __attribute__((address_space(3)))
typedef unsigned short bf16_t;
typedef short bf16x8 __attribute__((ext_vector_type(8)));
typedef float f32x4 __attribute__((ext_vector_type(4)));
typedef unsigned u32x4_t __attribute__((ext_vector_type(4)));

constexpr int D = 1024, NB = 32, L = 2048, CTX = 256;
constexpr int GB = 8, NG = NB / GB, ML = GB * L, MC = GB * CTX, M = ML + MC;
constexpr int UC = 12032, IN_COLS = 11808;
constexpr int cCB = 0, cCC = 1024, cCX = 2048, cZ = 3072, cXBC = 4096, cQ = 5632, cK = 6656, cV = 7680, cGATE = 8704, cDT = 11776;
constexpr int XW = 1536, NCTX = NB * CTX;
constexpr float EPS = 1e-6f;

constexpr size_t SZ_WIN = (size_t)UC * D * 2, SZ_WBR = (size_t)3 * D * D * 2, SZ_WOUT = (size_t)D * D * 2, SZ_WFF = (size_t)4 * D * D * 2;
constexpr size_t O_WIN = 0;
constexpr size_t O_WBR = O_WIN + 2 * SZ_WIN;
constexpr size_t O_WOUT = O_WBR + 2 * SZ_WBR;
constexpr size_t O_WFF1 = O_WOUT + 2 * SZ_WOUT;
constexpr size_t O_WFF2 = O_WFF1 + 2 * SZ_WFF;
constexpr size_t O_HC = O_WFF2 + 2 * SZ_WFF;
constexpr size_t O_MOD = O_HC + (size_t)NB * CTX * D * 4;
constexpr size_t O_ROPE = O_MOD + (size_t)2 * 33 * 6144 * 4 + 256 * 3;
constexpr size_t O_AN = O_ROPE + (size_t)2048 * 64 * 4;
constexpr size_t O_U = O_AN + (size_t)M * D * 2;
constexpr size_t O_XBCS = O_U + (size_t)M * UC * 2;
constexpr size_t O_DTS = O_XBCS + (size_t)M * XW * 2;
constexpr size_t O_DECS = O_DTS + (size_t)M * 32 * 4;
constexpr size_t O_YDIR = O_DECS + (size_t)M * 32 * 4;
constexpr size_t O_YBR = O_YDIR + (size_t)2 * M * D * 2;
constexpr size_t O_MRGB = O_YBR + (size_t)3 * M * D * 2;
constexpr size_t O_VT = O_MRGB + (size_t)M * D * 2;
constexpr size_t O_BAR = O_VT + (size_t)GB * 1024 * 2304 * 2;
constexpr size_t O_YBRC = O_BAR + 16384;
constexpr size_t O_GATEC = O_YBRC + (size_t)3 * NB * CTX * D * 2;
constexpr size_t WS_END = O_GATEC + (size_t)NB * CTX * 3072 * 2;
static_assert(WS_END <= ((size_t)1 << 30), "workspace map exceeds 1 GiB");

struct Params {
    const float *x, *c, *ctx, *c_ctx, *w_ada, *b_ada, *norm1_w, *w_in, *conv_mix_w, *ssd_conv_w, *ssd_conv_b, *ssd_a_log, *ssd_dt_bias, *ssd_d, *ssd_norm_w,
        *na_rpb, *w_br_conv, *w_br_ssd, *w_br_na, *w_out, *norm2_w, *w_ff1, *w_ff2, *final_norm_w;
    float* out; unsigned char* ws;
};

typedef const __attribute__((address_space(4))) Params* CP;
__device__ __forceinline__ CP params_ptr() { unsigned long long k = (unsigned long long)__builtin_amdgcn_kernarg_segment_ptr(); asm volatile("" : "+s"(k)); return (CP)k; }
__device__ __forceinline__ int fresh_tid() { int t = threadIdx.x; asm volatile("" : "+v"(t)); return t; }
__device__ __forceinline__ float bflo(unsigned u) { return __uint_as_float(u << 16); }
__device__ __forceinline__ float bfhi(unsigned u) { return __uint_as_float(u & 0xffff0000u); }
__device__ __forceinline__ unsigned f2bf(float f) { unsigned u = __float_as_uint(f); u += 0x7FFFu + ((u >> 16) & 1u); return u >> 16; }
__device__ __forceinline__ unsigned pack2(float lo, float hi) { unsigned r; asm volatile("v_cvt_pk_bf16_f32 %0, %1, %2" : "=v"(r) : "v"(lo), "v"(hi)); return r; }
__device__ __forceinline__ void unpack8(const uint4 v, float (&f)[8]) { f[0] = bflo(v.x); f[1] = bfhi(v.x); f[2] = bflo(v.y); f[3] = bfhi(v.y); f[4] = bflo(v.z); f[5] = bfhi(v.z); f[6] = bflo(v.w); f[7] = bfhi(v.w); }
__device__ __forceinline__ uint4 pack8(const float (&f)[8]) { uint4 v; v.x = pack2(f[0], f[1]); v.y = pack2(f[2], f[3]); v.z = pack2(f[4], f[5]); v.w = pack2(f[6], f[7]); return v; }
__device__ __forceinline__ float silu_f(float v) { return v * __builtin_amdgcn_rcpf(1.f + __expf(-v)); }
__device__ __forceinline__ float sigmoid_f(float v) { return __builtin_amdgcn_rcpf(1.f + __expf(-v)); }
__device__ __forceinline__ float x32_max(float v) { const auto r = __builtin_amdgcn_permlane32_swap(__float_as_uint(v), __float_as_uint(v), false, false); return fmaxf(__uint_as_float(r[0]), __uint_as_float(r[1])); }
__device__ __forceinline__ float x16_max(float v) { const auto r = __builtin_amdgcn_permlane16_swap(__float_as_uint(v), __float_as_uint(v), false, false); return fmaxf(__uint_as_float(r[0]), __uint_as_float(r[1])); }
__device__ __forceinline__ float x32_sum(float v) { const auto r = __builtin_amdgcn_permlane32_swap(__float_as_uint(v), __float_as_uint(v), false, false); return __uint_as_float(r[0]) + __uint_as_float(r[1]); }
__device__ __forceinline__ float x16_sum(float v) { const auto r = __builtin_amdgcn_permlane16_swap(__float_as_uint(v), __float_as_uint(v), false, false); return __uint_as_float(r[0]) + __uint_as_float(r[1]); }
__device__ __forceinline__ float wave_sum(float v) { v = x32_sum(v); v = x16_sum(v); for (int o = 8; o; o >>= 1) v += __shfl_xor(v, o); return v; }

namespace pg8 {
constexpr int BM = 256, BK = 64, HALF = 128, HTB = HALF * BK * 2, STAGE_BYTES = 8 * HTB, NXCD = 8, WGM = 8;
__device__ __forceinline__ int lds_byte(int r, int c) { const int st = (r >> 4) * 2 + (c >> 5), rr = r & 15, cc = c & 31, ob = rr * 64 + cc * 2; return st * 1024 + (ob ^ (((ob >> 9) & 1) << 5)); }
__device__ __forceinline__ void stage_rc(int b, int& R, int& C) { const int st = b / 1024, sb = b % 1024, swz = sb ^ (((sb >> 9) & 1) << 5); R = (st >> 1) * 16 + swz / 64; C = (st & 1) * 32 + (swz % 64) / 2; }
__device__ __forceinline__ int perm32(int rho) { const int n = rho >> 4, i = rho & 15; return 8 * (i >> 2) + 4 * n + (i & 3); }
struct Unit { int pm, pn, z; };
struct Gemm { const bf16_t* A; const bf16_t* Bt; int M, N, K; size_t azs, bzs; };
struct StaticOrder {
    int nM, nN, nwg, G, c, nz;
    __device__ void init(int M_, int N_, int G_, int c_, int nz_) { nM = M_ / BM; nN = N_ / BM; nwg = nM * nN; G = G_; c = c_; nz = nz_; }
    __device__ bool next(int i, Unit& u) const {
        const int ti = i / nz; u.z = i - ti * nz;
        const long Lx = (long)ti * G + c; if (Lx >= nwg) return false;
        int wgid = (int)Lx; { const int q = nwg / NXCD, r = nwg % NXCD, xcd = wgid % NXCD, off = wgid / NXCD; wgid = (xcd < r ? xcd * (q + 1) : r * (q + 1) + (xcd - r) * q) + off; }
        const int nig = WGM * nN, gid = wgid / nig, fm = gid * WGM, gsz = (nM - fm) < WGM ? (nM - fm) : WGM;
        u.pm = fm + ((wgid % nig) % gsz); u.pn = (wgid % nig) / gsz; return true;
    }
};
template <class Epi>
__device__ __forceinline__ void gemm_phase(LAS unsigned char* lds, const Gemm g, const StaticOrder& S, const Epi& E) {
    const int tid = fresh_tid(), wid = __builtin_amdgcn_readfirstlane(tid >> 6), lane = tid & 63, wr = wid >> 2, wc = wid & 3, fr = lane & 15, fq = lane >> 4;
    const int K = g.K, nt = K / BK;
    unsigned voffA[2], voffB[2];
#pragma unroll
    for (int i = 0; i < 2; ++i) { int R, C; stage_rc(tid * 16 + i * 8192, R, C); const int Rb = Epi::PERM ? ((R & ~31) + perm32(R & 31)) : R;
        voffA[i] = (unsigned)(R * K + C) * 2u; voffB[i] = (unsigned)(Rb * K + C) * 2u; }
    const size_t kstep = (size_t)(BK * 2);
    const size_t hstep = (size_t)HALF * K * 2;
    const size_t tstep = 2 * hstep;
    const unsigned ldsw = (unsigned)wid * 1024u;
    const int aoff = lds_byte(wr * 64 + fr, fq * 8), boff = lds_byte(wc * 32 + fr, fq * 8);
#define PG8_SA(b, h) (((b) * 2 + (h)) * HTB)
#define PG8_SB(b, h) ((4 + (b) * 2 + (h)) * HTB)
#define PG8_STAGE(bufoff, gbase, voff) do { _Pragma("unroll") for (int _i = 0; _i < 2; ++_i) \
        __builtin_amdgcn_global_load_lds((const unsigned*)((const char*)(gbase) + (voff)[_i]), (LAS unsigned*)(lds + (bufoff) + ldsw + _i * 8192), 16, 0, 0); } while (0)
#define PG8_LDA(dst, b, h) do { _Pragma("unroll") for (int m = 0; m < 4; ++m) _Pragma("unroll") for (int k = 0; k < 2; ++k) dst[m][k] = *(const LAS bf16x8*)(lds + PG8_SA(b, h) + aoff + m * 2048 + k * 1024); } while (0)
#define PG8_LDB(dst, b, h) do { _Pragma("unroll") for (int n = 0; n < 2; ++n) _Pragma("unroll") for (int k = 0; k < 2; ++k) dst[n][k] = *(const LAS bf16x8*)(lds + PG8_SB(b, h) + boff + n * 2048 + k * 1024); } while (0)
#define PG8_MMA(ai, bj, At, Bt) do { __builtin_amdgcn_s_setprio(1); _Pragma("unroll") for (int m = 0; m < 4; ++m) _Pragma("unroll") for (int n = 0; n < 2; ++n) _Pragma("unroll") for (int k = 0; k < 2; ++k) \
        acc[ai][bj][m][n] = __builtin_amdgcn_mfma_f32_16x16x32_bf16(Bt[n][k], At[m][k], acc[ai][bj][m][n], 0, 0, 0); __builtin_amdgcn_s_setprio(0); } while (0)
#define PG8_WAIT_V(n) asm volatile("s_waitcnt vmcnt(" #n ")" ::: "memory")
#define PG8_WAIT_L(n) asm volatile("s_waitcnt lgkmcnt(" #n ")" ::: "memory")
#define PG8_BAR __builtin_amdgcn_s_barrier()
#define PG8_SCHED __builtin_amdgcn_sched_barrier(0)
    Unit cur, nxt; int ui = 0;
    if (!S.next(0, cur)) return;
    f32x4 acc[2][2][4][2];
#pragma unroll
    for (int a = 0; a < 2; ++a)
#pragma unroll
        for (int b = 0; b < 2; ++b)
#pragma unroll
            for (int m = 0; m < 4; ++m)
#pragma unroll
                for (int n = 0; n < 2; ++n) acc[a][b][m][n] = (f32x4){0.f, 0.f, 0.f, 0.f};
    bf16x8 At[4][2], B0[2][2], B1[2][2];
    const char* cA = (const char*)g.A + (size_t)cur.z * g.azs + (size_t)cur.pm * tstep; const char* cB = (const char*)g.Bt + (size_t)cur.z * g.bzs + (size_t)cur.pn * tstep;
    PG8_STAGE(PG8_SB(0, 0), cB, voffB); PG8_STAGE(PG8_SA(0, 0), cA, voffA); PG8_STAGE(PG8_SB(0, 1), cB + hstep, voffB); PG8_STAGE(PG8_SA(0, 1), cA + hstep, voffA);
    if (wr == 1) PG8_BAR;
    PG8_WAIT_V(4); PG8_BAR;
    PG8_STAGE(PG8_SB(1, 0), cB + kstep, voffB); PG8_STAGE(PG8_SA(1, 0), cA + kstep, voffA); PG8_STAGE(PG8_SB(1, 1), cB + hstep + kstep, voffB);
    PG8_WAIT_V(6); PG8_BAR;
    for (;;) {
        const bool has_next = S.next(ui + 1, nxt);
        const char* nA = has_next ? (const char*)g.A + (size_t)nxt.z * g.azs + (size_t)nxt.pm * tstep : cA; const char* nB = has_next ? (const char*)g.Bt + (size_t)nxt.z * g.bzs + (size_t)nxt.pn * tstep : cB;
        for (int t = 0; t < nt; t += 2) {
            const bool last = (t == nt - 2);
            const char* a1 = cA + (size_t)(t + 1) * kstep;
            const char* a2 = last ? nA : cA + (size_t)(t + 2) * kstep; const char* b2 = last ? nB : cB + (size_t)(t + 2) * kstep;
            const char* a3 = a2 + kstep; const char* b3 = b2 + kstep;
            PG8_LDB(B0, 0, 0); PG8_SCHED; PG8_LDA(At, 0, 0); PG8_STAGE(PG8_SA(1, 1), a1 + hstep, voffA);
            PG8_WAIT_L(8); PG8_BAR; PG8_WAIT_L(0); PG8_MMA(0, 0, At, B0); PG8_BAR; PG8_SCHED;
            PG8_LDB(B1, 0, 1); PG8_STAGE(PG8_SB(0, 0), b2, voffB);
            PG8_BAR; PG8_WAIT_L(0); PG8_MMA(0, 1, At, B1); PG8_BAR;
            PG8_LDA(At, 0, 1); PG8_STAGE(PG8_SA(0, 0), a2, voffA);
            PG8_BAR; PG8_WAIT_L(0); PG8_MMA(1, 0, At, B0); PG8_BAR; PG8_SCHED;
            PG8_STAGE(PG8_SB(0, 1), b2 + hstep, voffB);
            PG8_WAIT_V(6); PG8_BAR; PG8_MMA(1, 1, At, B1); PG8_BAR;
            PG8_LDB(B0, 1, 0); PG8_SCHED; PG8_LDA(At, 1, 0); PG8_STAGE(PG8_SA(0, 1), a2 + hstep, voffA);
            PG8_WAIT_L(8); PG8_BAR; PG8_WAIT_L(0); PG8_MMA(0, 0, At, B0); PG8_BAR; PG8_SCHED;
            PG8_LDB(B1, 1, 1); PG8_STAGE(PG8_SB(1, 0), b3, voffB);
            PG8_BAR; PG8_WAIT_L(0); PG8_MMA(0, 1, At, B1); PG8_BAR;
            PG8_LDA(At, 1, 1); PG8_STAGE(PG8_SA(1, 0), a3, voffA);
            PG8_BAR; PG8_WAIT_L(0); PG8_MMA(1, 0, At, B0); PG8_BAR; PG8_SCHED;
            PG8_STAGE(PG8_SB(1, 1), b3 + hstep, voffB);
            PG8_WAIT_V(6); PG8_BAR; PG8_MMA(1, 1, At, B1); PG8_BAR;
        }
        E(acc, cur, wr, wc, fr, fq);
        if (!has_next) break;
        if (!E.keep(cur))
#pragma unroll
        for (int a = 0; a < 2; ++a)
#pragma unroll
            for (int b = 0; b < 2; ++b)
#pragma unroll
                for (int m = 0; m < 4; ++m)
#pragma unroll
                    for (int n = 0; n < 2; ++n) acc[a][b][m][n] = (f32x4){0.f, 0.f, 0.f, 0.f};
        cur = nxt; cA = nA; cB = nB; ++ui;
    }
    PG8_WAIT_V(0);
    if (wr == 0) PG8_BAR;
    PG8_BAR;
#undef PG8_SA
#undef PG8_SB
#undef PG8_STAGE
#undef PG8_LDA
#undef PG8_LDB
#undef PG8_MMA
#undef PG8_WAIT_V
#undef PG8_WAIT_L
#undef PG8_BAR
#undef PG8_SCHED
}
}
using pg8::Unit;

struct EpiU {
    static constexpr bool PERM = true;
    __device__ __forceinline__ bool keep(const Unit&) const { return false; }
    bf16_t* U;
    __device__ __forceinline__ void operator()(f32x4 (&acc)[2][2][4][2], const Unit& u, int wr, int wc, int fr, int fq) const {
        const int row0 = u.pm * 256 + wr * 64 + fr, col0 = u.pn * 256 + wc * 32 + 8 * fq;
        const bool sg = (u.pn >= cGATE / 256) && (u.pn < cDT / 256);
#pragma unroll
        for (int ai = 0; ai < 2; ++ai)
#pragma unroll
            for (int m = 0; m < 4; ++m) { bf16_t* rowp = U + (size_t)(row0 + ai * 128 + m * 16) * UC + col0;
#pragma unroll
                for (int bj = 0; bj < 2; ++bj) { f32x4 v0 = acc[ai][bj][m][0], v1 = acc[ai][bj][m][1];
                    if (sg) {
#pragma unroll
                        for (int j = 0; j < 4; ++j) { v0[j] = sigmoid_f(v0[j]); v1[j] = sigmoid_f(v1[j]); } }
                    uint4 o; o.x = pack2(v0[0], v0[1]); o.y = pack2(v0[2], v0[3]); o.z = pack2(v1[0], v1[1]); o.w = pack2(v1[2], v1[3]);
                    *(uint4*)(rowp + bj * 128) = o; } }
    }
};
struct EpiMerge {
    static constexpr bool PERM = true;
    const bf16_t* G; int gld; bf16_t* MB;
    __device__ __forceinline__ bool keep(const Unit& u) const { return u.z < 2; }
    __device__ __forceinline__ void operator()(f32x4 (&acc)[2][2][4][2], const Unit& u, int wr, int wc, int fr, int fq) const {
        const int row0 = u.pm * 256 + wr * 64 + fr, col0 = u.pn * 256 + wc * 32 + 8 * fq;
#pragma unroll
        for (int ai = 0; ai < 2; ++ai) {
            uint4 g0[4][2], g1[4][2];
#pragma unroll
            for (int m = 0; m < 4; ++m)
#pragma unroll
                for (int bj = 0; bj < 2; ++bj) { const bf16_t* gp = G + (size_t)(row0 + ai * 128 + m * 16) * gld + u.z * 1024 + col0 + bj * 128;
                    g0[m][bj] = *(const uint4*)gp; g1[m][bj] = (u.z < 2) ? *(const uint4*)(gp + 1024) : g0[m][bj]; }
#pragma unroll
            for (int m = 0; m < 4; ++m) { const size_t row = (size_t)(row0 + ai * 128 + m * 16);
#pragma unroll
                for (int bj = 0; bj < 2; ++bj) { const int col = col0 + bj * 128;
                    float gz[8]; unpack8(g0[m][bj], gz);
                    if (u.z < 2) { float gn[8]; unpack8(g1[m][bj], gn);
#pragma unroll
                        for (int j = 0; j < 8; ++j) { const float rt = fmaxf(gz[j], 1e-20f) * __builtin_amdgcn_rcpf(fmaxf(gn[j], 1e-20f)); acc[ai][bj][m][j >> 2][j & 3] *= rt; } }
                    else { f32x4 v0 = acc[ai][bj][m][0], v1 = acc[ai][bj][m][1];
#pragma unroll
                        for (int j = 0; j < 4; ++j) { v0[j] *= fmaxf(gz[j], 1e-20f); v1[j] *= fmaxf(gz[4 + j], 1e-20f); }
                        uint4 o; o.x = pack2(v0[0], v0[1]); o.y = pack2(v0[2], v0[3]); o.z = pack2(v1[0], v1[1]); o.w = pack2(v1[2], v1[3]); *(uint4*)(MB + row * D + col) = o; } } }
        }
    }
};
struct EpiRes {
    static constexpr bool PERM = false;
    __device__ __forceinline__ bool keep(const Unit&) const { return false; }
    float* hl; float* hc; const float* gate;
    int g; float gs; int allctx; long rdel;
    __device__ __forceinline__ void operator()(f32x4 (&acc)[2][2][4][2], const Unit& u, int wr, int wc, int fr, int fq) const {
        const int lr0 = u.pm * 256; const bool isctx = allctx || lr0 >= ML;
        float* base = allctx ? hc + (size_t)lr0 * D : (isctx ? hc + (size_t)(lr0 - ML) * D : hl + (size_t)lr0 * D);
        const float* rbase = base + rdel;
        const float* gp = gate + (size_t)(isctx ? 32 : g * GB + (lr0 >> 11)) * 6144;
        const int r0 = wr * 64 + fr, col0 = u.pn * 256 + wc * 32 + 4 * fq;
        f32x4 gv[2][2];
#pragma unroll
        for (int bj = 0; bj < 2; ++bj)
#pragma unroll
            for (int n = 0; n < 2; ++n) gv[bj][n] = *(const f32x4*)(gp + col0 + bj * 128 + n * 16) * gs;
#pragma unroll
        for (int ai = 0; ai < 2; ++ai) {
            f32x4 hv[4][2][2];
#pragma unroll
            for (int m = 0; m < 4; ++m)
#pragma unroll
                for (int bj = 0; bj < 2; ++bj)
#pragma unroll
                    for (int n = 0; n < 2; ++n) hv[m][bj][n] = *(const f32x4*)(rbase + (size_t)(r0 + ai * 128 + m * 16) * D + col0 + bj * 128 + n * 16);
#pragma unroll
            for (int m = 0; m < 4; ++m)
#pragma unroll
                for (int bj = 0; bj < 2; ++bj)
#pragma unroll
                    for (int n = 0; n < 2; ++n) *(f32x4*)(base + (size_t)(r0 + ai * 128 + m * 16) * D + col0 + bj * 128 + n * 16) = hv[m][bj][n] + gv[bj][n] * acc[ai][bj][m][n];
        }
    }
};
struct EpiFF1 {
    static constexpr bool PERM = true;
    __device__ __forceinline__ bool keep(const Unit&) const { return false; }
    bf16_t* H;
    __device__ __forceinline__ void operator()(f32x4 (&acc)[2][2][4][2], const Unit& u, int wr, int wc, int fr, int fq) const {
        const int row0 = u.pm * 256 + wr * 64 + fr, col0 = u.pn * 256 + wc * 32 + 8 * fq;
#pragma unroll
        for (int ai = 0; ai < 2; ++ai)
#pragma unroll
            for (int m = 0; m < 4; ++m) { bf16_t* rowp = H + (size_t)(row0 + ai * 128 + m * 16) * 4096 + col0;
#pragma unroll
                for (int bj = 0; bj < 2; ++bj) { f32x4 v0 = acc[ai][bj][m][0], v1 = acc[ai][bj][m][1];
#pragma unroll
                    for (int j = 0; j < 4; ++j) { const float a = fmaxf(v0[j], 0.f), b = fmaxf(v1[j], 0.f); v0[j] = a * a; v1[j] = b * b; }
                    uint4 o; o.x = pack2(v0[0], v0[1]); o.y = pack2(v0[2], v0[3]); o.z = pack2(v1[0], v1[1]); o.w = pack2(v1[2], v1[3]);
                    *(uint4*)(rowp + bj * 128) = o; } }
    }
};

__device__ __forceinline__ int w_in_src_col(int j) { return j < 5632 ? j : (j < 11776 ? j + 32 : (j < 11808 ? j - 11776 + 5632 : -1)); }

__device__ void transpose_weight(const float* __restrict__ W, int ld, int Kd, int Nout, bool mapped, bf16_t* __restrict__ Wt, float* lds) {
    const int tid = fresh_tid(); const int tn = Nout / 256, tk = Kd / 64;
    constexpr int P = 257;
    for (int t = blockIdx.x; t < tn * tk; t += gridDim.x) {
        const int n0 = (t % tn) * 256, k0 = (t / tn) * 64;
        __syncthreads();
#pragma unroll
        for (int i = 0; i < 8; ++i) { const int idx = i * 512 + tid, kk = idx >> 6, nn = (idx & 63) * 4; const int sc = mapped ? w_in_src_col(n0 + nn) : n0 + nn;
            const float4 v = sc >= 0 ? *(const float4*)(W + (size_t)(k0 + kk) * ld + sc) : make_float4(0.f, 0.f, 0.f, 0.f);
            float* d = lds + kk * P + nn; d[0] = v.x; d[1] = v.y; d[2] = v.z; d[3] = v.w; }
        __syncthreads();
#pragma unroll
        for (int i = 0; i < 4; ++i) { const int idx = i * 512 + tid, nn = idx >> 3, kp = (idx & 7) * 8;
            float f[8];
#pragma unroll
            for (int j = 0; j < 8; ++j) f[j] = lds[(kp + j) * P + nn];
            *(uint4*)(Wt + (size_t)(n0 + nn) * Kd + k0 + kp) = pack8(f); }
    }
}

__device__ void phase_prep(CP p, float* lds) {
    unsigned char* ws = p->ws; const int tid = fresh_tid();
    for (int l = 0; l < 2; ++l) {
        transpose_weight(p->w_in + (size_t)l * D * IN_COLS, IN_COLS, D, UC, true, (bf16_t*)(ws + O_WIN + l * SZ_WIN), lds);
        transpose_weight(p->w_br_conv + (size_t)l * D * D, D, D, D, false, (bf16_t*)(ws + O_WBR + l * SZ_WBR), lds);
        transpose_weight(p->w_br_ssd + (size_t)l * D * D, D, D, D, false, (bf16_t*)(ws + O_WBR + l * SZ_WBR) + (size_t)D * D, lds);
        transpose_weight(p->w_br_na + (size_t)l * D * D, D, D, D, false, (bf16_t*)(ws + O_WBR + l * SZ_WBR) + (size_t)2 * D * D, lds);
        transpose_weight(p->w_out + (size_t)l * D * D, D, D, D, false, (bf16_t*)(ws + O_WOUT + l * SZ_WOUT), lds);
        transpose_weight(p->w_ff1 + (size_t)l * D * 4096, 4096, D, 4096, false, (bf16_t*)(ws + O_WFF1 + l * SZ_WFF), lds);
        transpose_weight(p->w_ff2 + (size_t)l * 4096 * D, D, 4096, D, false, (bf16_t*)(ws + O_WFF2 + l * SZ_WFF), lds);
    }
    {
        float* tab = (float*)(ws + O_ROPE);
        for (int i = blockIdx.x * 512 + tid; i < 2048 * 32; i += gridDim.x * 512) {
            const int t = i >> 5, j = i & 31, ii = j & 15; const int pos = (j < 16) ? (t >> 6) : (t & 63);
            const float inv = powf(10000.0f, -(float)(2 * ii) / 32.0f); const float ang = (float)pos * inv;
            tab[t * 64 + j] = cosf(ang); tab[t * 64 + 32 + j] = sinf(ang);
        }
    }
    float* mod = (float*)(ws + O_MOD);
    for (int job = blockIdx.x; job < 2 * 96; job += gridDim.x) {
        const int l = job / 96, j0 = (job % 96) * 64;
        __syncthreads();
        for (int i = tid; i < 32 * 1024; i += 512) lds[i] = silu_f(p->c[i]);
        __syncthreads();
        const int col = tid & 63, kp = tid >> 6;
        float acc[33];
#pragma unroll
        for (int r = 0; r < 33; ++r) acc[r] = 0.f;
        const float* wp = p->w_ada + (size_t)l * D * 6144 + j0 + col;
        for (int k = kp * 128; k < kp * 128 + 128; ++k) {
            const float wv = wp[(size_t)k * 6144];
#pragma unroll
            for (int r = 0; r < 32; ++r) acc[r] += lds[r * 1024 + k] * wv;
            acc[32] += silu_f(p->c_ctx[k]) * wv;
        }
        __syncthreads();
#pragma unroll
        for (int r = 0; r < 33; ++r) lds[(kp * 33 + r) * 64 + col] = acc[r];
        __syncthreads();
        for (int i = tid; i < 33 * 64; i += 512) { const int r = i >> 6, cc = i & 63; float s = 0.f;
#pragma unroll
            for (int q = 0; q < 8; ++q) s += lds[(q * 33 + r) * 64 + cc];
            mod[((size_t)l * 33 + r) * 6144 + j0 + cc] = s + p->b_ada[l * 6144 + j0 + cc]; }
    }
}

__device__ void phase_norm(CP p, int g, int l, int which, int Mrows, bool ctxall) {
    unsigned char* ws = p->ws; const int tid_ = fresh_tid(); const int lane = tid_ & 63, gw = blockIdx.x * 8 + (tid_ >> 6), nw = gridDim.x * 8;
    const bool first = (l == 0 && which == 0);
    const float* nwt = (which ? p->norm2_w : p->norm1_w) + l * D;
    const float* mod = (const float*)(ws + O_MOD) + (size_t)l * 33 * 6144 + which * 3072;
    bf16_t* AN = (bf16_t*)(ws + O_AN);
    float4 wv[4];
#pragma unroll
    for (int j = 0; j < 4; ++j) wv[j] = *(const float4*)(nwt + j * 256 + lane * 4);
    auto src_of = [&](int lr) -> const float* {
        const bool isctx = ctxall || lr >= ML;
        const size_t grow = ctxall ? (size_t)lr : (isctx ? (size_t)g * MC + (lr - ML) : (size_t)g * ML + lr);
        return (first ? (isctx ? p->ctx : p->x) : (isctx ? (const float*)(ws + O_HC) : (const float*)p->out)) + grow * D;
    };
    float4 v[4], nx[4];
    if (gw < Mrows) { const float* src = src_of(gw);
#pragma unroll
        for (int j = 0; j < 4; ++j) v[j] = *(const float4*)(src + j * 256 + lane * 4); }
    for (int lr = gw; lr < Mrows; lr += nw) {
        if (lr + nw < Mrows) { const float* src = src_of(lr + nw);
#pragma unroll
            for (int j = 0; j < 4; ++j) nx[j] = *(const float4*)(src + j * 256 + lane * 4); }
        const bool isctx = ctxall || lr >= ML;
        const float* mr = mod + (size_t)(isctx ? 32 : g * GB + (lr >> 11)) * 6144;
        float ss = 0.f;
#pragma unroll
        for (int j = 0; j < 4; ++j) ss += v[j].x * v[j].x + v[j].y * v[j].y + v[j].z * v[j].z + v[j].w * v[j].w;
        ss = wave_sum(ss);
        const float rs = rsqrtf(ss * (1.f / 1024.f) + EPS);
#pragma unroll
        for (int j = 0; j < 4; ++j) {
            const int col = j * 256 + lane * 4;
            const float4 w = wv[j], sh = *(const float4*)(mr + col), sc = *(const float4*)(mr + 1024 + col);
            uint2 o; o.x = pack2(v[j].x * rs * w.x * (1.f + sc.x) + sh.x, v[j].y * rs * w.y * (1.f + sc.y) + sh.y);
            o.y = pack2(v[j].z * rs * w.z * (1.f + sc.z) + sh.z, v[j].w * rs * w.w * (1.f + sc.w) + sh.w);
            *(uint2*)(AN + (size_t)lr * D + col) = o;
        }
#pragma unroll
        for (int j = 0; j < 4; ++j) v[j] = nx[j];
    }
}

__device__ void phase_mixprep(CP p, int g, int l, bool last, bool do_qk) {
    unsigned char* ws = p->ws; const int tid_ = fresh_tid(); const int lane = tid_ & 63, gw = blockIdx.x * 8 + (tid_ >> 6), nw = gridDim.x * 8;
    bf16_t* U = (bf16_t*)(ws + O_U); bf16_t* XB = (bf16_t*)(ws + O_XBCS); float* DTS = (float*)(ws + O_DTS); float* DECS = (float*)(ws + O_DECS);
    bf16_t* YC = (bf16_t*)(ws + O_YBR); const float* tab = (const float*)(ws + O_ROPE);
    const float* cw = p->conv_mix_w + (size_t)l * 3 * D; const float* sw = p->ssd_conv_w + (size_t)l * 3 * XW; const float* sb = p->ssd_conv_b + (size_t)l * XW;
    const int RP = (M + nw - 1) / nw; const int lr0 = gw * RP, lr1 = min(lr0 + RP, M);
    {
        float wv[2][3][8], pcx[2][8], ccx[2][8], ncx[2][8];
#pragma unroll
        for (int j = 0; j < 2; ++j)
#pragma unroll
            for (int k = 0; k < 3; ++k)
#pragma unroll
                for (int i = 0; i < 8; ++i) wv[j][k][i] = cw[k * D + (lane + 64 * j) * 8 + i];
        auto load_cx = [&](int lr, float (&cx)[2][8]) {
            if (lr < 0 || lr >= M) {
#pragma unroll
                for (int i = 0; i < 8; ++i) { cx[0][i] = 0.f; cx[1][i] = 0.f; }
                return; }
            const bf16_t* u = U + (size_t)lr * UC;
#pragma unroll
            for (int j = 0; j < 2; ++j) { const int ch = (lane + 64 * j) * 8; float c8[8], x8[8]; unpack8(*(const uint4*)(u + cCC + ch), c8); unpack8(*(const uint4*)(u + cCX + ch), x8);
#pragma unroll
                for (int i = 0; i < 8; ++i) cx[j][i] = c8[i] * x8[i]; }
        };
        if (lr0 < M) { load_cx(lr0 - 1, pcx); load_cx(lr0, ccx); }
        for (int lr = lr0; lr < lr1; ++lr) {
            load_cx(lr + 1, ncx);
            const bool isctx = lr >= ML; const int t = isctx ? ((lr - ML) & 255) : (lr & 2047); const int Ls = isctx ? 256 : 2048;
            const float mp = t > 0 ? 1.f : 0.f, mn = t < Ls - 1 ? 1.f : 0.f;
            if (!(isctx && last)) {
                const bf16_t* u0 = U + (size_t)lr * UC;
#pragma unroll
                for (int j = 0; j < 2; ++j) { const int ch = (lane + 64 * j) * 8;
                    float cb[8]; unpack8(*(const uint4*)(u0 + cCB + ch), cb);
                    float o[8];
#pragma unroll
                    for (int i = 0; i < 8; ++i) o[i] = cb[i] * (wv[j][0][i] * (pcx[j][i] * mp) + wv[j][1][i] * ccx[j][i] + wv[j][2][i] * (ncx[j][i] * mn));
                    bf16_t* yo = isctx ? (bf16_t*)(ws + O_YBRC) + ((size_t)g * MC + (lr - ML)) * D : YC + (size_t)lr * D;
                    *(uint4*)(yo + ch) = pack8(o); }
            }
#pragma unroll
            for (int i = 0; i < 8; ++i)
#pragma unroll
                for (int j = 0; j < 2; ++j) { pcx[j][i] = ccx[j][i]; ccx[j][i] = ncx[j][i]; }
        }
    }
    float sv[3][4][8], pxb[3][8], cxb[3][8], nxb[3][8];
#pragma unroll
    for (int j = 0; j < 3; ++j)
#pragma unroll
        for (int i = 0; i < 8; ++i) { const int ch = (lane + 64 * j) * 8 + i; sv[j][0][i] = sw[ch]; sv[j][1][i] = sw[XW + ch]; sv[j][2][i] = sw[2 * XW + ch]; sv[j][3][i] = sb[ch]; }
    auto load_xb = [&](int lr, float (&xb)[3][8]) {
        if (lr < 0 || lr >= M) {
#pragma unroll
            for (int i = 0; i < 8; ++i) { xb[0][i] = 0.f; xb[1][i] = 0.f; xb[2][i] = 0.f; }
            return; }
        const bf16_t* u = U + (size_t)lr * UC;
#pragma unroll
        for (int j = 0; j < 3; ++j) unpack8(*(const uint4*)(u + cXBC + (lane + 64 * j) * 8), xb[j]);
    };
    if (lr0 < M) { load_xb(lr0 - 1, pxb); load_xb(lr0, cxb); }
    for (int lr = lr0; lr < lr1; ++lr) {
        load_xb(lr + 1, nxb);
        const bool isctx = lr >= ML; const int t = isctx ? ((lr - ML) & 255) : (lr & 2047); const int Ls = isctx ? 256 : 2048;
        const float mp = t > 0 ? 1.f : 0.f, mn = t < Ls - 1 ? 1.f : 0.f;
        bf16_t* u0 = U + (size_t)lr * UC;
#pragma unroll
        for (int j = 0; j < 3; ++j) { const int ch = (lane + 64 * j) * 8; float o[8];
#pragma unroll
            for (int i = 0; i < 8; ++i) o[i] = silu_f(sv[j][3][i] + sv[j][0][i] * (pxb[j][i] * mp) + sv[j][1][i] * cxb[j][i] + sv[j][2][i] * (nxb[j][i] * mn));
            *(uint4*)(XB + (size_t)lr * XW + ch) = pack8(o); }
#pragma unroll
        for (int i = 0; i < 8; ++i)
#pragma unroll
            for (int j = 0; j < 3; ++j) { pxb[j][i] = cxb[j][i]; cxb[j][i] = nxb[j][i]; }
        if (lane < 32) {
            const float raw = bflo((unsigned)u0[cDT + lane]) + p->ssd_dt_bias[l * 32 + lane];
            const float dt = fmaxf(raw, 0.f) + log1pf(__expf(-fabsf(raw)));
            const float A = -__expf(p->ssd_a_log[l * 32 + lane]);
            DTS[(size_t)lr * 32 + lane] = dt; DECS[(size_t)lr * 32 + lane] = dt * A;
        }
        if (do_qk) {
            const int hd = lane >> 2, i0 = (lane & 3) * 4;
            float cr[4], cc[4], sr[4], sc[4];
#pragma unroll
            for (int i = 0; i < 4; ++i) { cr[i] = 1.f; cc[i] = 1.f; sr[i] = 0.f; sc[i] = 0.f; }
            if (!isctx) { const float* tb = tab + t * 64;
#pragma unroll
                for (int i = 0; i < 4; ++i) { cr[i] = tb[i0 + i]; cc[i] = tb[16 + i0 + i]; sr[i] = tb[32 + i0 + i]; sc[i] = tb[48 + i0 + i]; } }
#pragma unroll
            for (int qk = 0; qk < 2; ++qk) {
                if (qk == 1 && isctx) break;
                bf16_t* base = u0 + (qk ? cK : cQ) + hd * 64 + i0; const float scl = qk ? 1.f : 0.125f;
                const uint2 v0 = *(const uint2*)(base), v1 = *(const uint2*)(base + 16), v2 = *(const uint2*)(base + 32), v3 = *(const uint2*)(base + 48);
                const float a[4] = {bflo(v0.x), bfhi(v0.x), bflo(v0.y), bfhi(v0.y)}, b[4] = {bflo(v1.x), bfhi(v1.x), bflo(v1.y), bfhi(v1.y)};
                const float c2[4] = {bflo(v2.x), bfhi(v2.x), bflo(v2.y), bfhi(v2.y)}, d2[4] = {bflo(v3.x), bfhi(v3.x), bflo(v3.y), bfhi(v3.y)};
                float oa[4], ob[4], oc[4], od[4];
#pragma unroll
                for (int i = 0; i < 4; ++i) { oa[i] = (a[i] * cr[i] - b[i] * sr[i]) * scl; ob[i] = (b[i] * cr[i] + a[i] * sr[i]) * scl;
                    oc[i] = (c2[i] * cc[i] - d2[i] * sc[i]) * scl; od[i] = (d2[i] * cc[i] + c2[i] * sc[i]) * scl; }
                *(uint2*)(base) = make_uint2(pack2(oa[0], oa[1]), pack2(oa[2], oa[3])); *(uint2*)(base + 16) = make_uint2(pack2(ob[0], ob[1]), pack2(ob[2], ob[3]));
                *(uint2*)(base + 32) = make_uint2(pack2(oc[0], oc[1]), pack2(oc[2], oc[3])); *(uint2*)(base + 48) = make_uint2(pack2(od[0], od[1]), pack2(od[2], od[3]));
            }
        }
    }
}

__device__ void phase_scan(CP p, bool ctx_out, unsigned char* ldsb) {
    unsigned char* ws = p->ws; const int tid = fresh_tid(); const int lane = tid & 63, w = tid >> 6, fr = lane & 15, fq = lane >> 4;
    const int lt = w < 4 ? w : 11 - w;
    const bf16_t* XB = (const bf16_t*)(ws + O_XBCS); const float* DTS = (const float*)(ws + O_DTS); const float* AS = (const float*)(ws + O_DECS);
    bf16_t* YD = (bf16_t*)(ws + O_YDIR);
    constexpr int PT = 136;
    bf16_t* XT = (bf16_t*)ldsb; bf16_t* BT = XT + 64 * PT; bf16_t* HL = BT + 128 * PT; bf16_t* BR = HL + 64 * PT; float* CUM = (float*)(BR + 128 * PT);
    typedef unsigned u32x4 __attribute__((ext_vector_type(4)));
    for (int item = blockIdx.x; item < GB * 32; item += gridDim.x) {
        const int dir = item & 1, head = (item >> 1) & 15, bl = item >> 5, grp = head >> 3;
        auto row_of = [&](int s) -> int { return s < 256 ? (ML + bl * 256 + (dir ? 255 - s : s)) : (bl * 2048 + (dir ? 2047 - (s - 256) : (s - 256))); };
        f32x4 hacc[4];
#pragma unroll
        for (int i = 0; i < 4; ++i) hacc[i] = (f32x4){0.f, 0.f, 0.f, 0.f};
        __syncthreads();
        for (int i = tid; i < 64 * PT / 2; i += 512) ((unsigned*)HL)[i] = 0u;
        uint4 rx[2], rb[4]; float rdt[2], ra[2];
        auto load_chunk = [&](int ch) {
#pragma unroll
            for (int q = 0; q < 2; ++q) { const int lr = row_of(ch * 128 + 2 * lane + q); const bf16_t* row = XB + (size_t)lr * XW;
                rx[q] = *(const uint4*)(row + head * 64 + w * 8); rb[2 * q] = *(const uint4*)(row + 1024 + grp * 128 + w * 16); rb[2 * q + 1] = *(const uint4*)(row + 1024 + grp * 128 + w * 16 + 8);
                rdt[q] = DTS[(size_t)lr * 32 + dir * 16 + head]; ra[q] = AS[(size_t)lr * 32 + dir * 16 + head]; }
        };
        load_chunk(0);
        for (int ch = 0; ch < 18; ++ch) {
            const bool doy = ctx_out || ch >= 2;
            const int lrl = row_of(ch * 128 + 16 * lt + fr);
            bf16x8 cf[4];
            if (doy) { const bf16_t* cp = XB + (size_t)lrl * XW + 1280 + grp * 128 + fq * 8;
#pragma unroll
                for (int k = 0; k < 4; ++k) cf[k] = *(const bf16x8*)(cp + k * 32); }
            const float ps = ra[0] + ra[1]; float incl = ps;
#pragma unroll
            for (int o = 1; o < 64; o <<= 1) { const float t = __shfl_up(incl, o); if (lane >= o) incl += t; }
            const float c0 = incl - ra[1], c1 = incl, total = __shfl(incl, 63);
            const float w0 = __expf(total - c0), w1 = __expf(total - c1), dec_total = __expf(total);
            if (w == 0) { CUM[2 * lane] = c0; CUM[2 * lane + 1] = c1; }
            { float x0[8], x1[8]; unpack8(rx[0], x0); unpack8(rx[1], x1);
#pragma unroll
              for (int i = 0; i < 8; ++i) ((unsigned*)(XT + (w * 8 + i) * PT))[lane] = pack2(x0[i] * rdt[0], x1[i] * rdt[1]); }
#pragma unroll
            for (int q = 0; q < 2; ++q) { *(uint4*)(BR + (2 * lane + q) * PT + w * 16) = rb[2 * q]; *(uint4*)(BR + (2 * lane + q) * PT + w * 16 + 8) = rb[2 * q + 1]; }
#pragma unroll
            for (int hh = 0; hh < 2; ++hh) { float b0[8], b1[8]; unpack8(rb[hh], b0); unpack8(rb[2 + hh], b1);
#pragma unroll
                for (int i = 0; i < 8; ++i) ((unsigned*)(BT + (w * 16 + hh * 8 + i) * PT))[lane] = pack2(b0[i] * w0, b1[i] * w1); }
            __syncthreads();
            if (ch + 1 < 18) load_chunk(ch + 1);
            if (doy) {
                const float cl = CUM[16 * lt + fr]; const float ecl = __expf(cl);
                f32x4 yacc[4];
#pragma unroll
                for (int pt = 0; pt < 4; ++pt) { f32x4 acc = (f32x4){0.f, 0.f, 0.f, 0.f};
#pragma unroll
                    for (int k = 0; k < 4; ++k) acc = __builtin_amdgcn_mfma_f32_16x16x32_bf16(*(const bf16x8*)(HL + (pt * 16 + fr) * PT + k * 32 + fq * 8), cf[k], acc, 0, 0, 0);
                    yacc[pt] = acc * ecl; }
                const int lidx = 16 * lt + fr;
#pragma unroll
                for (int sb = 0; sb < 4; ++sb) if (sb <= (lt >> 1)) {
                    f32x4 gt[2];
#pragma unroll
                    for (int t = 0; t < 2; ++t) { const int srow = sb * 32 + (fr >> 2) * 8 + t * 4 + (fr & 3);
                        const bf16_t* bp = BR + srow * PT + fq * 8; f32x4 acc = (f32x4){0.f, 0.f, 0.f, 0.f};
#pragma unroll
                        for (int k = 0; k < 4; ++k) acc = __builtin_amdgcn_mfma_f32_16x16x32_bf16(*(const bf16x8*)(bp + k * 32), cf[k], acc, 0, 0, 0);
                        gt[t] = acc; }
                    const float4 cs0 = *(const float4*)(CUM + sb * 32 + fq * 8), cs1 = *(const float4*)(CUM + sb * 32 + fq * 8 + 4);
                    const float csv[8] = {cs0.x, cs0.y, cs0.z, cs0.w, cs1.x, cs1.y, cs1.z, cs1.w};
                    float e[8];
#pragma unroll
                    for (int i = 0; i < 8; ++i) { const int sidx = sb * 32 + fq * 8 + i; e[i] = sidx <= lidx ? gt[i >> 2][i & 3] * __expf(fminf(cl - csv[i], 0.f)) : 0.f; }
                    const u32x4 pk = {pack2(e[0], e[1]), pack2(e[2], e[3]), pack2(e[4], e[5]), pack2(e[6], e[7])};
                    const bf16x8 pb = __builtin_bit_cast(bf16x8, pk);
#pragma unroll
                    for (int pt = 0; pt < 4; ++pt) yacc[pt] = __builtin_amdgcn_mfma_f32_16x16x32_bf16(*(const bf16x8*)(XT + (pt * 16 + fr) * PT + sb * 32 + fq * 8), pb, yacc[pt], 0, 0, 0);
                }
                bf16_t* op = YD + ((size_t)dir * M + lrl) * D + head * 64 + fq * 4;
#pragma unroll
                for (int pt = 0; pt < 4; ++pt) *(uint2*)(op + pt * 16) = make_uint2(pack2(yacc[pt][0], yacc[pt][1]), pack2(yacc[pt][2], yacc[pt][3]));
            }
#pragma unroll
            for (int pt = 0; pt < 4; ++pt) hacc[pt] *= dec_total;
#pragma unroll
            for (int k = 0; k < 4; ++k) { const bf16x8 bfr = *(const bf16x8*)(BT + (16 * w + fr) * PT + k * 32 + fq * 8);
#pragma unroll
                for (int pt = 0; pt < 4; ++pt) hacc[pt] = __builtin_amdgcn_mfma_f32_16x16x32_bf16(*(const bf16x8*)(XT + (pt * 16 + fr) * PT + k * 32 + fq * 8), bfr, hacc[pt], 0, 0, 0); }
            __syncthreads();
#pragma unroll
            for (int pt = 0; pt < 4; ++pt)
#pragma unroll
                for (int j = 0; j < 4; ++j) HL[(pt * 16 + fq * 4 + j) * PT + 16 * w + fr] = (bf16_t)f2bf(hacc[pt][j]);
        }
    }
}

__device__ void phase_vtrans(CP p, unsigned* lds) {
    unsigned char* ws = p->ws; const int tid = fresh_tid();
    const bf16_t* U = (const bf16_t*)(ws + O_U); bf16_t* VT = (bf16_t*)(ws + O_VT);
    constexpr int P = 130;
    uint4 tv[4];
    auto tile_load = [&](int tile) {
        const int cg4 = tile & 3, tt = (tile >> 2) % 36, bl = tile / 144;
        const int row0 = tt < 32 ? bl * 2048 + tt * 64 : ML + bl * 256 + (tt - 32) * 64;
#pragma unroll
        for (int i = 0; i < 4; ++i) { const int idx = i * 512 + tid, rr = idx >> 5, ck = idx & 31; tv[i] = *(const uint4*)(U + (size_t)(row0 + rr) * UC + cV + cg4 * 256 + ck * 8); }
    };
    if ((int)blockIdx.x < GB * 36 * 4) tile_load(blockIdx.x);
    for (int tile = blockIdx.x; tile < GB * 36 * 4; tile += gridDim.x) {
        const int cg4 = tile & 3, tt = (tile >> 2) % 36, bl = tile / 144;
        __syncthreads();
#pragma unroll
        for (int i = 0; i < 4; ++i) { const int idx = i * 512 + tid, rr = idx >> 5, ck = idx & 31; const uint4 v = tv[i];
            *(uint2*)(lds + rr * P + ck * 4) = make_uint2(v.x, v.y); *(uint2*)(lds + rr * P + ck * 4 + 2) = make_uint2(v.z, v.w); }
        __syncthreads();
        if (tile + (int)gridDim.x < GB * 36 * 4) tile_load(tile + gridDim.x);
        const unsigned short* l16 = (const unsigned short*)lds;
#pragma unroll
        for (int k = 0; k < 4; ++k) { const int col = (tid >> 3) + 64 * k, tg = tid & 7;
            unsigned w[4];
#pragma unroll
            for (int i = 0; i < 4; ++i) { const unsigned lo = l16[(tg * 8 + 2 * i) * (2 * P) + col], hi = l16[(tg * 8 + 2 * i + 1) * (2 * P) + col]; w[i] = lo | (hi << 16); }
            const int head = cg4 * 4 + (col >> 6), d = col & 63;
            *(uint4*)(VT + ((size_t)((bl * 16 + head) * 64 + d)) * 2304 + tt * 64 + tg * 8) = make_uint4(w[0], w[1], w[2], w[3]); }
    }
}

constexpr int ATT_KP = 72, ATT_VP = 264;
constexpr int ATT_LK = 0, ATT_LV = ATT_LK + 256 * ATT_KP * 2, ATT_LB = ATT_LV + 64 * ATT_VP * 2;
constexpr int ATT_KB = 72704;
constexpr int ATT_LDS_END = ATT_KB + 9 * 64 * 128;
__device__ __forceinline__ int att_kb_off(int key, int c) { const int f = ((key >> 1) & 1) | (((key >> 3) & 3) << 1); return key * 128 + ((c ^ f) << 4); }

template <bool MASK>
__device__ __forceinline__ void attn_chunk(const bf16x8 (&kc)[2][2][2], const bf16x8 (&vv)[2][4], const bf16x8 q0, const bf16x8 q1, f32x4 (&oacc)[4], float& mrun, float& lrun,
                                           const float* rpl, int dr0, int w0, int c, int cs, int fq) {
    f32x4 sc[2][2];
#pragma unroll
    for (int b = 0; b < 2; ++b) {
#pragma unroll
        for (int t = 0; t < 2; ++t) { f32x4 a = (f32x4){0.f, 0.f, 0.f, 0.f};
            a = __builtin_amdgcn_mfma_f32_16x16x32_bf16(kc[b][t][0], q0, a, 0, 0, 0);
            a = __builtin_amdgcn_mfma_f32_16x16x32_bf16(kc[b][t][1], q1, a, 0, 0, 0);
            sc[b][t] = a; }
        if (MASK) {
            const int dr = dr0 + b * 31;
#pragma unroll
            for (int t = 0; t < 2; ++t)
#pragma unroll
                for (int j = 0; j < 4; ++j) { const int kcol = w0 + fq * 8 + t * 4 + j; const bool ok = (unsigned)(kcol - cs) < 16u; const int dci = ok ? kcol - c + 15 : 15;
                    const float bias = rpl[dr + dci]; sc[b][t][j] = ok ? sc[b][t][j] + bias : -1e30f; }
        }
    }
    float mx = -1e30f;
#pragma unroll
    for (int b = 0; b < 2; ++b)
#pragma unroll
        for (int t = 0; t < 2; ++t)
#pragma unroll
            for (int j = 0; j < 4; ++j) mx = fmaxf(mx, sc[b][t][j]);
    mx = x16_max(mx); mx = x32_max(mx);
    const float mnew = fmaxf(mrun, mx), corr = __expf(mrun - mnew);
    lrun *= corr; mrun = mnew;
#pragma unroll
    for (int i = 0; i < 4; ++i) oacc[i] *= corr;
#pragma unroll
    for (int b = 0; b < 2; ++b) {
        float e[8];
#pragma unroll
        for (int t = 0; t < 2; ++t)
#pragma unroll
            for (int j = 0; j < 4; ++j) { e[t * 4 + j] = __expf(sc[b][t][j] - mnew); lrun += e[t * 4 + j]; }
        const u32x4_t pk = {pack2(e[0], e[1]), pack2(e[2], e[3]), pack2(e[4], e[5]), pack2(e[6], e[7])};
        const bf16x8 pb = __builtin_bit_cast(bf16x8, pk);
#pragma unroll
        for (int dt = 0; dt < 4; ++dt) oacc[dt] = __builtin_amdgcn_mfma_f32_16x16x32_bf16(vv[b][dt], pb, oacc[dt], 0, 0, 0);
    }
}

template <bool LAT>
__device__ __forceinline__ void attn_wave_item(const bf16_t* __restrict__ U, const bf16_t* __restrict__ VT, bf16_t* __restrict__ YN, const unsigned char* ldsb,
                                               int bl, int head, int r, int jq, int lane, int rb0) {
    const int fr = lane & 15, fq = lane >> 4;
    const float* rpl = (const float*)(ldsb + ATT_LB);
    int lrq0, r0 = 0, w0 = 0, c = 0, cs = 0;
    if (LAT) { lrq0 = bl * 2048 + r * 64 + jq * 16; r0 = min(max(r - 4, 0), 24); w0 = jq == 0 ? 0 : (jq == 1 ? 8 : (jq == 2 ? 24 : 32)); c = jq * 16 + fr; cs = min(max(c - 8, 0), 48); }
    else lrq0 = ML + bl * 256 + jq * 16;
    const bf16_t* qp = U + (size_t)(lrq0 + fr) * UC + cQ + head * 64 + fq * 8;
    const bf16x8 q0 = *(const bf16x8*)qp, q1 = *(const bf16x8*)(qp + 32);
    f32x4 oacc[4];
#pragma unroll
    for (int i = 0; i < 4; ++i) oacc[i] = (f32x4){0.f, 0.f, 0.f, 0.f};
    float mrun = -1e30f, lrun = 0.f;
    const int kapl = (fr >> 2) * 8 + (fr & 3);
    bf16x8 kc[2][2][2], vv[2][4];
    if (LAT) {
        const bf16_t* Vh = VT + (size_t)(bl * 16 + head) * 64 * 2304;
        unsigned vov[4];
#pragma unroll
        for (int dt = 0; dt < 4; ++dt) vov[dt] = (unsigned)((fr + 16 * dt) * 2304 + fq * 8);
        unsigned vto = (unsigned)(r0 * 64 + w0);
        const unsigned vstep = 64u;
        const unsigned char* KB = ldsb + ATT_KB;
#pragma unroll 1
        for (int ch = 0; ch < 4; ++ch) {
#pragma unroll
            for (int b = 0; b < 2; ++b)
#pragma unroll
                for (int dt = 0; dt < 4; ++dt) vv[b][dt] = *(const bf16x8*)(Vh + (vto + b * vstep + vov[dt]));
            vto += 2 * vstep;
#pragma unroll
            for (int b = 0; b < 2; ++b)
#pragma unroll
                for (int t = 0; t < 2; ++t) { const int key = (r0 - rb0 + ch * 2 + b) * 64 + w0 + kapl + 4 * t;
                    kc[b][t][0] = *(const bf16x8*)(KB + att_kb_off(key, fq)); kc[b][t][1] = *(const bf16x8*)(KB + att_kb_off(key, fq + 4)); }
            attn_chunk<true>(kc, vv, q0, q1, oacc, mrun, lrun, rpl, (r0 + ch * 2 - r + 7) * 31, w0, c, cs, fq);
        }
    }
    const bf16_t* LK = (const bf16_t*)(ldsb + ATT_LK) + kapl * ATT_KP + fq * 8;
    const bf16_t* LV = (const bf16_t*)(ldsb + ATT_LV) + fr * ATT_VP + fq * 8;
#pragma unroll 1
    for (int ch = 0; ch < 4; ++ch) {
#pragma unroll
        for (int b = 0; b < 2; ++b) {
#pragma unroll
            for (int t = 0; t < 2; ++t) { const bf16_t* kp = LK + ((ch * 2 + b) * 32 + 4 * t) * ATT_KP; kc[b][t][0] = *(const bf16x8*)kp; kc[b][t][1] = *(const bf16x8*)(kp + 32); }
#pragma unroll
            for (int dt = 0; dt < 4; ++dt) vv[b][dt] = *(const bf16x8*)(LV + dt * 16 * ATT_VP + (ch * 2 + b) * 32);
        }
        attn_chunk<false>(kc, vv, q0, q1, oacc, mrun, lrun, rpl, 0, 0, 0, 0, fq);
    }
    lrun = x16_sum(lrun); lrun = x32_sum(lrun);
    const float inv = 1.f / lrun;
    bf16_t* op = YN + (size_t)(lrq0 + fr) * D + head * 64 + fq * 4;
#pragma unroll
    for (int dt = 0; dt < 4; ++dt) *(uint2*)(op + dt * 16) = make_uint2(pack2(oacc[dt][0] * inv, oacc[dt][1] * inv), pack2(oacc[dt][2] * inv, oacc[dt][3] * inv));
}

__device__ void phase_attn(CP p, int g, int l, bool do_ctx, unsigned char* ldsb) {
    unsigned char* ws = p->ws; const int tid = fresh_tid(); const int lane = tid & 63, wid = tid >> 6;
    const bf16_t* U = (const bf16_t*)(ws + O_U); const bf16_t* VT = (const bf16_t*)(ws + O_VT); bf16_t* YN = (bf16_t*)(ws + O_YBR) + (size_t)2 * M * D;
    const int G = gridDim.x, cb = blockIdx.x;
    const int nlat = GB * 16 * 16, nctx = do_ctx ? GB * 16 * 2 : 0;
    const int perl = (nlat + G - 1) / G, perc = (nctx + G - 1) / G;
    int cur = -1;
    for (int k = 0; k < perl + perc; ++k) {
        const bool lat = k < perl;
        const int item = lat ? cb * perl + k : cb * perc + (k - perl);
        if (item >= (lat ? nlat : nctx)) continue;
        const int bh = lat ? (item >> 4) : (item >> 1);
        const int bl = bh >> 4, head = bh & 15;
        if (bh != cur) {
            cur = bh;
            __syncthreads();
#pragma unroll
            for (int i = 0; i < 4; ++i) { const int idx = i * 512 + tid;
                { const int key = idx >> 3, part = idx & 7;
                  *(uint4*)((bf16_t*)(ldsb + ATT_LK) + key * ATT_KP + part * 8) = *(const uint4*)(U + (size_t)(ML + bl * 256 + key) * UC + cK + head * 64 + part * 8); }
                { const int d = idx >> 5, part = idx & 31;
                  *(uint4*)((bf16_t*)(ldsb + ATT_LV) + d * ATT_VP + part * 8) = *(const uint4*)(VT + ((size_t)(bh * 64 + d)) * 2304 + 2048 + part * 8); } }
            if (tid < 465) ((float*)(ldsb + ATT_LB))[tid] = p->na_rpb[(size_t)(l * 16 + head) * 465 + tid];
            __syncthreads();
        }
        if (lat) {
            const int rp = item & 15, rb0 = min(max(2 * rp - 4, 0), 24);
            __syncthreads();
#pragma unroll
            for (int i = 0; i < 9; ++i) { const int idx = i * 512 + tid, key = idx >> 3, cc = idx & 7; const int brow = rb0 + (key >> 6);
                if (brow < 32) *(uint4*)(ldsb + ATT_KB + att_kb_off(key, cc)) = *(const uint4*)(U + (size_t)(bl * 2048 + brow * 64 + (key & 63)) * UC + cK + head * 64 + cc * 8); }
            __syncthreads();
            attn_wave_item<true>(U, VT, YN, ldsb, bl, head, rp * 2 + (wid >> 2), wid & 3, lane, rb0);
        }
        else attn_wave_item<false>(U, VT, (bf16_t*)(ws + O_YBRC) + ((size_t)2 * NCTX + (size_t)g * MC) * D - (size_t)ML * D, ldsb, bl, head, 0, (item & 1) * 8 + wid, lane, 0);
    }
}

__device__ void phase_ssdfin(CP p, int g, int l, int Mrows) {
    unsigned char* ws = p->ws; const int tid_ = fresh_tid(); const int lane = tid_ & 63, gw = blockIdx.x * 8 + (tid_ >> 6), nw = gridDim.x * 8;
    const bf16_t* U = (const bf16_t*)(ws + O_U); const bf16_t* XB = (const bf16_t*)(ws + O_XBCS); const bf16_t* YD = (const bf16_t*)(ws + O_YDIR);
    bf16_t* YS = (bf16_t*)(ws + O_YBR) + (size_t)M * D;
    const int head = lane >> 2; const float dsum = p->ssd_d[l * 32 + head] + p->ssd_d[l * 32 + 16 + head];
    float nwr[16];
#pragma unroll
    for (int i = 0; i < 16; ++i) nwr[i] = p->ssd_norm_w[l * D + lane * 16 + i];
    uint4 cu[2][4], nx[2][4];
    auto load_in = [&](int lr, uint4 (&d)[2][4]) {
#pragma unroll
        for (int j = 0; j < 2; ++j) { const int ch = lane * 16 + j * 8;
            d[j][0] = *(const uint4*)(YD + (size_t)lr * D + ch); d[j][1] = *(const uint4*)(YD + ((size_t)M + lr) * D + ch);
            d[j][2] = *(const uint4*)(XB + (size_t)lr * XW + ch); d[j][3] = *(const uint4*)(U + (size_t)lr * UC + cZ + ch); }
    };
    if (gw < Mrows) load_in(gw, cu);
    for (int lr = gw; lr < Mrows; lr += nw) {
        if (lr + nw < Mrows) load_in(lr + nw, nx);
        float v[16]; float ss = 0.f;
#pragma unroll
        for (int j = 0; j < 2; ++j) {
            float y0[8], y1[8], xs[8], z[8];
            unpack8(cu[j][0], y0); unpack8(cu[j][1], y1); unpack8(cu[j][2], xs); unpack8(cu[j][3], z);
#pragma unroll
            for (int i = 0; i < 8; ++i) { const float t = (y0[i] + y1[i] + xs[i] * dsum) * silu_f(z[i]); v[j * 8 + i] = t; ss += t * t; } }
#pragma unroll
        for (int o = 16; o; o >>= 1) ss += __shfl_xor(ss, o);
        const float rs = rsqrtf(ss * (1.f / 512.f) + EPS);
#pragma unroll
        for (int j = 0; j < 2; ++j) { const int ch = lane * 16 + j * 8; float o8[8];
#pragma unroll
            for (int i = 0; i < 8; ++i) o8[i] = v[j * 8 + i] * rs * nwr[j * 8 + i];
            bf16_t* yo = lr >= ML ? (bf16_t*)(ws + O_YBRC) + ((size_t)NCTX + (size_t)g * MC + (lr - ML)) * D : YS + (size_t)lr * D;
            *(uint4*)(yo + ch) = pack8(o8); }
        if (lr >= ML) {
            const bf16_t* gs_ = U + (size_t)lr * UC + cGATE; bf16_t* gd = (bf16_t*)(ws + O_GATEC) + ((size_t)g * MC + (lr - ML)) * 3072;
#pragma unroll
            for (int j = 0; j < 6; ++j) *(uint4*)(gd + (j * 64 + lane) * 8) = *(const uint4*)(gs_ + (j * 64 + lane) * 8);
        }
#pragma unroll
        for (int j = 0; j < 2; ++j)
#pragma unroll
            for (int k = 0; k < 4; ++k) cu[j][k] = nx[j][k];
    }
}

__device__ void phase_final(CP p, int g) {
    const int tid_ = fresh_tid(); const int lane = tid_ & 63, gw = blockIdx.x * 8 + (tid_ >> 6), nw = gridDim.x * 8;
    float4 wv[4], v[4], nx[4];
#pragma unroll
    for (int j = 0; j < 4; ++j) wv[j] = *(const float4*)(p->final_norm_w + j * 256 + lane * 4);
    float* base = p->out + (size_t)g * ML * D;
    if (gw < ML) {
#pragma unroll
        for (int j = 0; j < 4; ++j) v[j] = *(const float4*)(base + (size_t)gw * D + j * 256 + lane * 4); }
    for (int lr = gw; lr < ML; lr += nw) {
        float* hrow = base + (size_t)lr * D;
        if (lr + nw < ML) {
#pragma unroll
            for (int j = 0; j < 4; ++j) nx[j] = *(const float4*)(hrow + (size_t)nw * D + j * 256 + lane * 4); }
        float ss = 0.f;
#pragma unroll
        for (int j = 0; j < 4; ++j) ss += v[j].x * v[j].x + v[j].y * v[j].y + v[j].z * v[j].z + v[j].w * v[j].w;
        ss = wave_sum(ss);
        const float rs = rsqrtf(ss * (1.f / 1024.f) + EPS);
#pragma unroll
        for (int j = 0; j < 4; ++j) { const int col = j * 256 + lane * 4; const float4 w = wv[j];
            *(float4*)(hrow + col) = make_float4(v[j].x * rs * w.x, v[j].y * rs * w.y, v[j].z * rs * w.z, v[j].w * rs * w.w); }
#pragma unroll
        for (int j = 0; j < 4; ++j) v[j] = nx[j];
    }
}

#define XB_TMO      128
#define XB_XCNT(j)  (256  + 64 * (j))
#define XB_XSUB(j)  (1280 + 64 * (j))
#define XB_XGEN(j)  (2304 + 64 * (j))
#define XB_TOP      3328
#define XB_TOPGEN   3392
#define XCD_BAR_WORDS 3456
#define XB_SPIN_CAP (1u << 20)
__device__ __forceinline__ unsigned xb_ld(unsigned* p)              { return __hip_atomic_load(p, __ATOMIC_RELAXED, __HIP_MEMORY_SCOPE_AGENT); }
__device__ __forceinline__ unsigned xb_add(unsigned* p, unsigned v) { return __hip_atomic_fetch_add(p, v, __ATOMIC_RELAXED, __HIP_MEMORY_SCOPE_AGENT); }
__device__ __forceinline__ unsigned xb_xcc_id() { return (unsigned)__builtin_amdgcn_s_getreg((3 << 11) | 20) & 0xFu; }
#define XB_SPIN(cond, bar) do { unsigned _sp = 0; while (cond) { __builtin_amdgcn_s_sleep(1); \
    if ((++_sp & 255u) == 0u) { if (xb_ld(&(bar)[XB_TMO])) break; if (_sp > XB_SPIN_CAP) { atomicAdd(&(bar)[XB_TMO], 1u); break; } } } } while (0)
struct XcdBarrier { unsigned* bar; unsigned x; volatile LAS unsigned* st; };
__device__ __forceinline__ XcdBarrier xcd_barrier_post(unsigned* bar, volatile LAS unsigned* st) {
    XcdBarrier b; b.bar = bar; b.x = xb_xcc_id(); b.st = st;
    if (threadIdx.x == 0) (void)xb_add(&bar[XB_XCNT(b.x)], 1u);
    return b;
}
__device__ __forceinline__ void xcd_barrier_complete(unsigned* bar, unsigned x, unsigned& nloc, unsigned& nx) {
    const unsigned G = gridDim.x * gridDim.y * gridDim.z;
    unsigned sum, cnt, mine, sp = 0u;
    for (;;) {
        sum = 0u; cnt = 0u; mine = 0u;
#pragma unroll
        for (unsigned j = 0; j < 16; ++j) { const unsigned c = xb_ld(&bar[XB_XCNT(j)]); sum += c; cnt += (c > 0u) ? 1u : 0u; mine = (j == x) ? c : mine; }
        if (sum == G) break;
        __builtin_amdgcn_s_sleep(1);
        if ((++sp & 255u) == 0u) { if (xb_ld(&bar[XB_TMO])) break; if (sp > XB_SPIN_CAP) { atomicAdd(&bar[XB_TMO], 1u); break; } }
    }
    nloc = mine > 0u ? mine : 1u; nx = cnt > 0u ? cnt : 1u;
}
__device__ __forceinline__ void xcd_barrier(const XcdBarrier& b) {
    asm volatile("s_waitcnt vmcnt(0)" ::: "memory");
    __syncthreads();
    if (threadIdx.x == 0) {
        unsigned* bar = b.bar;
        __builtin_amdgcn_s_waitcnt(0);
        unsigned nloc = b.st[0], nx = b.st[1];
        if (nloc == 0u) { xcd_barrier_complete(bar, b.x, nloc, nx); b.st[0] = nloc; b.st[1] = nx; }
        const unsigned old = xb_add(&bar[XB_XSUB(b.x)], 1u);
        const unsigned gen = old / nloc;
        if (old + 1u == (gen + 1u) * nloc) {
            __builtin_amdgcn_fence(__ATOMIC_RELEASE, "agent");
            asm volatile("s_waitcnt vmcnt(0)" ::: "memory");
            const unsigned og = xb_add(&bar[XB_TOP], 1u);
            const unsigned tg = og / nx;
            if (og + 1u == (tg + 1u) * nx) xb_add(&bar[XB_TOPGEN], 1u);
            else XB_SPIN(xb_ld(&bar[XB_TOPGEN]) == tg, bar);
            __builtin_amdgcn_fence(__ATOMIC_ACQUIRE, "agent");
            xb_add(&bar[XB_XGEN(b.x)], 1u);
            asm volatile("s_waitcnt vmcnt(0)" ::: "memory");
        } else {
            XB_SPIN(xb_ld(&bar[XB_XGEN(b.x)]) == gen, bar);
            __builtin_amdgcn_fence(__ATOMIC_ACQUIRE, "agent");
            asm volatile("s_waitcnt vmcnt(0)" ::: "memory");
        }
    }
    __syncthreads();
}
#define GSYNC() do { xcd_barrier(xb); if (PROBE_DUP == 20) xcd_barrier(xb); } while (0)
__global__ void __launch_bounds__(512, 2) fwd_megakernel(Params p_unused) {
    extern __shared__ __attribute__((aligned(16))) unsigned char shm[];
    cg::grid_group grid = cg::this_grid();
    float* ldsf = (float*)shm; LAS unsigned char* ldsg = (LAS unsigned char*)shm;
    __shared__ uint4 xb_words;
    if (threadIdx.x == 0) xb_words = make_uint4(0u, 0u, 0u, 0u);
    __syncthreads();
    const XcdBarrier xb = xcd_barrier_post((unsigned*)(params_ptr()->ws + O_BAR), (volatile LAS unsigned*)&xb_words);
    DUP(1, phase_prep(params_ptr(), ldsf););
    grid.sync();
    for (int l = 0; l < 2; ++l) {
        const bool last = (l == 1);
        for (int g = 0; g < NG + (last ? 0 : 1); ++g) {
            const bool cchain = (g == NG);
            if (!cchain) {
                if (g == 0) {
                    DUP(2, phase_norm(params_ptr(), g, l, 0, M, false););
                    GSYNC();
                }
                DUP(3, { CP p = params_ptr(); unsigned char* ws = p->ws; const int G = gridDim.x, cb = blockIdx.x;
                  pg8::Gemm gm{(const bf16_t*)(ws + O_AN), (const bf16_t*)(ws + O_WIN + l * SZ_WIN), M, UC, D, 0, 0};
                  pg8::StaticOrder S; S.init(M, UC, G, cb, 1); EpiU E{(bf16_t*)(ws + O_U)}; pg8::gemm_phase(ldsg, gm, S, E); });
                GSYNC();
                DUP(12, phase_mixprep(params_ptr(), g, l, last, rep_ == 0););
                DUP(4, phase_vtrans(params_ptr(), (unsigned*)shm););
                GSYNC();
                DUP(5, phase_scan(params_ptr(), !last, shm););
                DUP(6, phase_attn(params_ptr(), g, l, !last, shm););
                GSYNC();
                DUP(7, phase_ssdfin(params_ptr(), g, l, last ? ML : M););
                GSYNC();
            }
            const int Mr = cchain ? NCTX : ML;
            DUP(8, { CP p = params_ptr(); unsigned char* ws = p->ws; const int G = gridDim.x, cb = blockIdx.x;
              pg8::Gemm gm{(const bf16_t*)(ws + (cchain ? O_YBRC : O_YBR)), (const bf16_t*)(ws + O_WBR + l * SZ_WBR), Mr, D, D, (size_t)(cchain ? NCTX : M) * D * 2, (size_t)D * D * 2};
              pg8::StaticOrder S; S.init(Mr, D, G, cb, 3);
              EpiMerge E{cchain ? (const bf16_t*)(ws + O_GATEC) : (const bf16_t*)(ws + O_U) + cGATE, cchain ? 3072 : UC, (bf16_t*)(ws + O_MRGB)}; pg8::gemm_phase(ldsg, gm, S, E); });
            GSYNC();
            DUP(9, { CP p = params_ptr(); unsigned char* ws = p->ws; const int G = gridDim.x, cb = blockIdx.x;
              const float* modl = (const float*)(ws + O_MOD) + (size_t)l * 33 * 6144;
              float* hl = p->out + (size_t)g * ML * D; float* hc = (float*)(ws + O_HC) + (cchain ? (size_t)0 : (size_t)g * MC * D);
              pg8::Gemm gm{(const bf16_t*)(ws + O_MRGB), (const bf16_t*)(ws + O_WOUT + l * SZ_WOUT), Mr, D, D, 0, 0};
              pg8::StaticOrder S; S.init(Mr, D, G, cb, 1); EpiRes E{hl, hc, modl + 2048, g, rep_ == 0 ? 1.f : 0.f, cchain ? 1 : 0, (l == 0 && rep_ == 0) ? (cchain ? (long)(p->ctx - hc) : (long)((p->x + (size_t)g * ML * D) - hl)) : 0L}; pg8::gemm_phase(ldsg, gm, S, E); });
            GSYNC();
            DUP(10, phase_norm(params_ptr(), g, l, 1, Mr, cchain););
            GSYNC();
            DUP(11, { CP p = params_ptr(); unsigned char* ws = p->ws; const int G = gridDim.x, cb = blockIdx.x;
              pg8::Gemm gm{(const bf16_t*)(ws + O_AN), (const bf16_t*)(ws + O_WFF1 + l * SZ_WFF), Mr, 4096, D, 0, 0};
              pg8::StaticOrder S; S.init(Mr, 4096, G, cb, 1); EpiFF1 E{(bf16_t*)(ws + O_U)}; pg8::gemm_phase(ldsg, gm, S, E); });
            GSYNC();
            DUP(13, { CP p = params_ptr(); unsigned char* ws = p->ws; const int G = gridDim.x, cb = blockIdx.x;
              const float* modl = (const float*)(ws + O_MOD) + (size_t)l * 33 * 6144;
              float* hl = p->out + (size_t)g * ML * D; float* hc = (float*)(ws + O_HC) + (cchain ? (size_t)0 : (size_t)g * MC * D);
              pg8::Gemm gm{(const bf16_t*)(ws + O_U), (const bf16_t*)(ws + O_WFF2 + l * SZ_WFF), Mr, D, 4096, 0, 0};
              pg8::StaticOrder S; S.init(Mr, D, G, cb, 1); EpiRes E{hl, hc, modl + 5120, g, rep_ == 0 ? 1.f : 0.f, cchain ? 1 : 0, 0L}; pg8::gemm_phase(ldsg, gm, S, E); });
            if (g + 1 < NG) phase_norm(params_ptr(), g + 1, l, 0, M, false);
            GSYNC();
        }
    }
    for (int g = 0; g < NG; ++g) phase_final(params_ptr(), g);
}

extern "C" void kernel_launch(void* const* d_in, const int* in_sizes, int n_in, void* d_out, int out_size, void* d_ws, size_t ws_size, hipStream_t stream) {
    constexpr size_t kDynLds = 155648;
    static_assert(ATT_LDS_END <= 155648, "attention LDS image too large");
    static int grid_blocks = 0;
    if (grid_blocks == 0) {
        if (n_in != 24 || ws_size < WS_END) { fprintf(stderr, "kernel_launch: need 24 inputs and %zu bytes of workspace, got %d / %zu\n", (size_t)WS_END, n_in, ws_size); grid_blocks = -1; return; }
        int dev = 0, cus = 0, per_cu = 0;
        (void)hipGetDevice(&dev);
        (void)hipDeviceGetAttribute(&cus, hipDeviceAttributeMultiprocessorCount, dev);
        (void)hipFuncSetAttribute((const void*)fwd_megakernel, hipFuncAttributeMaxDynamicSharedMemorySize, (int)kDynLds);
        (void)hipOccupancyMaxActiveBlocksPerMultiprocessor(&per_cu, (const void*)fwd_megakernel, 512, kDynLds);
        if (per_cu < 1) per_cu = 1;
        grid_blocks = cus * per_cu;
        (void)hipGetLastError();
    }
    if (grid_blocks < 0) return;
    Params p{};
    const float** pp = (const float**)&p;
    for (int i = 0; i < 24; ++i) pp[i] = (const float*)d_in[i];
    p.out = (float*)d_out; p.ws = (unsigned char*)d_ws;
    (void)hipMemsetAsync((unsigned char*)d_ws + O_BAR, 0, 16384, stream);
    void* args[] = {&p};
    hipError_t e = hipLaunchCooperativeKernel((void*)fwd_megakernel, dim3(grid_blocks), dim3(512), args, kDynLds, stream);
    if (e != hipSuccess) fprintf(stderr, "cooperative launch failed: %s (grid %d)\n", hipGetErrorString(e), grid_blocks);
}
```

```cpp
#include <hip/hip_runtime.h>
#include <hip/hip_cooperative_groups.h>
#include <cstdio>
namespace cg = cooperative_groups;
#ifndef PROBE_DUP
#define PROBE_DUP 0
#endif
#define DUP(n, ...) do { _Pragma("nounroll") for (int rep_ = 0; rep_ < ((PROBE_DUP == (n)) ? 2 : 1); ++rep_) { __VA_ARGS__ } } while (0)

#define LAS __attribute__((address_space(3)))
typedef unsigned short bf16_t;
typedef short bf16x8 __attribute__((ext_vector_type(8)));
typedef float f32x4 __attribute__((ext_vector_type(4)));
typedef unsigned u32x4_t __attribute__((ext_vector_type(4)));

constexpr int D = 1024, NB = 32, L = 2048, CTX = 256;
constexpr int GB = 8, NG = NB / GB, ML = GB * L, MC = GB * CTX, M = ML + MC;
constexpr int UC = 12032, IN_COLS = 11808;
constexpr int cCB = 0, cCC = 1024, cCX = 2048, cZ = 3072, cXBC = 4096, cQ = 5632, cK = 6656, cV = 7680, cGATE = 8704, cDT = 11776;
constexpr int XW = 1536, NCTX = NB * CTX;
constexpr float EPS = 1e-6f;

constexpr size_t SZ_WIN = (size_t)UC * D * 2, SZ_WBR = (size_t)3 * D * D * 2, SZ_WOUT = (size_t)D * D * 2, SZ_WFF = (size_t)4 * D * D * 2;
constexpr size_t O_WIN = 0;
constexpr size_t O_WBR = O_WIN + 2 * SZ_WIN;
constexpr size_t O_WOUT = O_WBR + 2 * SZ_WBR;
constexpr size_t O_WFF1 = O_WOUT + 2 * SZ_WOUT;
constexpr size_t O_WFF2 = O_WFF1 + 2 * SZ_WFF;
constexpr size_t O_HC = O_WFF2 + 2 * SZ_WFF;
constexpr size_t O_MOD = O_HC + (size_t)NB * CTX * D * 4;
constexpr size_t O_ROPE = O_MOD + (size_t)2 * 33 * 6144 * 4 + 256 * 3;
constexpr size_t O_AN = O_ROPE + (size_t)2048 * 64 * 4;
constexpr size_t O_U = O_AN + (size_t)M * D * 2;
constexpr size_t O_XBCS = O_U + (size_t)M * UC * 2;
constexpr size_t O_DTS = O_XBCS + (size_t)M * XW * 2;
constexpr size_t O_DECS = O_DTS + (size_t)M * 32 * 4;
constexpr size_t O_YDIR = O_DECS + (size_t)M * 32 * 4;
constexpr size_t O_YBR = O_YDIR + (size_t)2 * M * D * 2;
constexpr size_t O_MRGB = O_YBR + (size_t)3 * M * D * 2;
constexpr size_t O_VT = O_MRGB + (size_t)M * D * 2;
constexpr size_t O_BAR = O_VT + (size_t)GB * 1024 * 2304 * 2;
constexpr size_t O_YBRC = O_BAR + 16384;
constexpr size_t O_GATEC = O_YBRC + (size_t)3 * NB * CTX * D * 2;
constexpr size_t WS_END = O_GATEC + (size_t)NB * CTX * 3072 * 2;
static_assert(WS_END <= ((size_t)1 << 30), "workspace map exceeds 1 GiB");

struct Params {
    const float *x, *c, *ctx, *c_ctx, *w_ada, *b_ada, *norm1_w, *w_in, *conv_mix_w, *ssd_conv_w, *ssd_conv_b, *ssd_a_log, *ssd_dt_bias, *ssd_d, *ssd_norm_w,
        *na_rpb, *w_br_conv, *w_br_ssd, *w_br_na, *w_out, *norm2_w, *w_ff1, *w_ff2, *final_norm_w;
    float* out; unsigned char* ws;
};

typedef const __attribute__((address_space(4))) Params* CP;
__device__ __forceinline__ CP params_ptr() { unsigned long long k = (unsigned long long)__builtin_amdgcn_kernarg_segment_ptr(); asm volatile("" : "+s"(k)); return (CP)k; }
__device__ __forceinline__ int fresh_tid() { int t = threadIdx.x; asm volatile("" : "+v"(t)); return t; }
__device__ __forceinline__ float bflo(unsigned u) { return __uint_as_float(u << 16); }
__device__ __forceinline__ float bfhi(unsigned u) { return __uint_as_float(u & 0xffff0000u); }
__device__ __forceinline__ unsigned f2bf(float f) { unsigned u = __float_as_uint(f); u += 0x7FFFu + ((u >> 16) & 1u); return u >> 16; }
__device__ __forceinline__ unsigned pack2(float lo, float hi) { unsigned r; asm volatile("v_cvt_pk_bf16_f32 %0, %1, %2" : "=v"(r) : "v"(lo), "v"(hi)); return r; }
__device__ __forceinline__ void unpack8(const uint4 v, float (&f)[8]) { f[0] = bflo(v.x); f[1] = bfhi(v.x); f[2] = bflo(v.y); f[3] = bfhi(v.y); f[4] = bflo(v.z); f[5] = bfhi(v.z); f[6] = bflo(v.w); f[7] = bfhi(v.w); }
__device__ __forceinline__ uint4 pack8(const float (&f)[8]) { uint4 v; v.x = pack2(f[0], f[1]); v.y = pack2(f[2], f[3]); v.z = pack2(f[4], f[5]); v.w = pack2(f[6], f[7]); return v; }
__device__ __forceinline__ float silu_f(float v) { return v * __builtin_amdgcn_rcpf(1.f + __expf(-v)); }
__device__ __forceinline__ float sigmoid_f(float v) { return __builtin_amdgcn_rcpf(1.f + __expf(-v)); }
__device__ __forceinline__ float x32_max(float v) { const auto r = __builtin_amdgcn_permlane32_swap(__float_as_uint(v), __float_as_uint(v), false, false); return fmaxf(__uint_as_float(r[0]), __uint_as_float(r[1])); }
__device__ __forceinline__ float x16_max(float v) { const auto r = __builtin_amdgcn_permlane16_swap(__float_as_uint(v), __float_as_uint(v), false, false); return fmaxf(__uint_as_float(r[0]), __uint_as_float(r[1])); }
__device__ __forceinline__ float x32_sum(float v) { const auto r = __builtin_amdgcn_permlane32_swap(__float_as_uint(v), __float_as_uint(v), false, false); return __uint_as_float(r[0]) + __uint_as_float(r[1]); }
__device__ __forceinline__ float x16_sum(float v) { const auto r = __builtin_amdgcn_permlane16_swap(__float_as_uint(v), __float_as_uint(v), false, false); return __uint_as_float(r[0]) + __uint_as_float(r[1]); }
__device__ __forceinline__ float wave_sum(float v) { v = x32_sum(v); v = x16_sum(v); for (int o = 8; o; o >>= 1) v += __shfl_xor(v, o); return v; }

namespace pg8 {
constexpr int BM = 256, BK = 64, HALF = 128, HTB = HALF * BK * 2, STAGE_BYTES = 8 * HTB, NXCD = 8, WGM = 8;
__device__ __forceinline__ int lds_byte(int r, int c) { const int st = (r >> 4) * 2 + (c >> 5), rr = r & 15, cc = c & 31, ob = rr * 64 + cc * 2; return st * 1024 + (ob ^ (((ob >> 9) & 1) << 5)); }
__device__ __forceinline__ void stage_rc(int b, int& R, int& C) { const int st = b / 1024, sb = b % 1024, swz = sb ^ (((sb >> 9) & 1) << 5); R = (st >> 1) * 16 + swz / 64; C = (st & 1) * 32 + (swz % 64) / 2; }
__device__ __forceinline__ int perm32(int rho) { const int n = rho >> 4, i = rho & 15; return 8 * (i >> 2) + 4 * n + (i & 3); }
struct Unit { int pm, pn, z; };
struct Gemm { const bf16_t* A; const bf16_t* Bt; int M, N, K; size_t azs, bzs; };
struct StaticOrder {
    int nM, nN, nwg, G, c, nz;
    __device__ void init(int M_, int N_, int G_, int c_, int nz_) { nM = M_ / BM; nN = N_ / BM; nwg = nM * nN; G = G_; c = c_; nz = nz_; }
    __device__ bool next(int i, Unit& u) const {
        const int ti = i / nz; u.z = i - ti * nz;
        const long Lx = (long)ti * G + c; if (Lx >= nwg) return false;
        int wgid = (int)Lx; { const int q = nwg / NXCD, r = nwg % NXCD, xcd = wgid % NXCD, off = wgid / NXCD; wgid = (xcd < r ? xcd * (q + 1) : r * (q + 1) + (xcd - r) * q) + off; }
        const int nig = WGM * nN, gid = wgid / nig, fm = gid * WGM, gsz = (nM - fm) < WGM ? (nM - fm) : WGM;
        u.pm = fm + ((wgid % nig) % gsz); u.pn = (wgid % nig) / gsz; return true;
    }
};
template <class Epi>
__device__ __forceinline__ void gemm_phase(LAS unsigned char* lds, const Gemm g, const StaticOrder& S, const Epi& E) {
    const int tid = fresh_tid(), wid = __builtin_amdgcn_readfirstlane(tid >> 6), lane = tid & 63, wr = wid >> 2, wc = wid & 3, fr = lane & 15, fq = lane >> 4;
    const int K = g.K, nt = K / BK;
    unsigned voffA[2], voffB[2];
#pragma unroll
    for (int i = 0; i < 2; ++i) { int R, C; stage_rc(tid * 16 + i * 8192, R, C); const int Rb = Epi::PERM ? ((R & ~31) + perm32(R & 31)) : R;
        voffA[i] = (unsigned)(R * K + C) * 2u; voffB[i] = (unsigned)(Rb * K + C) * 2u; }
    const size_t kstep = (size_t)(BK * 2);
    const size_t hstep = (size_t)HALF * K * 2;
    const size_t tstep = 2 * hstep;
    const unsigned ldsw = (unsigned)wid * 1024u;
    const int aoff = lds_byte(wr * 64 + fr, fq * 8), boff = lds_byte(wc * 32 + fr, fq * 8);
#define PG8_SA(b, h) (((b) * 2 + (h)) * HTB)
#define PG8_SB(b, h) ((4 + (b) * 2 + (h)) * HTB)
#define PG8_STAGE(bufoff, gbase, voff) do { _Pragma("unroll") for (int _i = 0; _i < 2; ++_i) \
        __builtin_amdgcn_global_load_lds((const unsigned*)((const char*)(gbase) + (voff)[_i]), (LAS unsigned*)(lds + (bufoff) + ldsw + _i * 8192), 16, 0, 0); } while (0)
#define PG8_LDA(dst, b, h) do { _Pragma("unroll") for (int m = 0; m < 4; ++m) _Pragma("unroll") for (int k = 0; k < 2; ++k) dst[m][k] = *(const LAS bf16x8*)(lds + PG8_SA(b, h) + aoff + m * 2048 + k * 1024); } while (0)
#define PG8_LDB(dst, b, h) do { _Pragma("unroll") for (int n = 0; n < 2; ++n) _Pragma("unroll") for (int k = 0; k < 2; ++k) dst[n][k] = *(const LAS bf16x8*)(lds + PG8_SB(b, h) + boff + n * 2048 + k * 1024); } while (0)
#define PG8_MMA(ai, bj, At, Bt) do { __builtin_amdgcn_s_setprio(1); _Pragma("unroll") for (int m = 0; m < 4; ++m) _Pragma("unroll") for (int n = 0; n < 2; ++n) _Pragma("unroll") for (int k = 0; k < 2; ++k) \
        acc[ai][bj][m][n] = __builtin_amdgcn_mfma_f32_16x16x32_bf16(Bt[n][k], At[m][k], acc[ai][bj][m][n], 0, 0, 0); __builtin_amdgcn_s_setprio(0); } while (0)
#define PG8_WAIT_V(n) asm volatile("s_waitcnt vmcnt(" #n ")" ::: "memory")
#define PG8_WAIT_L(n) asm volatile("s_waitcnt lgkmcnt(" #n ")" ::: "memory")
#define PG8_BAR __builtin_amdgcn_s_barrier()
#define PG8_SCHED __builtin_amdgcn_sched_barrier(0)
    Unit cur, nxt; int ui = 0;
    if (!S.next(0, cur)) return;
    f32x4 acc[2][2][4][2];
#pragma unroll
    for (int a = 0; a < 2; ++a)
#pragma unroll
        for (int b = 0; b < 2; ++b)
#pragma unroll
            for (int m = 0; m < 4; ++m)
#pragma unroll
                for (int n = 0; n < 2; ++n) acc[a][b][m][n] = (f32x4){0.f, 0.f, 0.f, 0.f};
    bf16x8 At[4][2], B0[2][2], B1[2][2];
    const char* cA = (const char*)g.A + (size_t)cur.z * g.azs + (size_t)cur.pm * tstep; const char* cB = (const char*)g.Bt + (size_t)cur.z * g.bzs + (size_t)cur.pn * tstep;
    PG8_STAGE(PG8_SB(0, 0), cB, voffB); PG8_STAGE(PG8_SA(0, 0), cA, voffA); PG8_STAGE(PG8_SB(0, 1), cB + hstep, voffB); PG8_STAGE(PG8_SA(0, 1), cA + hstep, voffA);
    if (wr == 1) PG8_BAR;
    PG8_WAIT_V(4); PG8_BAR;
    PG8_STAGE(PG8_SB(1, 0), cB + kstep, voffB); PG8_STAGE(PG8_SA(1, 0), cA + kstep, voffA); PG8_STAGE(PG8_SB(1, 1), cB + hstep + kstep, voffB);
    PG8_WAIT_V(6); PG8_BAR;
    for (;;) {
        const bool has_next = S.next(ui + 1, nxt);
        const char* nA = has_next ? (const char*)g.A + (size_t)nxt.z * g.azs + (size_t)nxt.pm * tstep : cA; const char* nB = has_next ? (const char*)g.Bt + (size_t)nxt.z * g.bzs + (size_t)nxt.pn * tstep : cB;
        for (int t = 0; t < nt; t += 2) {
            const bool last = (t == nt - 2);
            const char* a1 = cA + (size_t)(t + 1) * kstep;
            const char* a2 = last ? nA : cA + (size_t)(t + 2) * kstep; const char* b2 = last ? nB : cB + (size_t)(t + 2) * kstep;
            const char* a3 = a2 + kstep; const char* b3 = b2 + kstep;
            PG8_LDB(B0, 0, 0); PG8_SCHED; PG8_LDA(At, 0, 0); PG8_STAGE(PG8_SA(1, 1), a1 + hstep, voffA);
            PG8_WAIT_L(8); PG8_BAR; PG8_WAIT_L(0); PG8_MMA(0, 0, At, B0); PG8_BAR; PG8_SCHED;
            PG8_LDB(B1, 0, 1); PG8_STAGE(PG8_SB(0, 0), b2, voffB);
            PG8_BAR; PG8_WAIT_L(0); PG8_MMA(0, 1, At, B1); PG8_BAR;
            PG8_LDA(At, 0, 1); PG8_STAGE(PG8_SA(0, 0), a2, voffA);
            PG8_BAR; PG8_WAIT_L(0); PG8_MMA(1, 0, At, B0); PG8_BAR; PG8_SCHED;
            PG8_STAGE(PG8_SB(0, 1), b2 + hstep, voffB);
            PG8_WAIT_V(6); PG8_BAR; PG8_MMA(1, 1, At, B1); PG8_BAR;
            PG8_LDB(B0, 1, 0); PG8_SCHED; PG8_LDA(At, 1, 0); PG8_STAGE(PG8_SA(0, 1), a2 + hstep, voffA);
            PG8_WAIT_L(8); PG8_BAR; PG8_WAIT_L(0); PG8_MMA(0, 0, At, B0); PG8_BAR; PG8_SCHED;
            PG8_LDB(B1, 1, 1); PG8_STAGE(PG8_SB(1, 0), b3, voffB);
            PG8_BAR; PG8_WAIT_L(0); PG8_MMA(0, 1, At, B1); PG8_BAR;
            PG8_LDA(At, 1, 1); PG8_STAGE(PG8_SA(1, 0), a3, voffA);
            PG8_BAR; PG8_WAIT_L(0); PG8_MMA(1, 0, At, B0); PG8_BAR; PG8_SCHED;
            PG8_STAGE(PG8_SB(1, 1), b3 + hstep, voffB);
            PG8_WAIT_V(6); PG8_BAR; PG8_MMA(1, 1, At, B1); PG8_BAR;
        }
        E(acc, cur, wr, wc, fr, fq);
        if (!has_next) break;
        if (!E.keep(cur))
#pragma unroll
        for (int a = 0; a < 2; ++a)
#pragma unroll
            for (int b = 0; b < 2; ++b)
#pragma unroll
                for (int m = 0; m < 4; ++m)
#pragma unroll
                    for (int n = 0; n < 2; ++n) acc[a][b][m][n] = (f32x4){0.f, 0.f, 0.f, 0.f};
        cur = nxt; cA = nA; cB = nB; ++ui;
    }
    PG8_WAIT_V(0);
    if (wr == 0) PG8_BAR;
    PG8_BAR;
#undef PG8_SA
#undef PG8_SB
#undef PG8_STAGE
#undef PG8_LDA
#undef PG8_LDB
#undef PG8_MMA
#undef PG8_WAIT_V
#undef PG8_WAIT_L
#undef PG8_BAR
#undef PG8_SCHED
}
}
using pg8::Unit;

struct EpiU {
    static constexpr bool PERM = true;
    __device__ __forceinline__ bool keep(const Unit&) const { return false; }
    bf16_t* U;
    __device__ __forceinline__ void operator()(f32x4 (&acc)[2][2][4][2], const Unit& u, int wr, int wc, int fr, int fq) const {
        const int row0 = u.pm * 256 + wr * 64 + fr, col0 = u.pn * 256 + wc * 32 + 8 * fq;
        const bool sg = (u.pn >= cGATE / 256) && (u.pn < cDT / 256);
#pragma unroll
        for (int ai = 0; ai < 2; ++ai)
#pragma unroll
            for (int m = 0; m < 4; ++m) { bf16_t* rowp = U + (size_t)(row0 + ai * 128 + m * 16) * UC + col0;
#pragma unroll
                for (int bj = 0; bj < 2; ++bj) { f32x4 v0 = acc[ai][bj][m][0], v1 = acc[ai][bj][m][1];
                    if (sg) {
#pragma unroll
                        for (int j = 0; j < 4; ++j) { v0[j] = sigmoid_f(v0[j]); v1[j] = sigmoid_f(v1[j]); } }
                    uint4 o; o.x = pack2(v0[0], v0[1]); o.y = pack2(v0[2], v0[3]); o.z = pack2(v1[0], v1[1]); o.w = pack2(v1[2], v1[3]);
                    *(uint4*)(rowp + bj * 128) = o; } }
    }
};
struct EpiMerge {
    static constexpr bool PERM = true;
    const bf16_t* G; int gld; bf16_t* MB;
    __device__ __forceinline__ bool keep(const Unit& u) const { return u.z < 2; }
    __device__ __forceinline__ void operator()(f32x4 (&acc)[2][2][4][2], const Unit& u, int wr, int wc, int fr, int fq) const {
        const int row0 = u.pm * 256 + wr * 64 + fr, col0 = u.pn * 256 + wc * 32 + 8 * fq;
#pragma unroll
        for (int ai = 0; ai < 2; ++ai) {
            uint4 g0[4][2], g1[4][2];
#pragma unroll
            for (int m = 0; m < 4; ++m)
#pragma unroll
                for (int bj = 0; bj < 2; ++bj) { const bf16_t* gp = G + (size_t)(row0 + ai * 128 + m * 16) * gld + u.z * 1024 + col0 + bj * 128;
                    g0[m][bj] = *(const uint4*)gp; g1[m][bj] = (u.z < 2) ? *(const uint4*)(gp + 1024) : g0[m][bj]; }
#pragma unroll
            for (int m = 0; m < 4; ++m) { const size_t row = (size_t)(row0 + ai * 128 + m * 16);
#pragma unroll
                for (int bj = 0; bj < 2; ++bj) { const int col = col0 + bj * 128;
                    float gz[8]; unpack8(g0[m][bj], gz);
                    if (u.z < 2) { float gn[8]; unpack8(g1[m][bj], gn);
#pragma unroll
                        for (int j = 0; j < 8; ++j) { const float rt = fmaxf(gz[j], 1e-20f) * __builtin_amdgcn_rcpf(fmaxf(gn[j], 1e-20f)); acc[ai][bj][m][j >> 2][j & 3] *= rt; } }
                    else { f32x4 v0 = acc[ai][bj][m][0], v1 = acc[ai][bj][m][1];
#pragma unroll
                        for (int j = 0; j < 4; ++j) { v0[j] *= fmaxf(gz[j], 1e-20f); v1[j] *= fmaxf(gz[4 + j], 1e-20f); }
                        uint4 o; o.x = pack2(v0[0], v0[1]); o.y = pack2(v0[2], v0[3]); o.z = pack2(v1[0], v1[1]); o.w = pack2(v1[2], v1[3]); *(uint4*)(MB + row * D + col) = o; } } }
        }
    }
};
struct EpiRes {
    static constexpr bool PERM = false;
    __device__ __forceinline__ bool keep(const Unit&) const { return false; }
    float* hl; float* hc; const float* gate;
    int g; float gs; int allctx; long rdel;
    __device__ __forceinline__ void operator()(f32x4 (&acc)[2][2][4][2], const Unit& u, int wr, int wc, int fr, int fq) const {
        const int lr0 = u.pm * 256; const bool isctx = allctx || lr0 >= ML;
        float* base = allctx ? hc + (size_t)lr0 * D : (isctx ? hc + (size_t)(lr0 - ML) * D : hl + (size_t)lr0 * D);
        const float* rbase = base + rdel;
        const float* gp = gate + (size_t)(isctx ? 32 : g * GB + (lr0 >> 11)) * 6144;
        const int r0 = wr * 64 + fr, col0 = u.pn * 256 + wc * 32 + 4 * fq;
        f32x4 gv[2][2];
#pragma unroll
        for (int bj = 0; bj < 2; ++bj)
#pragma unroll
            for (int n = 0; n < 2; ++n) gv[bj][n] = *(const f32x4*)(gp + col0 + bj * 128 + n * 16) * gs;
#pragma unroll
        for (int ai = 0; ai < 2; ++ai) {
            f32x4 hv[4][2][2];
#pragma unroll
            for (int m = 0; m < 4; ++m)
#pragma unroll
                for (int bj = 0; bj < 2; ++bj)
#pragma unroll
                    for (int n = 0; n < 2; ++n) hv[m][bj][n] = *(const f32x4*)(rbase + (size_t)(r0 + ai * 128 + m * 16) * D + col0 + bj * 128 + n * 16);
#pragma unroll
            for (int m = 0; m < 4; ++m)
#pragma unroll
                for (int bj = 0; bj < 2; ++bj)
#pragma unroll
                    for (int n = 0; n < 2; ++n) *(f32x4*)(base + (size_t)(r0 + ai * 128 + m * 16) * D + col0 + bj * 128 + n * 16) = hv[m][bj][n] + gv[bj][n] * acc[ai][bj][m][n];
        }
    }
};
struct EpiFF1 {
    static constexpr bool PERM = true;
    __device__ __forceinline__ bool keep(const Unit&) const { return false; }
    bf16_t* H;
    __device__ __forceinline__ void operator()(f32x4 (&acc)[2][2][4][2], const Unit& u, int wr, int wc, int fr, int fq) const {
        const int row0 = u.pm * 256 + wr * 64 + fr, col0 = u.pn * 256 + wc * 32 + 8 * fq;
#pragma unroll
        for (int ai = 0; ai < 2; ++ai)
#pragma unroll
            for (int m = 0; m < 4; ++m) { bf16_t* rowp = H + (size_t)(row0 + ai * 128 + m * 16) * 4096 + col0;
#pragma unroll
                for (int bj = 0; bj < 2; ++bj) { f32x4 v0 = acc[ai][bj][m][0], v1 = acc[ai][bj][m][1];
#pragma unroll
                    for (int j = 0; j < 4; ++j) { const float a = fmaxf(v0[j], 0.f), b = fmaxf(v1[j], 0.f); v0[j] = a * a; v1[j] = b * b; }
                    uint4 o; o.x = pack2(v0[0], v0[1]); o.y = pack2(v0[2], v0[3]); o.z = pack2(v1[0], v1[1]); o.w = pack2(v1[2], v1[3]);
                    *(uint4*)(rowp + bj * 128) = o; } }
    }
};

__device__ __forceinline__ int w_in_src_col(int j) { return j < 5632 ? j : (j < 11776 ? j + 32 : (j < 11808 ? j - 11776 + 5632 : -1)); }

__device__ void transpose_weight(const float* __restrict__ W, int ld, int Kd, int Nout, bool mapped, bf16_t* __restrict__ Wt, float* lds) {
    const int tid = fresh_tid(); const int tn = Nout / 256, tk = Kd / 64;
    constexpr int P = 257;
    for (int t = blockIdx.x; t < tn * tk; t += gridDim.x) {
        const int n0 = (t % tn) * 256, k0 = (t / tn) * 64;
        __syncthreads();
#pragma unroll
        for (int i = 0; i < 8; ++i) { const int idx = i * 512 + tid, kk = idx >> 6, nn = (idx & 63) * 4; const int sc = mapped ? w_in_src_col(n0 + nn) : n0 + nn;
            const float4 v = sc >= 0 ? *(const float4*)(W + (size_t)(k0 + kk) * ld + sc) : make_float4(0.f, 0.f, 0.f, 0.f);
            float* d = lds + kk * P + nn; d[0] = v.x; d[1] = v.y; d[2] = v.z; d[3] = v.w; }
        __syncthreads();
#pragma unroll
        for (int i = 0; i < 4; ++i) { const int idx = i * 512 + tid, nn = idx >> 3, kp = (idx & 7) * 8;
            float f[8];
#pragma unroll
            for (int j = 0; j < 8; ++j) f[j] = lds[(kp + j) * P + nn];
            *(uint4*)(Wt + (size_t)(n0 + nn) * Kd + k0 + kp) = pack8(f); }
    }
}

__device__ void phase_prep(CP p, float* lds) {
    unsigned char* ws = p->ws; const int tid = fresh_tid();
    for (int l = 0; l < 2; ++l) {
        transpose_weight(p->w_in + (size_t)l * D * IN_COLS, IN_COLS, D, UC, true, (bf16_t*)(ws + O_WIN + l * SZ_WIN), lds);
        transpose_weight(p->w_br_conv + (size_t)l * D * D, D, D, D, false, (bf16_t*)(ws + O_WBR + l * SZ_WBR), lds);
        transpose_weight(p->w_br_ssd + (size_t)l * D * D, D, D, D, false, (bf16_t*)(ws + O_WBR + l * SZ_WBR) + (size_t)D * D, lds);
        transpose_weight(p->w_br_na + (size_t)l * D * D, D, D, D, false, (bf16_t*)(ws + O_WBR + l * SZ_WBR) + (size_t)2 * D * D, lds);
        transpose_weight(p->w_out + (size_t)l * D * D, D, D, D, false, (bf16_t*)(ws + O_WOUT + l * SZ_WOUT), lds);
        transpose_weight(p->w_ff1 + (size_t)l * D * 4096, 4096, D, 4096, false, (bf16_t*)(ws + O_WFF1 + l * SZ_WFF), lds);
        transpose_weight(p->w_ff2 + (size_t)l * 4096 * D, D, 4096, D, false, (bf16_t*)(ws + O_WFF2 + l * SZ_WFF), lds);
    }
    {
        float* tab = (float*)(ws + O_ROPE);
        for (int i = blockIdx.x * 512 + tid; i < 2048 * 32; i += gridDim.x * 512) {
            const int t = i >> 5, j = i & 31, ii = j & 15; const int pos = (j < 16) ? (t >> 6) : (t & 63);
            const float inv = powf(10000.0f, -(float)(2 * ii) / 32.0f); const float ang = (float)pos * inv;
            tab[t * 64 + j] = cosf(ang); tab[t * 64 + 32 + j] = sinf(ang);
        }
    }
    float* mod = (float*)(ws + O_MOD);
    for (int job = blockIdx.x; job < 2 * 96; job += gridDim.x) {
        const int l = job / 96, j0 = (job % 96) * 64;
        __syncthreads();
        for (int i = tid; i < 32 * 1024; i += 512) lds[i] = silu_f(p->c[i]);
        __syncthreads();
        const int col = tid & 63, kp = tid >> 6;
        float acc[33];
#pragma unroll
        for (int r = 0; r < 33; ++r) acc[r] = 0.f;
        const float* wp = p->w_ada + (size_t)l * D * 6144 + j0 + col;
        for (int k = kp * 128; k < kp * 128 + 128; ++k) {
            const float wv = wp[(size_t)k * 6144];
#pragma unroll
            for (int r = 0; r < 32; ++r) acc[r] += lds[r * 1024 + k] * wv;
            acc[32] += silu_f(p->c_ctx[k]) * wv;
        }
        __syncthreads();
#pragma unroll
        for (int r = 0; r < 33; ++r) lds[(kp * 33 + r) * 64 + col] = acc[r];
        __syncthreads();
        for (int i = tid; i < 33 * 64; i += 512) { const int r = i >> 6, cc = i & 63; float s = 0.f;
#pragma unroll
            for (int q = 0; q < 8; ++q) s += lds[(q * 33 + r) * 64 + cc];
            mod[((size_t)l * 33 + r) * 6144 + j0 + cc] = s + p->b_ada[l * 6144 + j0 + cc]; }
    }
}

__device__ void phase_norm(CP p, int g, int l, int which, int Mrows, bool ctxall) {
    unsigned char* ws = p->ws; const int tid_ = fresh_tid(); const int lane = tid_ & 63, gw = blockIdx.x * 8 + (tid_ >> 6), nw = gridDim.x * 8;
    const bool first = (l == 0 && which == 0);
    const float* nwt = (which ? p->norm2_w : p->norm1_w) + l * D;
    const float* mod = (const float*)(ws + O_MOD) + (size_t)l * 33 * 6144 + which * 3072;
    bf16_t* AN = (bf16_t*)(ws + O_AN);
    float4 wv[4];
#pragma unroll
    for (int j = 0; j < 4; ++j) wv[j] = *(const float4*)(nwt + j * 256 + lane * 4);
    auto src_of = [&](int lr) -> const float* {
        const bool isctx = ctxall || lr >= ML;
        const size_t grow = ctxall ? (size_t)lr : (isctx ? (size_t)g * MC + (lr - ML) : (size_t)g * ML + lr);
        return (first ? (isctx ? p->ctx : p->x) : (isctx ? (const float*)(ws + O_HC) : (const float*)p->out)) + grow * D;
    };
    float4 v[4], nx[4];
    if (gw < Mrows) { const float* src = src_of(gw);
#pragma unroll
        for (int j = 0; j < 4; ++j) v[j] = *(const float4*)(src + j * 256 + lane * 4); }
    for (int lr = gw; lr < Mrows; lr += nw) {
        if (lr + nw < Mrows) { const float* src = src_of(lr + nw);
#pragma unroll
            for (int j = 0; j < 4; ++j) nx[j] = *(const float4*)(src + j * 256 + lane * 4); }
        const bool isctx = ctxall || lr >= ML;
        const float* mr = mod + (size_t)(isctx ? 32 : g * GB + (lr >> 11)) * 6144;
        float ss = 0.f;
#pragma unroll
        for (int j = 0; j < 4; ++j) ss += v[j].x * v[j].x + v[j].y * v[j].y + v[j].z * v[j].z + v[j].w * v[j].w;
        ss = wave_sum(ss);
        const float rs = rsqrtf(ss * (1.f / 1024.f) + EPS);
#pragma unroll
        for (int j = 0; j < 4; ++j) {
            const int col = j * 256 + lane * 4;
            const float4 w = wv[j], sh = *(const float4*)(mr + col), sc = *(const float4*)(mr + 1024 + col);
            uint2 o; o.x = pack2(v[j].x * rs * w.x * (1.f + sc.x) + sh.x, v[j].y * rs * w.y * (1.f + sc.y) + sh.y);
            o.y = pack2(v[j].z * rs * w.z * (1.f + sc.z) + sh.z, v[j].w * rs * w.w * (1.f + sc.w) + sh.w);
            *(uint2*)(AN + (size_t)lr * D + col) = o;
        }
#pragma unroll
        for (int j = 0; j < 4; ++j) v[j] = nx[j];
    }
}

__device__ void phase_mixprep(CP p, int g, int l, bool last, bool do_qk) {
    unsigned char* ws = p->ws; const int tid_ = fresh_tid(); const int lane = tid_ & 63, gw = blockIdx.x * 8 + (tid_ >> 6), nw = gridDim.x * 8;
    bf16_t* U = (bf16_t*)(ws + O_U); bf16_t* XB = (bf16_t*)(ws + O_XBCS); float* DTS = (float*)(ws + O_DTS); float* DECS = (float*)(ws + O_DECS);
    bf16_t* YC = (bf16_t*)(ws + O_YBR); const float* tab = (const float*)(ws + O_ROPE);
    const float* cw = p->conv_mix_w + (size_t)l * 3 * D; const float* sw = p->ssd_conv_w + (size_t)l * 3 * XW; const float* sb = p->ssd_conv_b + (size_t)l * XW;
    const int RP = (M + nw - 1) / nw; const int lr0 = gw * RP, lr1 = min(lr0 + RP, M);
    {
        float wv[2][3][8], pcx[2][8], ccx[2][8], ncx[2][8];
#pragma unroll
        for (int j = 0; j < 2; ++j)
#pragma unroll
            for (int k = 0; k < 3; ++k)
#pragma unroll
                for (int i = 0; i < 8; ++i) wv[j][k][i] = cw[k * D + (lane + 64 * j) * 8 + i];
        auto load_cx = [&](int lr, float (&cx)[2][8]) {
            if (lr < 0 || lr >= M) {
#pragma unroll
                for (int i = 0; i < 8; ++i) { cx[0][i] = 0.f; cx[1][i] = 0.f; }
                return; }
            const bf16_t* u = U + (size_t)lr * UC;
#pragma unroll
            for (int j = 0; j < 2; ++j) { const int ch = (lane + 64 * j) * 8; float c8[8], x8[8]; unpack8(*(const uint4*)(u + cCC + ch), c8); unpack8(*(const uint4*)(u + cCX + ch), x8);
#pragma unroll
                for (int i = 0; i < 8; ++i) cx[j][i] = c8[i] * x8[i]; }
        };
        if (lr0 < M) { load_cx(lr0 - 1, pcx); load_cx(lr0, ccx); }
        for (int lr = lr0; lr < lr1; ++lr) {
            load_cx(lr + 1, ncx);
            const bool isctx = lr >= ML; const int t = isctx ? ((lr - ML) & 255) : (lr & 2047); const int Ls = isctx ? 256 : 2048;
            const float mp = t > 0 ? 1.f : 0.f, mn = t < Ls - 1 ? 1.f : 0.f;
            if (!(isctx && last)) {
                const bf16_t* u0 = U + (size_t)lr * UC;
#pragma unroll
                for (int j = 0; j < 2; ++j) { const int ch = (lane + 64 * j) * 8;
                    float cb[8]; unpack8(*(const uint4*)(u0 + cCB + ch), cb);
                    float o[8];
#pragma unroll
                    for (int i = 0; i < 8; ++i) o[i] = cb[i] * (wv[j][0][i] * (pcx[j][i] * mp) + wv[j][1][i] * ccx[j][i] + wv[j][2][i] * (ncx[j][i] * mn));
                    bf16_t* yo = isctx ? (bf16_t*)(ws + O_YBRC) + ((size_t)g * MC + (lr - ML)) * D : YC + (size_t)lr * D;
                    *(uint4*)(yo + ch) = pack8(o); }
            }
#pragma unroll
            for (int i = 0; i < 8; ++i)
#pragma unroll
                for (int j = 0; j < 2; ++j) { pcx[j][i] = ccx[j][i]; ccx[j][i] = ncx[j][i]; }
        }
    }
    float sv[3][4][8], pxb[3][8], cxb[3][8], nxb[3][8];
#pragma unroll
    for (int j = 0; j < 3; ++j)
#pragma unroll
        for (int i = 0; i < 8; ++i) { const int ch = (lane + 64 * j) * 8 + i; sv[j][0][i] = sw[ch]; sv[j][1][i] = sw[XW + ch]; sv[j][2][i] = sw[2 * XW + ch]; sv[j][3][i] = sb[ch]; }
    auto load_xb = [&](int lr, float (&xb)[3][8]) {
        if (lr < 0 || lr >= M) {
#pragma unroll
            for (int i = 0; i < 8; ++i) { xb[0][i] = 0.f; xb[1][i] = 0.f; xb[2][i] = 0.f; }
            return; }
        const bf16_t* u = U + (size_t)lr * UC;
#pragma unroll
        for (int j = 0; j < 3; ++j) unpack8(*(const uint4*)(u + cXBC + (lane + 64 * j) * 8), xb[j]);
    };
    if (lr0 < M) { load_xb(lr0 - 1, pxb); load_xb(lr0, cxb); }
    for (int lr = lr0; lr < lr1; ++lr) {
        load_xb(lr + 1, nxb);
        const bool isctx = lr >= ML; const int t = isctx ? ((lr - ML) & 255) : (lr & 2047); const int Ls = isctx ? 256 : 2048;
        const float mp = t > 0 ? 1.f : 0.f, mn = t < Ls - 1 ? 1.f : 0.f;
        bf16_t* u0 = U + (size_t)lr * UC;
#pragma unroll
        for (int j = 0; j < 3; ++j) { const int ch = (lane + 64 * j) * 8; float o[8];
#pragma unroll
            for (int i = 0; i < 8; ++i) o[i] = silu_f(sv[j][3][i] + sv[j][0][i] * (pxb[j][i] * mp) + sv[j][1][i] * cxb[j][i] + sv[j][2][i] * (nxb[j][i] * mn));
            *(uint4*)(XB + (size_t)lr * XW + ch) = pack8(o); }
#pragma unroll
        for (int i = 0; i < 8; ++i)
#pragma unroll
            for (int j = 0; j < 3; ++j) { pxb[j][i] = cxb[j][i]; cxb[j][i] = nxb[j][i]; }
        if (lane < 32) {
            const float raw = bflo((unsigned)u0[cDT + lane]) + p->ssd_dt_bias[l * 32 + lane];
            const float dt = fmaxf(raw, 0.f) + log1pf(__expf(-fabsf(raw)));
            const float A = -__expf(p->ssd_a_log[l * 32 + lane]);
            DTS[(size_t)lr * 32 + lane] = dt; DECS[(size_t)lr * 32 + lane] = dt * A;
        }
        if (do_qk) {
            const int hd = lane >> 2, i0 = (lane & 3) * 4;
            float cr[4], cc[4], sr[4], sc[4];
#pragma unroll
            for (int i = 0; i < 4; ++i) { cr[i] = 1.f; cc[i] = 1.f; sr[i] = 0.f; sc[i] = 0.f; }
            if (!isctx) { const float* tb = tab + t * 64;
#pragma unroll
                for (int i = 0; i < 4; ++i) { cr[i] = tb[i0 + i]; cc[i] = tb[16 + i0 + i]; sr[i] = tb[32 + i0 + i]; sc[i] = tb[48 + i0 + i]; } }
#pragma unroll
            for (int qk = 0; qk < 2; ++qk) {
                if (qk == 1 && isctx) break;
                bf16_t* base = u0 + (qk ? cK : cQ) + hd * 64 + i0; const float scl = qk ? 1.f : 0.125f;
                const uint2 v0 = *(const uint2*)(base), v1 = *(const uint2*)(base + 16), v2 = *(const uint2*)(base + 32), v3 = *(const uint2*)(base + 48);
                const float a[4] = {bflo(v0.x), bfhi(v0.x), bflo(v0.y), bfhi(v0.y)}, b[4] = {bflo(v1.x), bfhi(v1.x), bflo(v1.y), bfhi(v1.y)};
                const float c2[4] = {bflo(v2.x), bfhi(v2.x), bflo(v2.y), bfhi(v2.y)}, d2[4] = {bflo(v3.x), bfhi(v3.x), bflo(v3.y), bfhi(v3.y)};
                float oa[4], ob[4], oc[4], od[4];
#pragma unroll
                for (int i = 0; i < 4; ++i) { oa[i] = (a[i] * cr[i] - b[i] * sr[i]) * scl; ob[i] = (b[i] * cr[i] + a[i] * sr[i]) * scl;
                    oc[i] = (c2[i] * cc[i] - d2[i] * sc[i]) * scl; od[i] = (d2[i] * cc[i] + c2[i] * sc[i]) * scl; }
                *(uint2*)(base) = make_uint2(pack2(oa[0], oa[1]), pack2(oa[2], oa[3])); *(uint2*)(base + 16) = make_uint2(pack2(ob[0], ob[1]), pack2(ob[2], ob[3]));
                *(uint2*)(base + 32) = make_uint2(pack2(oc[0], oc[1]), pack2(oc[2], oc[3])); *(uint2*)(base + 48) = make_uint2(pack2(od[0], od[1]), pack2(od[2], od[3]));
            }
        }
    }
}

__device__ void phase_scan(CP p, bool ctx_out, unsigned char* ldsb) {
    unsigned char* ws = p->ws; const int tid = fresh_tid(); const int lane = tid & 63, w = tid >> 6, fr = lane & 15, fq = lane >> 4;
    const int lt = w < 4 ? w : 11 - w;
    const bf16_t* XB = (const bf16_t*)(ws + O_XBCS); const float* DTS = (const float*)(ws + O_DTS); const float* AS = (const float*)(ws + O_DECS);
    bf16_t* YD = (bf16_t*)(ws + O_YDIR);
    constexpr int PT = 136;
    bf16_t* XT = (bf16_t*)ldsb; bf16_t* BT = XT + 64 * PT; bf16_t* HL = BT + 128 * PT; bf16_t* BR = HL + 64 * PT; float* CUM = (float*)(BR + 128 * PT);
    typedef unsigned u32x4 __attribute__((ext_vector_type(4)));
    for (int item = blockIdx.x; item < GB * 32; item += gridDim.x) {
        const int dir = item & 1, head = (item >> 1) & 15, bl = item >> 5, grp = head >> 3;
        auto row_of = [&](int s) -> int { return s < 256 ? (ML + bl * 256 + (dir ? 255 - s : s)) : (bl * 2048 + (dir ? 2047 - (s - 256) : (s - 256))); };
        f32x4 hacc[4];
#pragma unroll
        for (int i = 0; i < 4; ++i) hacc[i] = (f32x4){0.f, 0.f, 0.f, 0.f};
        __syncthreads();
        for (int i = tid; i < 64 * PT / 2; i += 512) ((unsigned*)HL)[i] = 0u;
        uint4 rx[2], rb[4]; float rdt[2], ra[2];
        auto load_chunk = [&](int ch) {
#pragma unroll
            for (int q = 0; q < 2; ++q) { const int lr = row_of(ch * 128 + 2 * lane + q); const bf16_t* row = XB + (size_t)lr * XW;
                rx[q] = *(const uint4*)(row + head * 64 + w * 8); rb[2 * q] = *(const uint4*)(row + 1024 + grp * 128 + w * 16); rb[2 * q + 1] = *(const uint4*)(row + 1024 + grp * 128 + w * 16 + 8);
                rdt[q] = DTS[(size_t)lr * 32 + dir * 16 + head]; ra[q] = AS[(size_t)lr * 32 + dir * 16 + head]; }
        };
        load_chunk(0);
        for (int ch = 0; ch < 18; ++ch) {
            const bool doy = ctx_out || ch >= 2;
            const int lrl = row_of(ch * 128 + 16 * lt + fr);
            bf16x8 cf[4];
            if (doy) { const bf16_t* cp = XB + (size_t)lrl * XW + 1280 + grp * 128 + fq * 8;
#pragma unroll
                for (int k = 0; k < 4; ++k) cf[k] = *(const bf16x8*)(cp + k * 32); }
            const float ps = ra[0] + ra[1]; float incl = ps;
#pragma unroll
            for (int o = 1; o < 64; o <<= 1) { const float t = __shfl_up(incl, o); if (lane >= o) incl += t; }
            const float c0 = incl - ra[1], c1 = incl, total = __int_as_float(__builtin_amdgcn_readlane(__float_as_int(incl), 63));
            const float w0 = __expf(total - c0), w1 = __expf(total - c1), dec_total = __expf(total);
            if (w == 0) { CUM[2 * lane] = c0; CUM[2 * lane + 1] = c1; }
            { float x0[8], x1[8]; unpack8(rx[0], x0); unpack8(rx[1], x1);
#pragma unroll
              for (int i = 0; i < 8; ++i) ((unsigned*)(XT + (w * 8 + i) * PT))[lane] = pack2(x0[i] * rdt[0], x1[i] * rdt[1]); }
#pragma unroll
            for (int q = 0; q < 2; ++q) { *(uint4*)(BR + (2 * lane + q) * PT + w * 16) = rb[2 * q]; *(uint4*)(BR + (2 * lane + q) * PT + w * 16 + 8) = rb[2 * q + 1]; }
#pragma unroll
            for (int hh = 0; hh < 2; ++hh) { float b0[8], b1[8]; unpack8(rb[hh], b0); unpack8(rb[2 + hh], b1);
#pragma unroll
                for (int i = 0; i < 8; ++i) ((unsigned*)(BT + (w * 16 + hh * 8 + i) * PT))[lane] = pack2(b0[i] * w0, b1[i] * w1); }
            __syncthreads();
            if (ch + 1 < 18) load_chunk(ch + 1);
            if (doy) {
                const float cl = CUM[16 * lt + fr]; const float ecl = __expf(cl);
                f32x4 yacc[4];
#pragma unroll
                for (int pt = 0; pt < 4; ++pt) { f32x4 acc = (f32x4){0.f, 0.f, 0.f, 0.f};
#pragma unroll
                    for (int k = 0; k < 4; ++k) acc = __builtin_amdgcn_mfma_f32_16x16x32_bf16(*(const bf16x8*)(HL + (pt * 16 + fr) * PT + k * 32 + fq * 8), cf[k], acc, 0, 0, 0);
                    yacc[pt] = acc * ecl; }
                const int lidx = 16 * lt + fr;
#pragma unroll
                for (int sb = 0; sb < 4; ++sb) if (sb <= (lt >> 1)) {
                    f32x4 gt[2];
#pragma unroll
                    for (int t = 0; t < 2; ++t) { const int srow = sb * 32 + (fr >> 2) * 8 + t * 4 + (fr & 3);
                        const bf16_t* bp = BR + srow * PT + fq * 8; f32x4 acc = (f32x4){0.f, 0.f, 0.f, 0.f};
#pragma unroll
                        for (int k = 0; k < 4; ++k) acc = __builtin_amdgcn_mfma_f32_16x16x32_bf16(*(const bf16x8*)(bp + k * 32), cf[k], acc, 0, 0, 0);
                        gt[t] = acc; }
                    const float4 cs0 = *(const float4*)(CUM + sb * 32 + fq * 8), cs1 = *(const float4*)(CUM + sb * 32 + fq * 8 + 4);
                    const float csv[8] = {cs0.x, cs0.y, cs0.z, cs0.w, cs1.x, cs1.y, cs1.z, cs1.w};
                    float e[8];
#pragma unroll
                    for (int i = 0; i < 8; ++i) { const int sidx = sb * 32 + fq * 8 + i; e[i] = sidx <= lidx ? gt[i >> 2][i & 3] * __expf(fminf(cl - csv[i], 0.f)) : 0.f; }
                    const u32x4 pk = {pack2(e[0], e[1]), pack2(e[2], e[3]), pack2(e[4], e[5]), pack2(e[6], e[7])};
                    const bf16x8 pb = __builtin_bit_cast(bf16x8, pk);
#pragma unroll
                    for (int pt = 0; pt < 4; ++pt) yacc[pt] = __builtin_amdgcn_mfma_f32_16x16x32_bf16(*(const bf16x8*)(XT + (pt * 16 + fr) * PT + sb * 32 + fq * 8), pb, yacc[pt], 0, 0, 0);
                }
                bf16_t* op = YD + ((size_t)dir * M + lrl) * D + head * 64 + fq * 4;
#pragma unroll
                for (int pt = 0; pt < 4; ++pt) *(uint2*)(op + pt * 16) = make_uint2(pack2(yacc[pt][0], yacc[pt][1]), pack2(yacc[pt][2], yacc[pt][3]));
            }
#pragma unroll
            for (int pt = 0; pt < 4; ++pt) hacc[pt] *= dec_total;
#pragma unroll
            for (int k = 0; k < 4; ++k) { const bf16x8 bfr = *(const bf16x8*)(BT + (16 * w + fr) * PT + k * 32 + fq * 8);
#pragma unroll
                for (int pt = 0; pt < 4; ++pt) hacc[pt] = __builtin_amdgcn_mfma_f32_16x16x32_bf16(*(const bf16x8*)(XT + (pt * 16 + fr) * PT + k * 32 + fq * 8), bfr, hacc[pt], 0, 0, 0); }
            __syncthreads();
#pragma unroll
            for (int pt = 0; pt < 4; ++pt)
#pragma unroll
                for (int j = 0; j < 4; ++j) HL[(pt * 16 + fq * 4 + j) * PT + 16 * w + fr] = (bf16_t)f2bf(hacc[pt][j]);
        }
    }
}

__device__ void phase_vtrans(CP p, unsigned* lds) {
    unsigned char* ws = p->ws; const int tid = fresh_tid();
    const bf16_t* U = (const bf16_t*)(ws + O_U); bf16_t* VT = (bf16_t*)(ws + O_VT);
    constexpr int P = 130;
    uint4 tv[4];
    auto tile_load = [&](int tile) {
        const int cg4 = tile & 3, tt = (tile >> 2) % 36, bl = tile / 144;
        const int row0 = tt < 32 ? bl * 2048 + tt * 64 : ML + bl * 256 + (tt - 32) * 64;
#pragma unroll
        for (int i = 0; i < 4; ++i) { const int idx = i * 512 + tid, rr = idx >> 5, ck = idx & 31; tv[i] = *(const uint4*)(U + (size_t)(row0 + rr) * UC + cV + cg4 * 256 + ck * 8); }
    };
    if ((int)blockIdx.x < GB * 36 * 4) tile_load(blockIdx.x);
    for (int tile = blockIdx.x; tile < GB * 36 * 4; tile += gridDim.x) {
        const int cg4 = tile & 3, tt = (tile >> 2) % 36, bl = tile / 144;
        __syncthreads();
#pragma unroll
        for (int i = 0; i < 4; ++i) { const int idx = i * 512 + tid, rr = idx >> 5, ck = idx & 31; const uint4 v = tv[i];
            *(uint2*)(lds + rr * P + ck * 4) = make_uint2(v.x, v.y); *(uint2*)(lds + rr * P + ck * 4 + 2) = make_uint2(v.z, v.w); }
        __syncthreads();
        if (tile + (int)gridDim.x < GB * 36 * 4) tile_load(tile + gridDim.x);
        const unsigned short* l16 = (const unsigned short*)lds;
#pragma unroll
        for (int k = 0; k < 4; ++k) { const int col = (tid >> 3) + 64 * k, tg = tid & 7;
            unsigned w[4];
#pragma unroll
            for (int i = 0; i < 4; ++i) { const unsigned lo = l16[(tg * 8 + 2 * i) * (2 * P) + col], hi = l16[(tg * 8 + 2 * i + 1) * (2 * P) + col]; w[i] = lo | (hi << 16); }
            const int head = cg4 * 4 + (col >> 6), d = col & 63;
            *(uint4*)(VT + ((size_t)((bl * 16 + head) * 64 + d)) * 2304 + tt * 64 + tg * 8) = make_uint4(w[0], w[1], w[2], w[3]); }
    }
}

constexpr int ATT_KP = 72, ATT_VP = 264;
constexpr int ATT_LK = 0, ATT_LV = ATT_LK + 256 * ATT_KP * 2, ATT_LB = ATT_LV + 64 * ATT_VP * 2;
constexpr int ATT_KB = 72704;
constexpr int ATT_LDS_END = ATT_KB + 9 * 64 * 128;
__device__ __forceinline__ int att_kb_off(int key, int c) { const int f = ((key >> 1) & 1) | (((key >> 3) & 3) << 1); return key * 128 + ((c ^ f) << 4); }

template <bool MASK>
__device__ __forceinline__ void attn_chunk(const bf16x8 (&kc)[2][2][2], const bf16x8 (&vv)[2][4], const bf16x8 q0, const bf16x8 q1, f32x4 (&oacc)[4], float& mrun, float& lrun,
                                           const float* rpl, int dr0, int w0, int c, int cs, int fq) {
    f32x4 sc[2][2];
#pragma unroll
    for (int b = 0; b < 2; ++b) {
#pragma unroll
        for (int t = 0; t < 2; ++t) { f32x4 a = (f32x4){0.f, 0.f, 0.f, 0.f};
            a = __builtin_amdgcn_mfma_f32_16x16x32_bf16(kc[b][t][0], q0, a, 0, 0, 0);
            a = __builtin_amdgcn_mfma_f32_16x16x32_bf16(kc[b][t][1], q1, a, 0, 0, 0);
            sc[b][t] = a; }
        if (MASK) {
            const int dr = dr0 + b * 31;
#pragma unroll
            for (int t = 0; t < 2; ++t)
#pragma unroll
                for (int j = 0; j < 4; ++j) { const int kcol = w0 + fq * 8 + t * 4 + j; const bool ok = (unsigned)(kcol - cs) < 16u; const int dci = ok ? kcol - c + 15 : 15;
                    const float bias = rpl[dr + dci]; sc[b][t][j] = ok ? sc[b][t][j] + bias : -1e30f; }
        }
    }
    float mx = -1e30f;
#pragma unroll
    for (int b = 0; b < 2; ++b)
#pragma unroll
        for (int t = 0; t < 2; ++t)
#pragma unroll
            for (int j = 0; j < 4; ++j) mx = fmaxf(mx, sc[b][t][j]);
    mx = x16_max(mx); mx = x32_max(mx);
    const float mnew = fmaxf(mrun, mx), corr = __expf(mrun - mnew);
    lrun *= corr; mrun = mnew;
#pragma unroll
    for (int i = 0; i < 4; ++i) oacc[i] *= corr;
#pragma unroll
    for (int b = 0; b < 2; ++b) {
        float e[8];
#pragma unroll
        for (int t = 0; t < 2; ++t)
#pragma unroll
            for (int j = 0; j < 4; ++j) { e[t * 4 + j] = __expf(sc[b][t][j] - mnew); lrun += e[t * 4 + j]; }
        const u32x4_t pk = {pack2(e[0], e[1]), pack2(e[2], e[3]), pack2(e[4], e[5]), pack2(e[6], e[7])};
        const bf16x8 pb = __builtin_bit_cast(bf16x8, pk);
#pragma unroll
        for (int dt = 0; dt < 4; ++dt) oacc[dt] = __builtin_amdgcn_mfma_f32_16x16x32_bf16(vv[b][dt], pb, oacc[dt], 0, 0, 0);
    }
}

template <bool LAT>
__device__ __forceinline__ void attn_wave_item(const bf16_t* __restrict__ U, const bf16_t* __restrict__ VT, bf16_t* __restrict__ YN, const unsigned char* ldsb,
                                               int bl, int head, int r, int jq, int lane, int rb0) {
    const int fr = lane & 15, fq = lane >> 4;
    const float* rpl = (const float*)(ldsb + ATT_LB);
    int lrq0, r0 = 0, w0 = 0, c = 0, cs = 0;
    if (LAT) { lrq0 = bl * 2048 + r * 64 + jq * 16; r0 = min(max(r - 4, 0), 24); w0 = jq == 0 ? 0 : (jq == 1 ? 8 : (jq == 2 ? 24 : 32)); c = jq * 16 + fr; cs = min(max(c - 8, 0), 48); }
    else lrq0 = ML + bl * 256 + jq * 16;
    const bf16_t* qp = U + (size_t)(lrq0 + fr) * UC + cQ + head * 64 + fq * 8;
    const bf16x8 q0 = *(const bf16x8*)qp, q1 = *(const bf16x8*)(qp + 32);
    f32x4 oacc[4];
#pragma unroll
    for (int i = 0; i < 4; ++i) oacc[i] = (f32x4){0.f, 0.f, 0.f, 0.f};
    float mrun = -1e30f, lrun = 0.f;
    const int kapl = (fr >> 2) * 8 + (fr & 3);
    bf16x8 kc[2][2][2], vv[2][4];
    if (LAT) {
        const bf16_t* Vh = VT + (size_t)(bl * 16 + head) * 64 * 2304;
        unsigned vov[4];
#pragma unroll
        for (int dt = 0; dt < 4; ++dt) vov[dt] = (unsigned)((fr + 16 * dt) * 2304 + fq * 8);
        unsigned vto = (unsigned)(r0 * 64 + w0);
        const unsigned vstep = 64u;
        const unsigned char* KB = ldsb + ATT_KB;
#pragma unroll 1
        for (int ch = 0; ch < 4; ++ch) {
#pragma unroll
            for (int b = 0; b < 2; ++b)
#pragma unroll
                for (int dt = 0; dt < 4; ++dt) vv[b][dt] = *(const bf16x8*)(Vh + (vto + b * vstep + vov[dt]));
            vto += 2 * vstep;
#pragma unroll
            for (int b = 0; b < 2; ++b)
#pragma unroll
                for (int t = 0; t < 2; ++t) { const int key = (r0 - rb0 + ch * 2 + b) * 64 + w0 + kapl + 4 * t;
                    kc[b][t][0] = *(const bf16x8*)(KB + att_kb_off(key, fq)); kc[b][t][1] = *(const bf16x8*)(KB + att_kb_off(key, fq + 4)); }
            attn_chunk<true>(kc, vv, q0, q1, oacc, mrun, lrun, rpl, (r0 + ch * 2 - r + 7) * 31, w0, c, cs, fq);
        }
    }
    const bf16_t* LK = (const bf16_t*)(ldsb + ATT_LK) + kapl * ATT_KP + fq * 8;
    const bf16_t* LV = (const bf16_t*)(ldsb + ATT_LV) + fr * ATT_VP + fq * 8;
#pragma unroll 1
    for (int ch = 0; ch < 4; ++ch) {
#pragma unroll
        for (int b = 0; b < 2; ++b) {
#pragma unroll
            for (int t = 0; t < 2; ++t) { const bf16_t* kp = LK + ((ch * 2 + b) * 32 + 4 * t) * ATT_KP; kc[b][t][0] = *(const bf16x8*)kp; kc[b][t][1] = *(const bf16x8*)(kp + 32); }
#pragma unroll
            for (int dt = 0; dt < 4; ++dt) vv[b][dt] = *(const bf16x8*)(LV + dt * 16 * ATT_VP + (ch * 2 + b) * 32);
        }
        attn_chunk<false>(kc, vv, q0, q1, oacc, mrun, lrun, rpl, 0, 0, 0, 0, fq);
    }
    lrun = x16_sum(lrun); lrun = x32_sum(lrun);
    const float inv = 1.f / lrun;
    bf16_t* op = YN + (size_t)(lrq0 + fr) * D + head * 64 + fq * 4;
#pragma unroll
    for (int dt = 0; dt < 4; ++dt) *(uint2*)(op + dt * 16) = make_uint2(pack2(oacc[dt][0] * inv, oacc[dt][1] * inv), pack2(oacc[dt][2] * inv, oacc[dt][3] * inv));
}

__device__ void phase_attn(CP p, int g, int l, bool do_ctx, unsigned char* ldsb) {
    unsigned char* ws = p->ws; const int tid = fresh_tid(); const int lane = tid & 63, wid = tid >> 6;
    const bf16_t* U = (const bf16_t*)(ws + O_U); const bf16_t* VT = (const bf16_t*)(ws + O_VT); bf16_t* YN = (bf16_t*)(ws + O_YBR) + (size_t)2 * M * D;
    const int G = gridDim.x, cb = blockIdx.x;
    const int nlat = GB * 16 * 16, nctx = do_ctx ? GB * 16 * 2 : 0;
    const int perl = (nlat + G - 1) / G, perc = (nctx + G - 1) / G;
    int cur = -1;
    for (int k = 0; k < perl + perc; ++k) {
        const bool lat = k < perl;
        const int item = lat ? cb * perl + k : cb * perc + (k - perl);
        if (item >= (lat ? nlat : nctx)) continue;
        const int bh = lat ? (item >> 4) : (item >> 1);
        const int bl = bh >> 4, head = bh & 15;
        if (bh != cur) {
            cur = bh;
            __syncthreads();
#pragma unroll
            for (int i = 0; i < 4; ++i) { const int idx = i * 512 + tid;
                { const int key = idx >> 3, part = idx & 7;
                  *(uint4*)((bf16_t*)(ldsb + ATT_LK) + key * ATT_KP + part * 8) = *(const uint4*)(U + (size_t)(ML + bl * 256 + key) * UC + cK + head * 64 + part * 8); }
                { const int d = idx >> 5, part = idx & 31;
                  *(uint4*)((bf16_t*)(ldsb + ATT_LV) + d * ATT_VP + part * 8) = *(const uint4*)(VT + ((size_t)(bh * 64 + d)) * 2304 + 2048 + part * 8); } }
            if (tid < 465) ((float*)(ldsb + ATT_LB))[tid] = p->na_rpb[(size_t)(l * 16 + head) * 465 + tid];
            __syncthreads();
        }
        if (lat) {
            const int rp = item & 15, rb0 = min(max(2 * rp - 4, 0), 24);
            __syncthreads();
#pragma unroll
            for (int i = 0; i < 9; ++i) { const int idx = i * 512 + tid, key = idx >> 3, cc = idx & 7; const int brow = rb0 + (key >> 6);
                if (brow < 32) *(uint4*)(ldsb + ATT_KB + att_kb_off(key, cc)) = *(const uint4*)(U + (size_t)(bl * 2048 + brow * 64 + (key & 63)) * UC + cK + head * 64 + cc * 8); }
            __syncthreads();
            attn_wave_item<true>(U, VT, YN, ldsb, bl, head, rp * 2 + (wid >> 2), wid & 3, lane, rb0);
        }
        else attn_wave_item<false>(U, VT, (bf16_t*)(ws + O_YBRC) + ((size_t)2 * NCTX + (size_t)g * MC) * D - (size_t)ML * D, ldsb, bl, head, 0, (item & 1) * 8 + wid, lane, 0);
    }
}

__device__ void phase_ssdfin(CP p, int g, int l, int Mrows) {
    unsigned char* ws = p->ws; const int tid_ = fresh_tid(); const int lane = tid_ & 63, gw = blockIdx.x * 8 + (tid_ >> 6), nw = gridDim.x * 8;
    const bf16_t* U = (const bf16_t*)(ws + O_U); const bf16_t* XB = (const bf16_t*)(ws + O_XBCS); const bf16_t* YD = (const bf16_t*)(ws + O_YDIR);
    bf16_t* YS = (bf16_t*)(ws + O_YBR) + (size_t)M * D;
    const int head = lane >> 2; const float dsum = p->ssd_d[l * 32 + head] + p->ssd_d[l * 32 + 16 + head];
    float nwr[16];
#pragma unroll
    for (int i = 0; i < 16; ++i) nwr[i] = p->ssd_norm_w[l * D + lane * 16 + i];
    uint4 cu[2][4], nx[2][4];
    auto load_in = [&](int lr, uint4 (&d)[2][4]) {
#pragma unroll
        for (int j = 0; j < 2; ++j) { const int ch = lane * 16 + j * 8;
            d[j][0] = *(const uint4*)(YD + (size_t)lr * D + ch); d[j][1] = *(const uint4*)(YD + ((size_t)M + lr) * D + ch);
            d[j][2] = *(const uint4*)(XB + (size_t)lr * XW + ch); d[j][3] = *(const uint4*)(U + (size_t)lr * UC + cZ + ch); }
    };
    if (gw < Mrows) load_in(gw, cu);
    for (int lr = gw; lr < Mrows; lr += nw) {
        if (lr + nw < Mrows) load_in(lr + nw, nx);
        float v[16]; float ss = 0.f;
#pragma unroll
        for (int j = 0; j < 2; ++j) {
            float y0[8], y1[8], xs[8], z[8];
            unpack8(cu[j][0], y0); unpack8(cu[j][1], y1); unpack8(cu[j][2], xs); unpack8(cu[j][3], z);
#pragma unroll
            for (int i = 0; i < 8; ++i) { const float t = (y0[i] + y1[i] + xs[i] * dsum) * silu_f(z[i]); v[j * 8 + i] = t; ss += t * t; } }
#pragma unroll
        for (int o = 16; o; o >>= 1) ss += __shfl_xor(ss, o);
        const float rs = rsqrtf(ss * (1.f / 512.f) + EPS);
#pragma unroll
        for (int j = 0; j < 2; ++j) { const int ch = lane * 16 + j * 8; float o8[8];
#pragma unroll
            for (int i = 0; i < 8; ++i) o8[i] = v[j * 8 + i] * rs * nwr[j * 8 + i];
            bf16_t* yo = lr >= ML ? (bf16_t*)(ws + O_YBRC) + ((size_t)NCTX + (size_t)g * MC + (lr - ML)) * D : YS + (size_t)lr * D;
            *(uint4*)(yo + ch) = pack8(o8); }
        if (lr >= ML) {
            const bf16_t* gs_ = U + (size_t)lr * UC + cGATE; bf16_t* gd = (bf16_t*)(ws + O_GATEC) + ((size_t)g * MC + (lr - ML)) * 3072;
#pragma unroll
            for (int j = 0; j < 6; ++j) *(uint4*)(gd + (j * 64 + lane) * 8) = *(const uint4*)(gs_ + (j * 64 + lane) * 8);
        }
#pragma unroll
        for (int j = 0; j < 2; ++j)
#pragma unroll
            for (int k = 0; k < 4; ++k) cu[j][k] = nx[j][k];
    }
}

__device__ void phase_final(CP p, int g) {
    const int tid_ = fresh_tid(); const int lane = tid_ & 63, gw = blockIdx.x * 8 + (tid_ >> 6), nw = gridDim.x * 8;
    float4 wv[4], v[4], nx[4];
#pragma unroll
    for (int j = 0; j < 4; ++j) wv[j] = *(const float4*)(p->final_norm_w + j * 256 + lane * 4);
    float* base = p->out + (size_t)g * ML * D;
    if (gw < ML) {
#pragma unroll
        for (int j = 0; j < 4; ++j) v[j] = *(const float4*)(base + (size_t)gw * D + j * 256 + lane * 4); }
    for (int lr = gw; lr < ML; lr += nw) {
        float* hrow = base + (size_t)lr * D;
        if (lr + nw < ML) {
#pragma unroll
            for (int j = 0; j < 4; ++j) nx[j] = *(const float4*)(hrow + (size_t)nw * D + j * 256 + lane * 4); }
        float ss = 0.f;
#pragma unroll
        for (int j = 0; j < 4; ++j) ss += v[j].x * v[j].x + v[j].y * v[j].y + v[j].z * v[j].z + v[j].w * v[j].w;
        ss = wave_sum(ss);
        const float rs = rsqrtf(ss * (1.f / 1024.f) + EPS);
#pragma unroll
        for (int j = 0; j < 4; ++j) { const int col = j * 256 + lane * 4; const float4 w = wv[j];
            *(float4*)(hrow + col) = make_float4(v[j].x * rs * w.x, v[j].y * rs * w.y, v[j].z * rs * w.z, v[j].w * rs * w.w); }
#pragma unroll
        for (int j = 0; j < 4; ++j) v[j] = nx[j];
    }
}

#define XB_TMO      128
#define XB_XCNT(j)  (256  + 64 * (j))
#define XB_XSUB(j)  (1280 + 64 * (j))
#define XB_XGEN(j)  (2304 + 64 * (j))
#define XB_TOP      3328
#define XB_TOPGEN   3392
#define XCD_BAR_WORDS 3456
#define XB_SPIN_CAP (1u << 20)
__device__ __forceinline__ unsigned xb_ld(unsigned* p)              { return __hip_atomic_load(p, __ATOMIC_RELAXED, __HIP_MEMORY_SCOPE_AGENT); }
__device__ __forceinline__ unsigned xb_add(unsigned* p, unsigned v) { return __hip_atomic_fetch_add(p, v, __ATOMIC_RELAXED, __HIP_MEMORY_SCOPE_AGENT); }
__device__ __forceinline__ unsigned xb_xcc_id() { return (unsigned)__builtin_amdgcn_s_getreg((3 << 11) | 20) & 0xFu; }
#define XB_SPIN(cond, bar) do { unsigned _sp = 0; while (cond) { __builtin_amdgcn_s_sleep(1); \
    if ((++_sp & 255u) == 0u) { if (xb_ld(&(bar)[XB_TMO])) break; if (_sp > XB_SPIN_CAP) { atomicAdd(&(bar)[XB_TMO], 1u); break; } } } } while (0)
struct XcdBarrier { unsigned* bar; unsigned x; volatile LAS unsigned* st; };
__device__ __forceinline__ XcdBarrier xcd_barrier_post(unsigned* bar, volatile LAS unsigned* st) {
    XcdBarrier b; b.bar = bar; b.x = xb_xcc_id(); b.st = st;
    if (threadIdx.x == 0) (void)xb_add(&bar[XB_XCNT(b.x)], 1u);
    return b;
}
__device__ __forceinline__ void xcd_barrier_complete(unsigned* bar, unsigned x, unsigned& nloc, unsigned& nx) {
    const unsigned G = gridDim.x * gridDim.y * gridDim.z;
    unsigned sum, cnt, mine, sp = 0u;
    for (;;) {
        sum = 0u; cnt = 0u; mine = 0u;
#pragma unroll
        for (unsigned j = 0; j < 16; ++j) { const unsigned c = xb_ld(&bar[XB_XCNT(j)]); sum += c; cnt += (c > 0u) ? 1u : 0u; mine = (j == x) ? c : mine; }
        if (sum == G) break;
        __builtin_amdgcn_s_sleep(1);
        if ((++sp & 255u) == 0u) { if (xb_ld(&bar[XB_TMO])) break; if (sp > XB_SPIN_CAP) { atomicAdd(&bar[XB_TMO], 1u); break; } }
    }
    nloc = mine > 0u ? mine : 1u; nx = cnt > 0u ? cnt : 1u;
}
__device__ __forceinline__ void xcd_barrier(const XcdBarrier& b) {
    asm volatile("s_waitcnt vmcnt(0)" ::: "memory");
    __syncthreads();
    if (threadIdx.x == 0) {
        unsigned* bar = b.bar;
        __builtin_amdgcn_s_waitcnt(0);
        unsigned nloc = b.st[0], nx = b.st[1];
        if (nloc == 0u) { xcd_barrier_complete(bar, b.x, nloc, nx); b.st[0] = nloc; b.st[1] = nx; }
        const unsigned old = xb_add(&bar[XB_XSUB(b.x)], 1u);
        const unsigned gen = old / nloc;
        if (old + 1u == (gen + 1u) * nloc) {
            __builtin_amdgcn_fence(__ATOMIC_RELEASE, "agent");
            asm volatile("s_waitcnt vmcnt(0)" ::: "memory");
            const unsigned og = xb_add(&bar[XB_TOP], 1u);
            const unsigned tg = og / nx;
            if (og + 1u == (tg + 1u) * nx) xb_add(&bar[XB_TOPGEN], 1u);
            else XB_SPIN(xb_ld(&bar[XB_TOPGEN]) == tg, bar);
            __builtin_amdgcn_fence(__ATOMIC_ACQUIRE, "agent");
            xb_add(&bar[XB_XGEN(b.x)], 1u);
            asm volatile("s_waitcnt vmcnt(0)" ::: "memory");
        } else {
            XB_SPIN(xb_ld(&bar[XB_XGEN(b.x)]) == gen, bar);
            __builtin_amdgcn_fence(__ATOMIC_ACQUIRE, "agent");
            asm volatile("s_waitcnt vmcnt(0)" ::: "memory");
        }
    }
    __syncthreads();
}
#define GSYNC() do { xcd_barrier(xb); if (PROBE_DUP == 20) xcd_barrier(xb); } while (0)
__global__ void __launch_bounds__(512, 2) fwd_megakernel(Params p_unused) {
    extern __shared__ __attribute__((aligned(16))) unsigned char shm[];
    cg::grid_group grid = cg::this_grid();
    float* ldsf = (float*)shm; LAS unsigned char* ldsg = (LAS unsigned char*)shm;
    __shared__ uint4 xb_words;
    if (threadIdx.x == 0) xb_words = make_uint4(0u, 0u, 0u, 0u);
    __syncthreads();
    const XcdBarrier xb = xcd_barrier_post((unsigned*)(params_ptr()->ws + O_BAR), (volatile LAS unsigned*)&xb_words);
    DUP(1, phase_prep(params_ptr(), ldsf););
    grid.sync();
    for (int l = 0; l < 2; ++l) {
        const bool last = (l == 1);
        for (int g = 0; g < NG + (last ? 0 : 1); ++g) {
            const bool cchain = (g == NG);
            if (!cchain) {
                if (g == 0) {
                    DUP(2, phase_norm(params_ptr(), g, l, 0, M, false););
                    GSYNC();
                }
                DUP(3, { CP p = params_ptr(); unsigned char* ws = p->ws; const int G = gridDim.x, cb = blockIdx.x;
                  pg8::Gemm gm{(const bf16_t*)(ws + O_AN), (const bf16_t*)(ws + O_WIN + l * SZ_WIN), M, UC, D, 0, 0};
                  pg8::StaticOrder S; S.init(M, UC, G, cb, 1); EpiU E{(bf16_t*)(ws + O_U)}; pg8::gemm_phase(ldsg, gm, S, E); });
                GSYNC();
                DUP(12, phase_mixprep(params_ptr(), g, l, last, rep_ == 0););
                DUP(4, phase_vtrans(params_ptr(), (unsigned*)shm););
                GSYNC();
                DUP(5, phase_scan(params_ptr(), !last, shm););
                DUP(6, phase_attn(params_ptr(), g, l, !last, shm););
                GSYNC();
                DUP(7, phase_ssdfin(params_ptr(), g, l, last ? ML : M););
                GSYNC();
            }
            const int Mr = cchain ? NCTX : ML;
            DUP(8, { CP p = params_ptr(); unsigned char* ws = p->ws; const int G = gridDim.x, cb = blockIdx.x;
              pg8::Gemm gm{(const bf16_t*)(ws + (cchain ? O_YBRC : O_YBR)), (const bf16_t*)(ws + O_WBR + l * SZ_WBR), Mr, D, D, (size_t)(cchain ? NCTX : M) * D * 2, (size_t)D * D * 2};
              pg8::StaticOrder S; S.init(Mr, D, G, cb, 3);
              EpiMerge E{cchain ? (const bf16_t*)(ws + O_GATEC) : (const bf16_t*)(ws + O_U) + cGATE, cchain ? 3072 : UC, (bf16_t*)(ws + O_MRGB)}; pg8::gemm_phase(ldsg, gm, S, E); });
            GSYNC();
            DUP(9, { CP p = params_ptr(); unsigned char* ws = p->ws; const int G = gridDim.x, cb = blockIdx.x;
              const float* modl = (const float*)(ws + O_MOD) + (size_t)l * 33 * 6144;
              float* hl = p->out + (size_t)g * ML * D; float* hc = (float*)(ws + O_HC) + (cchain ? (size_t)0 : (size_t)g * MC * D);
              pg8::Gemm gm{(const bf16_t*)(ws + O_MRGB), (const bf16_t*)(ws + O_WOUT + l * SZ_WOUT), Mr, D, D, 0, 0};
              pg8::StaticOrder S; S.init(Mr, D, G, cb, 1); EpiRes E{hl, hc, modl + 2048, g, rep_ == 0 ? 1.f : 0.f, cchain ? 1 : 0, (l == 0 && rep_ == 0) ? (cchain ? (long)(p->ctx - hc) : (long)((p->x + (size_t)g * ML * D) - hl)) : 0L}; pg8::gemm_phase(ldsg, gm, S, E); });
            GSYNC();
            DUP(10, phase_norm(params_ptr(), g, l, 1, Mr, cchain););
            GSYNC();
            DUP(11, { CP p = params_ptr(); unsigned char* ws = p->ws; const int G = gridDim.x, cb = blockIdx.x;
              pg8::Gemm gm{(const bf16_t*)(ws + O_AN), (const bf16_t*)(ws + O_WFF1 + l * SZ_WFF), Mr, 4096, D, 0, 0};
              pg8::StaticOrder S; S.init(Mr, 4096, G, cb, 1); EpiFF1 E{(bf16_t*)(ws + O_U)}; pg8::gemm_phase(ldsg, gm, S, E); });
            GSYNC();
            DUP(13, { CP p = params_ptr(); unsigned char* ws = p->ws; const int G = gridDim.x, cb = blockIdx.x;
              const float* modl = (const float*)(ws + O_MOD) + (size_t)l * 33 * 6144;
              float* hl = p->out + (size_t)g * ML * D; float* hc = (float*)(ws + O_HC) + (cchain ? (size_t)0 : (size_t)g * MC * D);
              pg8::Gemm gm{(const bf16_t*)(ws + O_U), (const bf16_t*)(ws + O_WFF2 + l * SZ_WFF), Mr, D, 4096, 0, 0};
              pg8::StaticOrder S; S.init(Mr, D, G, cb, 1); EpiRes E{hl, hc, modl + 5120, g, rep_ == 0 ? 1.f : 0.f, cchain ? 1 : 0, 0L}; pg8::gemm_phase(ldsg, gm, S, E); });
            if (g + 1 < NG) phase_norm(params_ptr(), g + 1, l, 0, M, false);
            GSYNC();
        }
    }
    for (int g = 0; g < NG; ++g) phase_final(params_ptr(), g);
}

extern "C" void kernel_launch(void* const* d_in, const int* in_sizes, int n_in, void* d_out, int out_size, void* d_ws, size_t ws_size, hipStream_t stream) {
    constexpr size_t kDynLds = 155648;
    static_assert(ATT_LDS_END <= 155648, "attention LDS image too large");
    static int grid_blocks = 0;
    if (grid_blocks == 0) {
        if (n_in != 24 || ws_size < WS_END) { fprintf(stderr, "kernel_launch: need 24 inputs and %zu bytes of workspace, got %d / %zu\n", (size_t)WS_END, n_in, ws_size); grid_blocks = -1; return; }
        int dev = 0, cus = 0, per_cu = 0;
        (void)hipGetDevice(&dev);
        (void)hipDeviceGetAttribute(&cus, hipDeviceAttributeMultiprocessorCount, dev);
        (void)hipFuncSetAttribute((const void*)fwd_megakernel, hipFuncAttributeMaxDynamicSharedMemorySize, (int)kDynLds);
        (void)hipOccupancyMaxActiveBlocksPerMultiprocessor(&per_cu, (const void*)fwd_megakernel, 512, kDynLds);
        if (per_cu < 1) per_cu = 1;
        grid_blocks = cus * per_cu;
        (void)hipGetLastError();
    }
    if (grid_blocks < 0) return;
    Params p{};
    const float** pp = (const float**)&p;
    for (int i = 0; i < 24; ++i) pp[i] = (const float*)d_in[i];
    p.out = (float*)d_out; p.ws = (unsigned char*)d_ws;
    (void)hipMemsetAsync((unsigned char*)d_ws + O_BAR, 0, 16384, stream);
    void* args[] = {&p};
    hipError_t e = hipLaunchCooperativeKernel((void*)fwd_megakernel, dim3(grid_blocks), dim3(512), args, kDynLds, stream);
    if (e != hipSuccess) fprintf(stderr, "cooperative launch failed: %s (grid %d)\n", hipGetErrorString(e), grid_blocks);
}
```

```cpp
#include <hip/hip_runtime.h>
#include <hip/hip_cooperative_groups.h>
#include <cstdio>
namespace cg = cooperative_groups;
#ifndef PROBE_DUP
#define PROBE_DUP 0
#endif
#define DUP(n, ...) do { _Pragma("nounroll") for (int rep_ = 0; rep_ < ((PROBE_DUP == (n)) ? 2 : 1); ++rep_) { __VA_ARGS__ } } while (0)

#define LAS __attribute__((address_space(3)))
typedef unsigned short bf16_t;
typedef short bf16x8 __attribute__((ext_vector_type(8)));
typedef float f32x4 __attribute__((ext_vector_type(4)));
typedef unsigned u32x4_t __attribute__((ext_vector_type(4)));

constexpr int D = 1024, NB = 32, L = 2048, CTX = 256;
constexpr int GB = 8, NG = NB / GB, ML = GB * L, MC = GB * CTX, M = ML + MC;
constexpr int UC = 12032, IN_COLS = 11808;
constexpr int cCB = 0, cCC = 1024, cCX = 2048, cZ = 3072, cXBC = 4096, cQ = 5632, cK = 6656, cV = 7680, cGATE = 8704, cDT = 11776;
constexpr int XW = 1536, NCTX = NB * CTX;
constexpr float EPS = 1e-6f;

constexpr size_t SZ_WIN = (size_t)UC * D * 2, SZ_WBR = (size_t)3 * D * D * 2, SZ_WOUT = (size_t)D * D * 2, SZ_WFF = (size_t)4 * D * D * 2;
constexpr size_t O_WIN = 0;
constexpr size_t O_WBR = O_WIN + 2 * SZ_WIN;
constexpr size_t O_WOUT = O_WBR + 2 * SZ_WBR;
constexpr size_t O_WFF1 = O_WOUT + 2 * SZ_WOUT;
constexpr size_t O_WFF2 = O_WFF1 + 2 * SZ_WFF;
constexpr size_t O_HC = O_WFF2 + 2 * SZ_WFF;
constexpr size_t O_MOD = O_HC + (size_t)NB * CTX * D * 4;
constexpr size_t O_ROPE = O_MOD + (size_t)2 * 33 * 6144 * 4 + 256 * 3;
constexpr size_t O_AN = O_ROPE + (size_t)2048 * 64 * 4;
constexpr size_t O_U = O_AN + (size_t)M * D * 2;
constexpr size_t O_XBCS = O_U + (size_t)M * UC * 2;
constexpr size_t O_DTS = O_XBCS + (size_t)M * XW * 2;
constexpr size_t O_DECS = O_DTS + (size_t)M * 32 * 4;
constexpr size_t O_YDIR = O_DECS + (size_t)M * 32 * 4;
constexpr size_t O_YBR = O_YDIR + (size_t)2 * M * D * 2;
constexpr size_t O_MRGB = O_YBR + (size_t)3 * M * D * 2;
constexpr size_t O_VT = O_MRGB + (size_t)M * D * 2;
constexpr size_t O_BAR = O_VT + (size_t)GB * 1024 * 2304 * 2;
constexpr size_t O_YBRC = O_BAR + 16384;
constexpr size_t O_GATEC = O_YBRC + (size_t)3 * NB * CTX * D * 2;
constexpr size_t WS_END = O_GATEC + (size_t)NB * CTX * 3072 * 2;
static_assert(WS_END <= ((size_t)1 << 30), "workspace map exceeds 1 GiB");

struct Params {
    const float *x, *c, *ctx, *c_ctx, *w_ada, *b_ada, *norm1_w, *w_in, *conv_mix_w, *ssd_conv_w, *ssd_conv_b, *ssd_a_log, *ssd_dt_bias, *ssd_d, *ssd_norm_w,
        *na_rpb, *w_br_conv, *w_br_ssd, *w_br_na, *w_out, *norm2_w, *w_ff1, *w_ff2, *final_norm_w;
    float* out; unsigned char* ws;
};

typedef const __attribute__((address_space(4))) Params* CP;
__device__ __forceinline__ CP params_ptr() { unsigned long long k = (unsigned long long)__builtin_amdgcn_kernarg_segment_ptr(); asm volatile("" : "+s"(k)); return (CP)k; }
__device__ __forceinline__ int fresh_tid() { int t = threadIdx.x; asm volatile("" : "+v"(t)); return t; }
__device__ __forceinline__ float bflo(unsigned u) { return __uint_as_float(u << 16); }
__device__ __forceinline__ float bfhi(unsigned u) { return __uint_as_float(u & 0xffff0000u); }
__device__ __forceinline__ unsigned f2bf(float f) { unsigned u = __float_as_uint(f); u += 0x7FFFu + ((u >> 16) & 1u); return u >> 16; }
__device__ __forceinline__ unsigned pack2(float lo, float hi) { unsigned r; asm volatile("v_cvt_pk_bf16_f32 %0, %1, %2" : "=v"(r) : "v"(lo), "v"(hi)); return r; }
__device__ __forceinline__ void unpack8(const uint4 v, float (&f)[8]) { f[0] = bflo(v.x); f[1] = bfhi(v.x); f[2] = bflo(v.y); f[3] = bfhi(v.y); f[4] = bflo(v.z); f[5] = bfhi(v.z); f[6] = bflo(v.w); f[7] = bfhi(v.w); }
__device__ __forceinline__ uint4 pack8(const float (&f)[8]) { uint4 v; v.x = pack2(f[0], f[1]); v.y = pack2(f[2], f[3]); v.z = pack2(f[4], f[5]); v.w = pack2(f[6], f[7]); return v; }
__device__ __forceinline__ float silu_f(float v) { return v * __builtin_amdgcn_rcpf(1.f + __expf(-v)); }
__device__ __forceinline__ float sigmoid_f(float v) { return __builtin_amdgcn_rcpf(1.f + __expf(-v)); }
__device__ __forceinline__ float x32_max(float v) { const auto r = __builtin_amdgcn_permlane32_swap(__float_as_uint(v), __float_as_uint(v), false, false); return fmaxf(__uint_as_float(r[0]), __uint_as_float(r[1])); }
__device__ __forceinline__ float x16_max(float v) { const auto r = __builtin_amdgcn_permlane16_swap(__float_as_uint(v), __float_as_uint(v), false, false); return fmaxf(__uint_as_float(r[0]), __uint_as_float(r[1])); }
__device__ __forceinline__ float x32_sum(float v) { const auto r = __builtin_amdgcn_permlane32_swap(__float_as_uint(v), __float_as_uint(v), false, false); return __uint_as_float(r[0]) + __uint_as_float(r[1]); }
__device__ __forceinline__ float x16_sum(float v) { const auto r = __builtin_amdgcn_permlane16_swap(__float_as_uint(v), __float_as_uint(v), false, false); return __uint_as_float(r[0]) + __uint_as_float(r[1]); }
__device__ __forceinline__ float wave_sum(float v) { v = x32_sum(v); v = x16_sum(v); for (int o = 8; o; o >>= 1) v += __shfl_xor(v, o); return v; }

namespace pg8 {
constexpr int BM = 256, BK = 64, HALF = 128, HTB = HALF * BK * 2, STAGE_BYTES = 8 * HTB, NXCD = 8, WGM = 8;
__device__ __forceinline__ int lds_byte(int r, int c) { const int st = (r >> 4) * 2 + (c >> 5), rr = r & 15, cc = c & 31, ob = rr * 64 + cc * 2; return st * 1024 + (ob ^ (((ob >> 9) & 1) << 5)); }
__device__ __forceinline__ void stage_rc(int b, int& R, int& C) { const int st = b / 1024, sb = b % 1024, swz = sb ^ (((sb >> 9) & 1) << 5); R = (st >> 1) * 16 + swz / 64; C = (st & 1) * 32 + (swz % 64) / 2; }
__device__ __forceinline__ int perm32(int rho) { const int n = rho >> 4, i = rho & 15; return 8 * (i >> 2) + 4 * n + (i & 3); }
struct Unit { int pm, pn, z; };
struct Gemm { const bf16_t* A; const bf16_t* Bt; int M, N, K; size_t azs, bzs; };
struct StaticOrder {
    int nM, nN, nwg, G, c, nz;
    __device__ void init(int M_, int N_, int G_, int c_, int nz_) { nM = M_ / BM; nN = N_ / BM; nwg = nM * nN; G = G_; c = c_; nz = nz_; }
    __device__ bool next(int i, Unit& u) const {
        const int ti = i / nz; u.z = i - ti * nz;
        const long Lx = (long)ti * G + c; if (Lx >= nwg) return false;
        int wgid = (int)Lx; { const int q = nwg / NXCD, r = nwg % NXCD, xcd = wgid % NXCD, off = wgid / NXCD; wgid = (xcd < r ? xcd * (q + 1) : r * (q + 1) + (xcd - r) * q) + off; }
        const int nig = WGM * nN, gid = wgid / nig, fm = gid * WGM, gsz = (nM - fm) < WGM ? (nM - fm) : WGM;
        u.pm = fm + ((wgid % nig) % gsz); u.pn = (wgid % nig) / gsz; return true;
    }
};
template <class Epi>
__device__ __forceinline__ void gemm_phase(LAS unsigned char* lds, const Gemm g, const StaticOrder& S, const Epi& E) {
    const int tid = fresh_tid(), wid = __builtin_amdgcn_readfirstlane(tid >> 6), lane = tid & 63, wr = wid >> 2, wc = wid & 3, fr = lane & 15, fq = lane >> 4;
    const int K = g.K, nt = K / BK;
    unsigned voffA[2], voffB[2];
#pragma unroll
    for (int i = 0; i < 2; ++i) { int R, C; stage_rc(tid * 16 + i * 8192, R, C); const int Rb = Epi::PERM ? ((R & ~31) + perm32(R & 31)) : R;
        voffA[i] = (unsigned)(R * K + C) * 2u; voffB[i] = (unsigned)(Rb * K + C) * 2u; }
    const size_t kstep = (size_t)(BK * 2);
    const size_t hstep = (size_t)HALF * K * 2;
    const size_t tstep = 2 * hstep;
    const unsigned ldsw = (unsigned)wid * 1024u;
    const int aoff = lds_byte(wr * 64 + fr, fq * 8), boff = lds_byte(wc * 32 + fr, fq * 8);
#define PG8_SA(b, h) (((b) * 2 + (h)) * HTB)
#define PG8_SB(b, h) ((4 + (b) * 2 + (h)) * HTB)
#define PG8_STAGE(bufoff, gbase, voff) do { _Pragma("unroll") for (int _i = 0; _i < 2; ++_i) \
        __builtin_amdgcn_global_load_lds((const unsigned*)((const char*)(gbase) + (voff)[_i]), (LAS unsigned*)(lds + (bufoff) + ldsw + _i * 8192), 16, 0, 0); } while (0)
#define PG8_LDA(dst, b, h) do { _Pragma("unroll") for (int m = 0; m < 4; ++m) _Pragma("unroll") for (int k = 0; k < 2; ++k) dst[m][k] = *(const LAS bf16x8*)(lds + PG8_SA(b, h) + aoff + m * 2048 + k * 1024); } while (0)
#define PG8_LDB(dst, b, h) do { _Pragma("unroll") for (int n = 0; n < 2; ++n) _Pragma("unroll") for (int k = 0; k < 2; ++k) dst[n][k] = *(const LAS bf16x8*)(lds + PG8_SB(b, h) + boff + n * 2048 + k * 1024); } while (0)
#define PG8_MMA(ai, bj, At, Bt) do { __builtin_amdgcn_s_setprio(1); _Pragma("unroll") for (int m = 0; m < 4; ++m) _Pragma("unroll") for (int n = 0; n < 2; ++n) _Pragma("unroll") for (int k = 0; k < 2; ++k) \
        acc[ai][bj][m][n] = __builtin_amdgcn_mfma_f32_16x16x32_bf16(Bt[n][k], At[m][k], acc[ai][bj][m][n], 0, 0, 0); __builtin_amdgcn_s_setprio(0); } while (0)
#define PG8_WAIT_V(n) asm volatile("s_waitcnt vmcnt(" #n ")" ::: "memory")
#define PG8_WAIT_L(n) asm volatile("s_waitcnt lgkmcnt(" #n ")" ::: "memory")
#define PG8_BAR __builtin_amdgcn_s_barrier()
#define PG8_SCHED __builtin_amdgcn_sched_barrier(0)
    Unit cur, nxt; int ui = 0;
    if (!S.next(0, cur)) return;
    f32x4 acc[2][2][4][2];
#pragma unroll
    for (int a = 0; a < 2; ++a)
#pragma unroll
        for (int b = 0; b < 2; ++b)
#pragma unroll
            for (int m = 0; m < 4; ++m)
#pragma unroll
                for (int n = 0; n < 2; ++n) acc[a][b][m][n] = (f32x4){0.f, 0.f, 0.f, 0.f};
    bf16x8 At[4][2], B0[2][2], B1[2][2];
    const char* cA = (const char*)g.A + (size_t)cur.z * g.azs + (size_t)cur.pm * tstep; const char* cB = (const char*)g.Bt + (size_t)cur.z * g.bzs + (size_t)cur.pn * tstep;
    PG8_STAGE(PG8_SB(0, 0), cB, voffB); PG8_STAGE(PG8_SA(0, 0), cA, voffA); PG8_STAGE(PG8_SB(0, 1), cB + hstep, voffB); PG8_STAGE(PG8_SA(0, 1), cA + hstep, voffA);
    if (wr == 1) PG8_BAR;
    PG8_WAIT_V(4); PG8_BAR;
    PG8_STAGE(PG8_SB(1, 0), cB + kstep, voffB); PG8_STAGE(PG8_SA(1, 0), cA + kstep, voffA); PG8_STAGE(PG8_SB(1, 1), cB + hstep + kstep, voffB);
    PG8_WAIT_V(6); PG8_BAR;
    for (;;) {
        const bool has_next = S.next(ui + 1, nxt);
        const char* nA = has_next ? (const char*)g.A + (size_t)nxt.z * g.azs + (size_t)nxt.pm * tstep : cA; const char* nB = has_next ? (const char*)g.Bt + (size_t)nxt.z * g.bzs + (size_t)nxt.pn * tstep : cB;
        for (int t = 0; t < nt; t += 2) {
            const bool last = (t == nt - 2);
            const char* a1 = cA + (size_t)(t + 1) * kstep;
            const char* a2 = last ? nA : cA + (size_t)(t + 2) * kstep; const char* b2 = last ? nB : cB + (size_t)(t + 2) * kstep;
            const char* a3 = a2 + kstep; const char* b3 = b2 + kstep;
            PG8_LDB(B0, 0, 0); PG8_SCHED; PG8_LDA(At, 0, 0); PG8_STAGE(PG8_SA(1, 1), a1 + hstep, voffA);
            PG8_WAIT_L(8); PG8_BAR; PG8_WAIT_L(0); PG8_MMA(0, 0, At, B0); PG8_BAR; PG8_SCHED;
            PG8_LDB(B1, 0, 1); PG8_STAGE(PG8_SB(0, 0), b2, voffB);
            PG8_BAR; PG8_WAIT_L(0); PG8_MMA(0, 1, At, B1); PG8_BAR;
            PG8_LDA(At, 0, 1); PG8_STAGE(PG8_SA(0, 0), a2, voffA);
            PG8_BAR; PG8_WAIT_L(0); PG8_MMA(1, 0, At, B0); PG8_BAR; PG8_SCHED;
            PG8_STAGE(PG8_SB(0, 1), b2 + hstep, voffB);
            PG8_WAIT_V(6); PG8_BAR; PG8_MMA(1, 1, At, B1); PG8_BAR;
            PG8_LDB(B0, 1, 0); PG8_SCHED; PG8_LDA(At, 1, 0); PG8_STAGE(PG8_SA(0, 1), a2 + hstep, voffA);
            PG8_WAIT_L(8); PG8_BAR; PG8_WAIT_L(0); PG8_MMA(0, 0, At, B0); PG8_BAR; PG8_SCHED;
            PG8_LDB(B1, 1, 1); PG8_STAGE(PG8_SB(1, 0), b3, voffB);
            PG8_BAR; PG8_WAIT_L(0); PG8_MMA(0, 1, At, B1); PG8_BAR;
            PG8_LDA(At, 1, 1); PG8_STAGE(PG8_SA(1, 0), a3, voffA);
            PG8_BAR; PG8_WAIT_L(0); PG8_MMA(1, 0, At, B0); PG8_BAR; PG8_SCHED;
            PG8_STAGE(PG8_SB(1, 1), b3 + hstep, voffB);
            PG8_WAIT_V(6); PG8_BAR; PG8_MMA(1, 1, At, B1); PG8_BAR;
        }
        E(acc, cur, wr, wc, fr, fq);
        if (!has_next) break;
        if (!E.keep(cur))
#pragma unroll
        for (int a = 0; a < 2; ++a)
#pragma unroll
            for (int b = 0; b < 2; ++b)
#pragma unroll
                for (int m = 0; m < 4; ++m)
#pragma unroll
                    for (int n = 0; n < 2; ++n) acc[a][b][m][n] = (f32x4){0.f, 0.f, 0.f, 0.f};
        cur = nxt; cA = nA; cB = nB; ++ui;
    }
    PG8_WAIT_V(0);
    if (wr == 0) PG8_BAR;
    PG8_BAR;
#undef PG8_SA
#undef PG8_SB
#undef PG8_STAGE
#undef PG8_LDA
#undef PG8_LDB
#undef PG8_MMA
#undef PG8_WAIT_V
#undef PG8_WAIT_L
#undef PG8_BAR
#undef PG8_SCHED
}
}
using pg8::Unit;

struct EpiU {
    static constexpr bool PERM = true;
    __device__ __forceinline__ bool keep(const Unit&) const { return false; }
    bf16_t* U;
    __device__ __forceinline__ void operator()(f32x4 (&acc)[2][2][4][2], const Unit& u, int wr, int wc, int fr, int fq) const {
        const int row0 = u.pm * 256 + wr * 64 + fr, col0 = u.pn * 256 + wc * 32 + 8 * fq;
        const bool sg = (u.pn >= cGATE / 256) && (u.pn < cDT / 256);
#pragma unroll
        for (int ai = 0; ai < 2; ++ai)
#pragma unroll
            for (int m = 0; m < 4; ++m) { bf16_t* rowp = U + (size_t)(row0 + ai * 128 + m * 16) * UC + col0;
#pragma unroll
                for (int bj = 0; bj < 2; ++bj) { f32x4 v0 = acc[ai][bj][m][0], v1 = acc[ai][bj][m][1];
                    if (sg) {
#pragma unroll
                        for (int j = 0; j < 4; ++j) { v0[j] = sigmoid_f(v0[j]); v1[j] = sigmoid_f(v1[j]); } }
                    uint4 o; o.x = pack2(v0[0], v0[1]); o.y = pack2(v0[2], v0[3]); o.z = pack2(v1[0], v1[1]); o.w = pack2(v1[2], v1[3]);
                    *(uint4*)(rowp + bj * 128) = o; } }
    }
};
struct EpiMerge {
    static constexpr bool PERM = true;
    const bf16_t* G; int gld; bf16_t* MB;
    __device__ __forceinline__ bool keep(const Unit& u) const { return u.z < 2; }
    __device__ __forceinline__ void operator()(f32x4 (&acc)[2][2][4][2], const Unit& u, int wr, int wc, int fr, int fq) const {
        const int row0 = u.pm * 256 + wr * 64 + fr, col0 = u.pn * 256 + wc * 32 + 8 * fq;
#pragma unroll
        for (int ai = 0; ai < 2; ++ai) {
            uint4 g0[4][2], g1[4][2];
#pragma unroll
            for (int m = 0; m < 4; ++m)
#pragma unroll
                for (int bj = 0; bj < 2; ++bj) { const bf16_t* gp = G + (size_t)(row0 + ai * 128 + m * 16) * gld + u.z * 1024 + col0 + bj * 128;
                    g0[m][bj] = *(const uint4*)gp; g1[m][bj] = (u.z < 2) ? *(const uint4*)(gp + 1024) : g0[m][bj]; }
#pragma unroll
            for (int m = 0; m < 4; ++m) { const size_t row = (size_t)(row0 + ai * 128 + m * 16);
#pragma unroll
                for (int bj = 0; bj < 2; ++bj) { const int col = col0 + bj * 128;
                    float gz[8]; unpack8(g0[m][bj], gz);
                    if (u.z < 2) { float gn[8]; unpack8(g1[m][bj], gn);
#pragma unroll
                        for (int j = 0; j < 8; ++j) { const float rt = fmaxf(gz[j], 1e-20f) * __builtin_amdgcn_rcpf(fmaxf(gn[j], 1e-20f)); acc[ai][bj][m][j >> 2][j & 3] *= rt; } }
                    else { f32x4 v0 = acc[ai][bj][m][0], v1 = acc[ai][bj][m][1];
#pragma unroll
                        for (int j = 0; j < 4; ++j) { v0[j] *= fmaxf(gz[j], 1e-20f); v1[j] *= fmaxf(gz[4 + j], 1e-20f); }
                        uint4 o; o.x = pack2(v0[0], v0[1]); o.y = pack2(v0[2], v0[3]); o.z = pack2(v1[0], v1[1]); o.w = pack2(v1[2], v1[3]); *(uint4*)(MB + row * D + col) = o; } } }
        }
    }
};
struct EpiRes {
    static constexpr bool PERM = false;
    __device__ __forceinline__ bool keep(const Unit&) const { return false; }
    float* hl; float* hc; const float* gate;
    int g; float gs; int allctx; long rdel;
    __device__ __forceinline__ void operator()(f32x4 (&acc)[2][2][4][2], const Unit& u, int wr, int wc, int fr, int fq) const {
        const int lr0 = u.pm * 256; const bool isctx = allctx || lr0 >= ML;
        float* base = allctx ? hc + (size_t)lr0 * D : (isctx ? hc + (size_t)(lr0 - ML) * D : hl + (size_t)lr0 * D);
        const float* rbase = base + rdel;
        const float* gp = gate + (size_t)(isctx ? 32 : g * GB + (lr0 >> 11)) * 6144;
        const int r0 = wr * 64 + fr, col0 = u.pn * 256 + wc * 32 + 4 * fq;
        f32x4 gv[2][2];
#pragma unroll
        for (int bj = 0; bj < 2; ++bj)
#pragma unroll
            for (int n = 0; n < 2; ++n) gv[bj][n] = *(const f32x4*)(gp + col0 + bj * 128 + n * 16) * gs;
#pragma unroll
        for (int ai = 0; ai < 2; ++ai) {
            f32x4 hv[4][2][2];
#pragma unroll
            for (int m = 0; m < 4; ++m)
#pragma unroll
                for (int bj = 0; bj < 2; ++bj)
#pragma unroll
                    for (int n = 0; n < 2; ++n) hv[m][bj][n] = *(const f32x4*)(rbase + (size_t)(r0 + ai * 128 + m * 16) * D + col0 + bj * 128 + n * 16);
#pragma unroll
            for (int m = 0; m < 4; ++m)
#pragma unroll
                for (int bj = 0; bj < 2; ++bj)
#pragma unroll
                    for (int n = 0; n < 2; ++n) *(f32x4*)(base + (size_t)(r0 + ai * 128 + m * 16) * D + col0 + bj * 128 + n * 16) = hv[m][bj][n] + gv[bj][n] * acc[ai][bj][m][n];
        }
    }
};
struct EpiFF1 {
    static constexpr bool PERM = true;
    __device__ __forceinline__ bool keep(const Unit&) const { return false; }
    bf16_t* H;
    __device__ __forceinline__ void operator()(f32x4 (&acc)[2][2][4][2], const Unit& u, int wr, int wc, int fr, int fq) const {
        const int row0 = u.pm * 256 + wr * 64 + fr, col0 = u.pn * 256 + wc * 32 + 8 * fq;
#pragma unroll
        for (int ai = 0; ai < 2; ++ai)
#pragma unroll
            for (int m = 0; m < 4; ++m) { bf16_t* rowp = H + (size_t)(row0 + ai * 128 + m * 16) * 4096 + col0;
#pragma unroll
                for (int bj = 0; bj < 2; ++bj) { f32x4 v0 = acc[ai][bj][m][0], v1 = acc[ai][bj][m][1];
#pragma unroll
                    for (int j = 0; j < 4; ++j) { const float a = fmaxf(v0[j], 0.f), b = fmaxf(v1[j], 0.f); v0[j] = a * a; v1[j] = b * b; }
                    uint4 o; o.x = pack2(v0[0], v0[1]); o.y = pack2(v0[2], v0[3]); o.z = pack2(v1[0], v1[1]); o.w = pack2(v1[2], v1[3]);
                    *(uint4*)(rowp + bj * 128) = o; } }
    }
};

__device__ __forceinline__ int w_in_src_col(int j) { return j < 5632 ? j : (j < 11776 ? j + 32 : (j < 11808 ? j - 11776 + 5632 : -1)); }

__device__ void transpose_weight(const float* __restrict__ W, int ld, int Kd, int Nout, bool mapped, bf16_t* __restrict__ Wt, float* lds) {
    const int tid = fresh_tid(); const int tn = Nout / 256, tk = Kd / 64;
    constexpr int P = 257;
    for (int t = blockIdx.x; t < tn * tk; t += gridDim.x) {
        const int n0 = (t % tn) * 256, k0 = (t / tn) * 64;
        __syncthreads();
#pragma unroll
        for (int i = 0; i < 8; ++i) { const int idx = i * 512 + tid, kk = idx >> 6, nn = (idx & 63) * 4; const int sc = mapped ? w_in_src_col(n0 + nn) : n0 + nn;
            const float4 v = sc >= 0 ? *(const float4*)(W + (size_t)(k0 + kk) * ld + sc) : make_float4(0.f, 0.f, 0.f, 0.f);
            float* d = lds + kk * P + nn; d[0] = v.x; d[1] = v.y; d[2] = v.z; d[3] = v.w; }
        __syncthreads();
#pragma unroll
        for (int i = 0; i < 4; ++i) { const int idx = i * 512 + tid, nn = idx >> 3, kp = (idx & 7) * 8;
            float f[8];
#pragma unroll
            for (int j = 0; j < 8; ++j) f[j] = lds[(kp + j) * P + nn];
            *(uint4*)(Wt + (size_t)(n0 + nn) * Kd + k0 + kp) = pack8(f); }
    }
}

__device__ void phase_prep(CP p, float* lds) {
    unsigned char* ws = p->ws; const int tid = fresh_tid();
    for (int l = 0; l < 2; ++l) {
        transpose_weight(p->w_in + (size_t)l * D * IN_COLS, IN_COLS, D, UC, true, (bf16_t*)(ws + O_WIN + l * SZ_WIN), lds);
        transpose_weight(p->w_br_conv + (size_t)l * D * D, D, D, D, false, (bf16_t*)(ws + O_WBR + l * SZ_WBR), lds);
        transpose_weight(p->w_br_ssd + (size_t)l * D * D, D, D, D, false, (bf16_t*)(ws + O_WBR + l * SZ_WBR) + (size_t)D * D, lds);
        transpose_weight(p->w_br_na + (size_t)l * D * D, D, D, D, false, (bf16_t*)(ws + O_WBR + l * SZ_WBR) + (size_t)2 * D * D, lds);
        transpose_weight(p->w_out + (size_t)l * D * D, D, D, D, false, (bf16_t*)(ws + O_WOUT + l * SZ_WOUT), lds);
        transpose_weight(p->w_ff1 + (size_t)l * D * 4096, 4096, D, 4096, false, (bf16_t*)(ws + O_WFF1 + l * SZ_WFF), lds);
        transpose_weight(p->w_ff2 + (size_t)l * 4096 * D, D, 4096, D, false, (bf16_t*)(ws + O_WFF2 + l * SZ_WFF), lds);
    }
    {
        float* tab = (float*)(ws + O_ROPE);
        for (int i = blockIdx.x * 512 + tid; i < 2048 * 32; i += gridDim.x * 512) {
            const int t = i >> 5, j = i & 31, ii = j & 15; const int pos = (j < 16) ? (t >> 6) : (t & 63);
            const float inv = powf(10000.0f, -(float)(2 * ii) / 32.0f); const float ang = (float)pos * inv;
            tab[t * 64 + j] = cosf(ang); tab[t * 64 + 32 + j] = sinf(ang);
        }
    }
    float* mod = (float*)(ws + O_MOD);
    for (int job = blockIdx.x; job < 2 * 96; job += gridDim.x) {
        const int l = job / 96, j0 = (job % 96) * 64;
        __syncthreads();
        for (int i = tid; i < 32 * 1024; i += 512) lds[i] = silu_f(p->c[i]);
        __syncthreads();
        const int col = tid & 63, kp = tid >> 6;
        float acc[33];
#pragma unroll
        for (int r = 0; r < 33; ++r) acc[r] = 0.f;
        const float* wp = p->w_ada + (size_t)l * D * 6144 + j0 + col;
        for (int k = kp * 128; k < kp * 128 + 128; ++k) {
            const float wv = wp[(size_t)k * 6144];
#pragma unroll
            for (int r = 0; r < 32; ++r) acc[r] += lds[r * 1024 + k] * wv;
            acc[32] += silu_f(p->c_ctx[k]) * wv;
        }
        __syncthreads();
#pragma unroll
        for (int r = 0; r < 33; ++r) lds[(kp * 33 + r) * 64 + col] = acc[r];
        __syncthreads();
        for (int i = tid; i < 33 * 64; i += 512) { const int r = i >> 6, cc = i & 63; float s = 0.f;
#pragma unroll
            for (int q = 0; q < 8; ++q) s += lds[(q * 33 + r) * 64 + cc];
            mod[((size_t)l * 33 + r) * 6144 + j0 + cc] = s + p->b_ada[l * 6144 + j0 + cc]; }
    }
}

__device__ void phase_norm(CP p, int g, int l, int which, int Mrows, bool ctxall) {
    unsigned char* ws = p->ws; const int tid_ = fresh_tid(); const int lane = tid_ & 63, gw = blockIdx.x * 8 + (tid_ >> 6), nw = gridDim.x * 8;
    const bool first = (l == 0 && which == 0);
    const float* nwt = (which ? p->norm2_w : p->norm1_w) + l * D;
    const float* mod = (const float*)(ws + O_MOD) + (size_t)l * 33 * 6144 + which * 3072;
    bf16_t* AN = (bf16_t*)(ws + O_AN);
    float4 wv[4];
#pragma unroll
    for (int j = 0; j < 4; ++j) wv[j] = *(const float4*)(nwt + j * 256 + lane * 4);
    auto src_of = [&](int lr) -> const float* {
        const bool isctx = ctxall || lr >= ML;
        const size_t grow = ctxall ? (size_t)lr : (isctx ? (size_t)g * MC + (lr - ML) : (size_t)g * ML + lr);
        return (first ? (isctx ? p->ctx : p->x) : (isctx ? (const float*)(ws + O_HC) : (const float*)p->out)) + grow * D;
    };
    float4 v[4], nx[4];
    if (gw < Mrows) { const float* src = src_of(gw);
#pragma unroll
        for (int j = 0; j < 4; ++j) v[j] = *(const float4*)(src + j * 256 + lane * 4); }
    for (int lr = gw; lr < Mrows; lr += nw) {
        if (lr + nw < Mrows) { const float* src = src_of(lr + nw);
#pragma unroll
            for (int j = 0; j < 4; ++j) nx[j] = *(const float4*)(src + j * 256 + lane * 4); }
        const bool isctx = ctxall || lr >= ML;
        const float* mr = mod + (size_t)(isctx ? 32 : g * GB + (lr >> 11)) * 6144;
        float ss = 0.f;
#pragma unroll
        for (int j = 0; j < 4; ++j) ss += v[j].x * v[j].x + v[j].y * v[j].y + v[j].z * v[j].z + v[j].w * v[j].w;
        ss = wave_sum(ss);
        const float rs = rsqrtf(ss * (1.f / 1024.f) + EPS);
#pragma unroll
        for (int j = 0; j < 4; ++j) {
            const int col = j * 256 + lane * 4;
            const float4 w = wv[j], sh = *(const float4*)(mr + col), sc = *(const float4*)(mr + 1024 + col);
            uint2 o; o.x = pack2(v[j].x * rs * w.x * (1.f + sc.x) + sh.x, v[j].y * rs * w.y * (1.f + sc.y) + sh.y);
            o.y = pack2(v[j].z * rs * w.z * (1.f + sc.z) + sh.z, v[j].w * rs * w.w * (1.f + sc.w) + sh.w);
            *(uint2*)(AN + (size_t)lr * D + col) = o;
        }
#pragma unroll
        for (int j = 0; j < 4; ++j) v[j] = nx[j];
    }
}

__device__ void phase_mixprep(CP p, int g, int l, bool last, bool do_qk) {
    unsigned char* ws = p->ws; const int tid_ = fresh_tid(); const int lane = tid_ & 63, gw = blockIdx.x * 8 + (tid_ >> 6), nw = gridDim.x * 8;
    bf16_t* U = (bf16_t*)(ws + O_U); bf16_t* XB = (bf16_t*)(ws + O_XBCS); float* DTS = (float*)(ws + O_DTS); float* DECS = (float*)(ws + O_DECS);
    bf16_t* YC = (bf16_t*)(ws + O_YBR); const float* tab = (const float*)(ws + O_ROPE);
    const float* cw = p->conv_mix_w + (size_t)l * 3 * D; const float* sw = p->ssd_conv_w + (size_t)l * 3 * XW; const float* sb = p->ssd_conv_b + (size_t)l * XW;
    const int RP = (M + nw - 1) / nw; const int lr0 = gw * RP, lr1 = min(lr0 + RP, M);
    {
        float wv[2][3][8], pcx[2][8], ccx[2][8], ncx[2][8];
#pragma unroll
        for (int j = 0; j < 2; ++j)
#pragma unroll
            for (int k = 0; k < 3; ++k)
#pragma unroll
                for (int i = 0; i < 8; ++i) wv[j][k][i] = cw[k * D + (lane + 64 * j) * 8 + i];
        auto load_cx = [&](int lr, float (&cx)[2][8]) {
            if (lr < 0 || lr >= M) {
#pragma unroll
                for (int i = 0; i < 8; ++i) { cx[0][i] = 0.f; cx[1][i] = 0.f; }
                return; }
            const bf16_t* u = U + (size_t)lr * UC;
#pragma unroll
            for (int j = 0; j < 2; ++j) { const int ch = (lane + 64 * j) * 8; float c8[8], x8[8]; unpack8(*(const uint4*)(u + cCC + ch), c8); unpack8(*(const uint4*)(u + cCX + ch), x8);
#pragma unroll
                for (int i = 0; i < 8; ++i) cx[j][i] = c8[i] * x8[i]; }
        };
        if (lr0 < M) { load_cx(lr0 - 1, pcx); load_cx(lr0, ccx); }
        for (int lr = lr0; lr < lr1; ++lr) {
            load_cx(lr + 1, ncx);
            const bool isctx = lr >= ML; const int t = isctx ? ((lr - ML) & 255) : (lr & 2047); const int Ls = isctx ? 256 : 2048;
            const float mp = t > 0 ? 1.f : 0.f, mn = t < Ls - 1 ? 1.f : 0.f;
            if (!(isctx && last)) {
                const bf16_t* u0 = U + (size_t)lr * UC;
#pragma unroll
                for (int j = 0; j < 2; ++j) { const int ch = (lane + 64 * j) * 8;
                    float cb[8]; unpack8(*(const uint4*)(u0 + cCB + ch), cb);
                    float o[8];
#pragma unroll
                    for (int i = 0; i < 8; ++i) o[i] = cb[i] * (wv[j][0][i] * (pcx[j][i] * mp) + wv[j][1][i] * ccx[j][i] + wv[j][2][i] * (ncx[j][i] * mn));
                    bf16_t* yo = isctx ? (bf16_t*)(ws + O_YBRC) + ((size_t)g * MC + (lr - ML)) * D : YC + (size_t)lr * D;
                    *(uint4*)(yo + ch) = pack8(o); }
            }
#pragma unroll
            for (int i = 0; i < 8; ++i)
#pragma unroll
                for (int j = 0; j < 2; ++j) { pcx[j][i] = ccx[j][i]; ccx[j][i] = ncx[j][i]; }
        }
    }
    float sv[3][4][8], pxb[3][8], cxb[3][8], nxb[3][8];
#pragma unroll
    for (int j = 0; j < 3; ++j)
#pragma unroll
        for (int i = 0; i < 8; ++i) { const int ch = (lane + 64 * j) * 8 + i; sv[j][0][i] = sw[ch]; sv[j][1][i] = sw[XW + ch]; sv[j][2][i] = sw[2 * XW + ch]; sv[j][3][i] = sb[ch]; }
    auto load_xb = [&](int lr, float (&xb)[3][8]) {
        if (lr < 0 || lr >= M) {
#pragma unroll
            for (int i = 0; i < 8; ++i) { xb[0][i] = 0.f; xb[1][i] = 0.f; xb[2][i] = 0.f; }
            return; }
        const bf16_t* u = U + (size_t)lr * UC;
#pragma unroll
        for (int j = 0; j < 3; ++j) unpack8(*(const uint4*)(u + cXBC + (lane + 64 * j) * 8), xb[j]);
    };
    if (lr0 < M) { load_xb(lr0 - 1, pxb); load_xb(lr0, cxb); }
    for (int lr = lr0; lr < lr1; ++lr) {
        load_xb(lr + 1, nxb);
        const bool isctx = lr >= ML; const int t = isctx ? ((lr - ML) & 255) : (lr & 2047); const int Ls = isctx ? 256 : 2048;
        const float mp = t > 0 ? 1.f : 0.f, mn = t < Ls - 1 ? 1.f : 0.f;
        bf16_t* u0 = U + (size_t)lr * UC;
#pragma unroll
        for (int j = 0; j < 3; ++j) { const int ch = (lane + 64 * j) * 8; float o[8];
#pragma unroll
            for (int i = 0; i < 8; ++i) o[i] = silu_f(sv[j][3][i] + sv[j][0][i] * (pxb[j][i] * mp) + sv[j][1][i] * cxb[j][i] + sv[j][2][i] * (nxb[j][i] * mn));
            *(uint4*)(XB + (size_t)lr * XW + ch) = pack8(o); }
#pragma unroll
        for (int i = 0; i < 8; ++i)
#pragma unroll
            for (int j = 0; j < 3; ++j) { pxb[j][i] = cxb[j][i]; cxb[j][i] = nxb[j][i]; }
        if (lane < 32) {
            const float raw = bflo((unsigned)u0[cDT + lane]) + p->ssd_dt_bias[l * 32 + lane];
            const float dt = fmaxf(raw, 0.f) + log1pf(__expf(-fabsf(raw)));
            const float A = -__expf(p->ssd_a_log[l * 32 + lane]);
            DTS[(size_t)lr * 32 + lane] = dt; DECS[(size_t)lr * 32 + lane] = dt * A;
        }
        if (do_qk) {
            const int hd = lane >> 2, i0 = (lane & 3) * 4;
            float cr[4], cc[4], sr[4], sc[4];
#pragma unroll
            for (int i = 0; i < 4; ++i) { cr[i] = 1.f; cc[i] = 1.f; sr[i] = 0.f; sc[i] = 0.f; }
            if (!isctx) { const float* tb = tab + t * 64;
#pragma unroll
                for (int i = 0; i < 4; ++i) { cr[i] = tb[i0 + i]; cc[i] = tb[16 + i0 + i]; sr[i] = tb[32 + i0 + i]; sc[i] = tb[48 + i0 + i]; } }
#pragma unroll
            for (int qk = 0; qk < 2; ++qk) {
                if (qk == 1 && isctx) break;
                bf16_t* base = u0 + (qk ? cK : cQ) + hd * 64 + i0; const float scl = qk ? 1.f : 0.125f;
                const uint2 v0 = *(const uint2*)(base), v1 = *(const uint2*)(base + 16), v2 = *(const uint2*)(base + 32), v3 = *(const uint2*)(base + 48);
                const float a[4] = {bflo(v0.x), bfhi(v0.x), bflo(v0.y), bfhi(v0.y)}, b[4] = {bflo(v1.x), bfhi(v1.x), bflo(v1.y), bfhi(v1.y)};
                const float c2[4] = {bflo(v2.x), bfhi(v2.x), bflo(v2.y), bfhi(v2.y)}, d2[4] = {bflo(v3.x), bfhi(v3.x), bflo(v3.y), bfhi(v3.y)};
                float oa[4], ob[4], oc[4], od[4];
#pragma unroll
                for (int i = 0; i < 4; ++i) { oa[i] = (a[i] * cr[i] - b[i] * sr[i]) * scl; ob[i] = (b[i] * cr[i] + a[i] * sr[i]) * scl;
                    oc[i] = (c2[i] * cc[i] - d2[i] * sc[i]) * scl; od[i] = (d2[i] * cc[i] + c2[i] * sc[i]) * scl; }
                *(uint2*)(base) = make_uint2(pack2(oa[0], oa[1]), pack2(oa[2], oa[3])); *(uint2*)(base + 16) = make_uint2(pack2(ob[0], ob[1]), pack2(ob[2], ob[3]));
                *(uint2*)(base + 32) = make_uint2(pack2(oc[0], oc[1]), pack2(oc[2], oc[3])); *(uint2*)(base + 48) = make_uint2(pack2(od[0], od[1]), pack2(od[2], od[3]));
            }
        }
    }
}

__device__ void phase_scan(CP p, bool ctx_out, unsigned char* ldsb) {
    unsigned char* ws = p->ws; const int tid = fresh_tid(); const int lane = tid & 63, w = tid >> 6, fr = lane & 15, fq = lane >> 4;
    const int lt = w < 4 ? w : 11 - w;
    const bf16_t* XB = (const bf16_t*)(ws + O_XBCS); const float* DTS = (const float*)(ws + O_DTS); const float* AS = (const float*)(ws + O_DECS);
    bf16_t* YD = (bf16_t*)(ws + O_YDIR);
    constexpr int PT = 136;
    bf16_t* XT = (bf16_t*)ldsb; bf16_t* BT = XT + 64 * PT; bf16_t* HL = BT + 128 * PT; bf16_t* BR = HL + 64 * PT; float* CUM = (float*)(BR + 128 * PT);
    typedef unsigned u32x4 __attribute__((ext_vector_type(4)));
    for (int item = blockIdx.x; item < GB * 32; item += gridDim.x) {
        const int dir = item & 1, head = (item >> 1) & 15, bl = item >> 5, grp = head >> 3;
        auto row_of = [&](int s) -> int { return s < 256 ? (ML + bl * 256 + (dir ? 255 - s : s)) : (bl * 2048 + (dir ? 2047 - (s - 256) : (s - 256))); };
        f32x4 hacc[4];
#pragma unroll
        for (int i = 0; i < 4; ++i) hacc[i] = (f32x4){0.f, 0.f, 0.f, 0.f};
        __syncthreads();
        for (int i = tid; i < 64 * PT / 2; i += 512) ((unsigned*)HL)[i] = 0u;
        uint4 rx[2], rb[4]; float rdt[2], ra[2];
        auto load_chunk = [&](int ch) {
#pragma unroll
            for (int q = 0; q < 2; ++q) { const int lr = row_of(ch * 128 + 2 * lane + q); const bf16_t* row = XB + (size_t)lr * XW;
                rx[q] = *(const uint4*)(row + head * 64 + w * 8); rb[2 * q] = *(const uint4*)(row + 1024 + grp * 128 + w * 16); rb[2 * q + 1] = *(const uint4*)(row + 1024 + grp * 128 + w * 16 + 8);
                rdt[q] = DTS[(size_t)lr * 32 + dir * 16 + head]; ra[q] = AS[(size_t)lr * 32 + dir * 16 + head]; }
        };
        load_chunk(0);
        for (int ch = 0; ch < 18; ++ch) {
            const bool doy = ctx_out || ch >= 2;
            const int lrl = row_of(ch * 128 + 16 * lt + fr);
            bf16x8 cf[4];
            if (doy) { const bf16_t* cp = XB + (size_t)lrl * XW + 1280 + grp * 128 + fq * 8;
#pragma unroll
                for (int k = 0; k < 4; ++k) cf[k] = *(const bf16x8*)(cp + k * 32); }
            const float ps = ra[0] + ra[1]; float incl = ps;
            incl += __int_as_float(__builtin_amdgcn_update_dpp(0, __float_as_int(incl), 0x111, 0xF, 0xF, true));
            incl += __int_as_float(__builtin_amdgcn_update_dpp(0, __float_as_int(incl), 0x112, 0xF, 0xF, true));
            incl += __int_as_float(__builtin_amdgcn_update_dpp(0, __float_as_int(incl), 0x114, 0xF, 0xF, true));
            incl += __int_as_float(__builtin_amdgcn_update_dpp(0, __float_as_int(incl), 0x118, 0xF, 0xF, true));
            incl += __int_as_float(__builtin_amdgcn_update_dpp(0, __float_as_int(incl), 0x142, 0xA, 0xF, false));
            incl += __int_as_float(__builtin_amdgcn_update_dpp(0, __float_as_int(incl), 0x143, 0xC, 0xF, false));
            const float c0 = incl - ra[1], c1 = incl, total = __int_as_float(__builtin_amdgcn_readlane(__float_as_int(incl), 63));
            const float w0 = __expf(total - c0), w1 = __expf(total - c1), dec_total = __expf(total);
            if (w == 0) { CUM[2 * lane] = c0; CUM[2 * lane + 1] = c1; }
            { float x0[8], x1[8]; unpack8(rx[0], x0); unpack8(rx[1], x1);
#pragma unroll
              for (int i = 0; i < 8; ++i) ((unsigned*)(XT + (w * 8 + i) * PT))[lane] = pack2(x0[i] * rdt[0], x1[i] * rdt[1]); }
#pragma unroll
            for (int q = 0; q < 2; ++q) { *(uint4*)(BR + (2 * lane + q) * PT + w * 16) = rb[2 * q]; *(uint4*)(BR + (2 * lane + q) * PT + w * 16 + 8) = rb[2 * q + 1]; }
#pragma unroll
            for (int hh = 0; hh < 2; ++hh) { float b0[8], b1[8]; unpack8(rb[hh], b0); unpack8(rb[2 + hh], b1);
#pragma unroll
                for (int i = 0; i < 8; ++i) ((unsigned*)(BT + (w * 16 + hh * 8 + i) * PT))[lane] = pack2(b0[i] * w0, b1[i] * w1); }
            __syncthreads();
            if (ch + 1 < 18) load_chunk(ch + 1);
            if (doy) {
                const float cl = CUM[16 * lt + fr]; const float ecl = __expf(cl);
                f32x4 yacc[4];
#pragma unroll
                for (int pt = 0; pt < 4; ++pt) { f32x4 acc = (f32x4){0.f, 0.f, 0.f, 0.f};
#pragma unroll
                    for (int k = 0; k < 4; ++k) acc = __builtin_amdgcn_mfma_f32_16x16x32_bf16(*(const bf16x8*)(HL + (pt * 16 + fr) * PT + k * 32 + fq * 8), cf[k], acc, 0, 0, 0);
                    yacc[pt] = acc * ecl; }
                const int lidx = 16 * lt + fr;
#pragma unroll
                for (int sb = 0; sb < 4; ++sb) if (sb <= (lt >> 1)) {
                    f32x4 gt[2];
#pragma unroll
                    for (int t = 0; t < 2; ++t) { const int srow = sb * 32 + (fr >> 2) * 8 + t * 4 + (fr & 3);
                        const bf16_t* bp = BR + srow * PT + fq * 8; f32x4 acc = (f32x4){0.f, 0.f, 0.f, 0.f};
#pragma unroll
                        for (int k = 0; k < 4; ++k) acc = __builtin_amdgcn_mfma_f32_16x16x32_bf16(*(const bf16x8*)(bp + k * 32), cf[k], acc, 0, 0, 0);
                        gt[t] = acc; }
                    const float4 cs0 = *(const float4*)(CUM + sb * 32 + fq * 8), cs1 = *(const float4*)(CUM + sb * 32 + fq * 8 + 4);
                    const float csv[8] = {cs0.x, cs0.y, cs0.z, cs0.w, cs1.x, cs1.y, cs1.z, cs1.w};
                    float e[8];
#pragma unroll
                    for (int i = 0; i < 8; ++i) { const int sidx = sb * 32 + fq * 8 + i; e[i] = sidx <= lidx ? gt[i >> 2][i & 3] * __expf(fminf(cl - csv[i], 0.f)) : 0.f; }
                    const u32x4 pk = {pack2(e[0], e[1]), pack2(e[2], e[3]), pack2(e[4], e[5]), pack2(e[6], e[7])};
                    const bf16x8 pb = __builtin_bit_cast(bf16x8, pk);
#pragma unroll
                    for (int pt = 0; pt < 4; ++pt) yacc[pt] = __builtin_amdgcn_mfma_f32_16x16x32_bf16(*(const bf16x8*)(XT + (pt * 16 + fr) * PT + sb * 32 + fq * 8), pb, yacc[pt], 0, 0, 0);
                }
                bf16_t* op = YD + ((size_t)dir * M + lrl) * D + head * 64 + fq * 4;
#pragma unroll
                for (int pt = 0; pt < 4; ++pt) *(uint2*)(op + pt * 16) = make_uint2(pack2(yacc[pt][0], yacc[pt][1]), pack2(yacc[pt][2], yacc[pt][3]));
            }
#pragma unroll
            for (int pt = 0; pt < 4; ++pt) hacc[pt] *= dec_total;
#pragma unroll
            for (int k = 0; k < 4; ++k) { const bf16x8 bfr = *(const bf16x8*)(BT + (16 * w + fr) * PT + k * 32 + fq * 8);
#pragma unroll
                for (int pt = 0; pt < 4; ++pt) hacc[pt] = __builtin_amdgcn_mfma_f32_16x16x32_bf16(*(const bf16x8*)(XT + (pt * 16 + fr) * PT + k * 32 + fq * 8), bfr, hacc[pt], 0, 0, 0); }
            __syncthreads();
#pragma unroll
            for (int pt = 0; pt < 4; ++pt)
#pragma unroll
                for (int j = 0; j < 4; ++j) HL[(pt * 16 + fq * 4 + j) * PT + 16 * w + fr] = (bf16_t)f2bf(hacc[pt][j]);
        }
    }
}

__device__ void phase_vtrans(CP p, unsigned* lds) {
    unsigned char* ws = p->ws; const int tid = fresh_tid();
    const bf16_t* U = (const bf16_t*)(ws + O_U); bf16_t* VT = (bf16_t*)(ws + O_VT);
    constexpr int P = 130;
    uint4 tv[4];
    auto tile_load = [&](int tile) {
        const int cg4 = tile & 3, tt = (tile >> 2) % 36, bl = tile / 144;
        const int row0 = tt < 32 ? bl * 2048 + tt * 64 : ML + bl * 256 + (tt - 32) * 64;
#pragma unroll
        for (int i = 0; i < 4; ++i) { const int idx = i * 512 + tid, rr = idx >> 5, ck = idx & 31; tv[i] = *(const uint4*)(U + (size_t)(row0 + rr) * UC + cV + cg4 * 256 + ck * 8); }
    };
    if ((int)blockIdx.x < GB * 36 * 4) tile_load(blockIdx.x);
    for (int tile = blockIdx.x; tile < GB * 36 * 4; tile += gridDim.x) {
        const int cg4 = tile & 3, tt = (tile >> 2) % 36, bl = tile / 144;
        __syncthreads();
#pragma unroll
        for (int i = 0; i < 4; ++i) { const int idx = i * 512 + tid, rr = idx >> 5, ck = idx & 31; const uint4 v = tv[i];
            *(uint2*)(lds + rr * P + ck * 4) = make_uint2(v.x, v.y); *(uint2*)(lds + rr * P + ck * 4 + 2) = make_uint2(v.z, v.w); }
        __syncthreads();
        if (tile + (int)gridDim.x < GB * 36 * 4) tile_load(tile + gridDim.x);
        const unsigned short* l16 = (const unsigned short*)lds;
#pragma unroll
        for (int k = 0; k < 4; ++k) { const int col = (tid >> 3) + 64 * k, tg = tid & 7;
            unsigned w[4];
#pragma unroll
            for (int i = 0; i < 4; ++i) { const unsigned lo = l16[(tg * 8 + 2 * i) * (2 * P) + col], hi = l16[(tg * 8 + 2 * i + 1) * (2 * P) + col]; w[i] = lo | (hi << 16); }
            const int head = cg4 * 4 + (col >> 6), d = col & 63;
            *(uint4*)(VT + ((size_t)((bl * 16 + head) * 64 + d)) * 2304 + tt * 64 + tg * 8) = make_uint4(w[0], w[1], w[2], w[3]); }
    }
}

constexpr int ATT_KP = 72, ATT_VP = 264;
constexpr int ATT_LK = 0, ATT_LV = ATT_LK + 256 * ATT_KP * 2, ATT_LB = ATT_LV + 64 * ATT_VP * 2;
constexpr int ATT_KB = 72704;
constexpr int ATT_LDS_END = ATT_KB + 9 * 64 * 128;
__device__ __forceinline__ int att_kb_off(int key, int c) { const int f = ((key >> 1) & 1) | (((key >> 3) & 3) << 1); return key * 128 + ((c ^ f) << 4); }

template <bool MASK>
__device__ __forceinline__ void attn_chunk(const bf16x8 (&kc)[2][2][2], const bf16x8 (&vv)[2][4], const bf16x8 q0, const bf16x8 q1, f32x4 (&oacc)[4], float& mrun, float& lrun,
                                           const float* rpl, int dr0, int w0, int c, int cs, int fq) {
    f32x4 sc[2][2];
#pragma unroll
    for (int b = 0; b < 2; ++b) {
#pragma unroll
        for (int t = 0; t < 2; ++t) { f32x4 a = (f32x4){0.f, 0.f, 0.f, 0.f};
            a = __builtin_amdgcn_mfma_f32_16x16x32_bf16(kc[b][t][0], q0, a, 0, 0, 0);
            a = __builtin_amdgcn_mfma_f32_16x16x32_bf16(kc[b][t][1], q1, a, 0, 0, 0);
            sc[b][t] = a; }
        if (MASK) {
            const int dr = dr0 + b * 31;
#pragma unroll
            for (int t = 0; t < 2; ++t)
#pragma unroll
                for (int j = 0; j < 4; ++j) { const int kcol = w0 + fq * 8 + t * 4 + j; const bool ok = (unsigned)(kcol - cs) < 16u; const int dci = ok ? kcol - c + 15 : 15;
                    const float bias = rpl[dr + dci]; sc[b][t][j] = ok ? sc[b][t][j] + bias : -1e30f; }
        }
    }
    float mx = -1e30f;
#pragma unroll
    for (int b = 0; b < 2; ++b)
#pragma unroll
        for (int t = 0; t < 2; ++t)
#pragma unroll
            for (int j = 0; j < 4; ++j) mx = fmaxf(mx, sc[b][t][j]);
    mx = x16_max(mx); mx = x32_max(mx);
    const float mnew = fmaxf(mrun, mx), corr = __expf(mrun - mnew);
    lrun *= corr; mrun = mnew;
#pragma unroll
    for (int i = 0; i < 4; ++i) oacc[i] *= corr;
#pragma unroll
    for (int b = 0; b < 2; ++b) {
        float e[8];
#pragma unroll
        for (int t = 0; t < 2; ++t)
#pragma unroll
            for (int j = 0; j < 4; ++j) { e[t * 4 + j] = __expf(sc[b][t][j] - mnew); lrun += e[t * 4 + j]; }
        const u32x4_t pk = {pack2(e[0], e[1]), pack2(e[2], e[3]), pack2(e[4], e[5]), pack2(e[6], e[7])};
        const bf16x8 pb = __builtin_bit_cast(bf16x8, pk);
#pragma unroll
        for (int dt = 0; dt < 4; ++dt) oacc[dt] = __builtin_amdgcn_mfma_f32_16x16x32_bf16(vv[b][dt], pb, oacc[dt], 0, 0, 0);
    }
}

template <bool LAT>
__device__ __forceinline__ void attn_wave_item(const bf16_t* __restrict__ U, const bf16_t* __restrict__ VT, bf16_t* __restrict__ YN, const unsigned char* ldsb,
                                               int bl, int head, int r, int jq, int lane, int rb0) {
    const int fr = lane & 15, fq = lane >> 4;
    const float* rpl = (const float*)(ldsb + ATT_LB);
    int lrq0, r0 = 0, w0 = 0, c = 0, cs = 0;
    if (LAT) { lrq0 = bl * 2048 + r * 64 + jq * 16; r0 = min(max(r - 4, 0), 24); w0 = jq == 0 ? 0 : (jq == 1 ? 8 : (jq == 2 ? 24 : 32)); c = jq * 16 + fr; cs = min(max(c - 8, 0), 48); }
    else lrq0 = ML + bl * 256 + jq * 16;
    const bf16_t* qp = U + (size_t)(lrq0 + fr) * UC + cQ + head * 64 + fq * 8;
    const bf16x8 q0 = *(const bf16x8*)qp, q1 = *(const bf16x8*)(qp + 32);
    f32x4 oacc[4];
#pragma unroll
    for (int i = 0; i < 4; ++i) oacc[i] = (f32x4){0.f, 0.f, 0.f, 0.f};
    float mrun = -1e30f, lrun = 0.f;
    const int kapl = (fr >> 2) * 8 + (fr & 3);
    bf16x8 kc[2][2][2], vv[2][4];
    if (LAT) {
        const bf16_t* Vh = VT + (size_t)(bl * 16 + head) * 64 * 2304;
        unsigned vov[4];
#pragma unroll
        for (int dt = 0; dt < 4; ++dt) vov[dt] = (unsigned)((fr + 16 * dt) * 2304 + fq * 8);
        unsigned vto = (unsigned)(r0 * 64 + w0);
        const unsigned vstep = 64u;
        const unsigned char* KB = ldsb + ATT_KB;
#pragma unroll 1
        for (int ch = 0; ch < 4; ++ch) {
#pragma unroll
            for (int b = 0; b < 2; ++b)
#pragma unroll
                for (int dt = 0; dt < 4; ++dt) vv[b][dt] = *(const bf16x8*)(Vh + (vto + b * vstep + vov[dt]));
            vto += 2 * vstep;
#pragma unroll
            for (int b = 0; b < 2; ++b)
#pragma unroll
                for (int t = 0; t < 2; ++t) { const int key = (r0 - rb0 + ch * 2 + b) * 64 + w0 + kapl + 4 * t;
                    kc[b][t][0] = *(const bf16x8*)(KB + att_kb_off(key, fq)); kc[b][t][1] = *(const bf16x8*)(KB + att_kb_off(key, fq + 4)); }
            attn_chunk<true>(kc, vv, q0, q1, oacc, mrun, lrun, rpl, (r0 + ch * 2 - r + 7) * 31, w0, c, cs, fq);
        }
    }
    const bf16_t* LK = (const bf16_t*)(ldsb + ATT_LK) + kapl * ATT_KP + fq * 8;
    const bf16_t* LV = (const bf16_t*)(ldsb + ATT_LV) + fr * ATT_VP + fq * 8;
#pragma unroll 1
    for (int ch = 0; ch < 4; ++ch) {
#pragma unroll
        for (int b = 0; b < 2; ++b) {
#pragma unroll
            for (int t = 0; t < 2; ++t) { const bf16_t* kp = LK + ((ch * 2 + b) * 32 + 4 * t) * ATT_KP; kc[b][t][0] = *(const bf16x8*)kp; kc[b][t][1] = *(const bf16x8*)(kp + 32); }
#pragma unroll
            for (int dt = 0; dt < 4; ++dt) vv[b][dt] = *(const bf16x8*)(LV + dt * 16 * ATT_VP + (ch * 2 + b) * 32);
        }
        attn_chunk<false>(kc, vv, q0, q1, oacc, mrun, lrun, rpl, 0, 0, 0, 0, fq);
    }
    lrun = x16_sum(lrun); lrun = x32_sum(lrun);
    const float inv = 1.f / lrun;
    bf16_t* op = YN + (size_t)(lrq0 + fr) * D + head * 64 + fq * 4;
#pragma unroll
    for (int dt = 0; dt < 4; ++dt) *(uint2*)(op + dt * 16) = make_uint2(pack2(oacc[dt][0] * inv, oacc[dt][1] * inv), pack2(oacc[dt][2] * inv, oacc[dt][3] * inv));
}

__device__ void phase_attn(CP p, int g, int l, bool do_ctx, unsigned char* ldsb) {
    unsigned char* ws = p->ws; const int tid = fresh_tid(); const int lane = tid & 63, wid = tid >> 6;
    const bf16_t* U = (const bf16_t*)(ws + O_U); const bf16_t* VT = (const bf16_t*)(ws + O_VT); bf16_t* YN = (bf16_t*)(ws + O_YBR) + (size_t)2 * M * D;
    const int G = gridDim.x, cb = blockIdx.x;
    const int nlat = GB * 16 * 16, nctx = do_ctx ? GB * 16 * 2 : 0;
    const int perl = (nlat + G - 1) / G, perc = (nctx + G - 1) / G;
    int cur = -1;
    for (int k = 0; k < perl + perc; ++k) {
        const bool lat = k < perl;
        const int item = lat ? cb * perl + k : cb * perc + (k - perl);
        if (item >= (lat ? nlat : nctx)) continue;
        const int bh = lat ? (item >> 4) : (item >> 1);
        const int bl = bh >> 4, head = bh & 15;
        if (bh != cur) {
            cur = bh;
            __syncthreads();
#pragma unroll
            for (int i = 0; i < 4; ++i) { const int idx = i * 512 + tid;
                { const int key = idx >> 3, part = idx & 7;
                  *(uint4*)((bf16_t*)(ldsb + ATT_LK) + key * ATT_KP + part * 8) = *(const uint4*)(U + (size_t)(ML + bl * 256 + key) * UC + cK + head * 64 + part * 8); }
                { const int d = idx >> 5, part = idx & 31;
                  *(uint4*)((bf16_t*)(ldsb + ATT_LV) + d * ATT_VP + part * 8) = *(const uint4*)(VT + ((size_t)(bh * 64 + d)) * 2304 + 2048 + part * 8); } }
            if (tid < 465) ((float*)(ldsb + ATT_LB))[tid] = p->na_rpb[(size_t)(l * 16 + head) * 465 + tid];
            __syncthreads();
        }
        if (lat) {
            const int rp = item & 15, rb0 = min(max(2 * rp - 4, 0), 24);
            __syncthreads();
#pragma unroll
            for (int i = 0; i < 9; ++i) { const int idx = i * 512 + tid, key = idx >> 3, cc = idx & 7; const int brow = rb0 + (key >> 6);
                if (brow < 32) *(uint4*)(ldsb + ATT_KB + att_kb_off(key, cc)) = *(const uint4*)(U + (size_t)(bl * 2048 + brow * 64 + (key & 63)) * UC + cK + head * 64 + cc * 8); }
            __syncthreads();
            attn_wave_item<true>(U, VT, YN, ldsb, bl, head, rp * 2 + (wid >> 2), wid & 3, lane, rb0);
        }
        else attn_wave_item<false>(U, VT, (bf16_t*)(ws + O_YBRC) + ((size_t)2 * NCTX + (size_t)g * MC) * D - (size_t)ML * D, ldsb, bl, head, 0, (item & 1) * 8 + wid, lane, 0);
    }
}

__device__ void phase_ssdfin(CP p, int g, int l, int Mrows) {
    unsigned char* ws = p->ws; const int tid_ = fresh_tid(); const int lane = tid_ & 63, gw = blockIdx.x * 8 + (tid_ >> 6), nw = gridDim.x * 8;
    const bf16_t* U = (const bf16_t*)(ws + O_U); const bf16_t* XB = (const bf16_t*)(ws + O_XBCS); const bf16_t* YD = (const bf16_t*)(ws + O_YDIR);
    bf16_t* YS = (bf16_t*)(ws + O_YBR) + (size_t)M * D;
    const int head = lane >> 2; const float dsum = p->ssd_d[l * 32 + head] + p->ssd_d[l * 32 + 16 + head];
    float nwr[16];
#pragma unroll
    for (int i = 0; i < 16; ++i) nwr[i] = p->ssd_norm_w[l * D + lane * 16 + i];
    uint4 cu[2][4], nx[2][4];
    auto load_in = [&](int lr, uint4 (&d)[2][4]) {
#pragma unroll
        for (int j = 0; j < 2; ++j) { const int ch = lane * 16 + j * 8;
            d[j][0] = *(const uint4*)(YD + (size_t)lr * D + ch); d[j][1] = *(const uint4*)(YD + ((size_t)M + lr) * D + ch);
            d[j][2] = *(const uint4*)(XB + (size_t)lr * XW + ch); d[j][3] = *(const uint4*)(U + (size_t)lr * UC + cZ + ch); }
    };
    if (gw < Mrows) load_in(gw, cu);
    for (int lr = gw; lr < Mrows; lr += nw) {
        if (lr + nw < Mrows) load_in(lr + nw, nx);
        float v[16]; float ss = 0.f;
#pragma unroll
        for (int j = 0; j < 2; ++j) {
            float y0[8], y1[8], xs[8], z[8];
            unpack8(cu[j][0], y0); unpack8(cu[j][1], y1); unpack8(cu[j][2], xs); unpack8(cu[j][3], z);
#pragma unroll
            for (int i = 0; i < 8; ++i) { const float t = (y0[i] + y1[i] + xs[i] * dsum) * silu_f(z[i]); v[j * 8 + i] = t; ss += t * t; } }
#pragma unroll
        for (int o = 16; o; o >>= 1) ss += __shfl_xor(ss, o);
        const float rs = rsqrtf(ss * (1.f / 512.f) + EPS);
#pragma unroll
        for (int j = 0; j < 2; ++j) { const int ch = lane * 16 + j * 8; float o8[8];
#pragma unroll
            for (int i = 0; i < 8; ++i) o8[i] = v[j * 8 + i] * rs * nwr[j * 8 + i];
            bf16_t* yo = lr >= ML ? (bf16_t*)(ws + O_YBRC) + ((size_t)NCTX + (size_t)g * MC + (lr - ML)) * D : YS + (size_t)lr * D;
            *(uint4*)(yo + ch) = pack8(o8); }
        if (lr >= ML) {
            const bf16_t* gs_ = U + (size_t)lr * UC + cGATE; bf16_t* gd = (bf16_t*)(ws + O_GATEC) + ((size_t)g * MC + (lr - ML)) * 3072;
#pragma unroll
            for (int j = 0; j < 6; ++j) *(uint4*)(gd + (j * 64 + lane) * 8) = *(const uint4*)(gs_ + (j * 64 + lane) * 8);
        }
#pragma unroll
        for (int j = 0; j < 2; ++j)
#pragma unroll
            for (int k = 0; k < 4; ++k) cu[j][k] = nx[j][k];
    }
}

__device__ void phase_final(CP p, int g) {
    const int tid_ = fresh_tid(); const int lane = tid_ & 63, gw = blockIdx.x * 8 + (tid_ >> 6), nw = gridDim.x * 8;
    float4 wv[4], v[4], nx[4];
#pragma unroll
    for (int j = 0; j < 4; ++j) wv[j] = *(const float4*)(p->final_norm_w + j * 256 + lane * 4);
    float* base = p->out + (size_t)g * ML * D;
    if (gw < ML) {
#pragma unroll
        for (int j = 0; j < 4; ++j) v[j] = *(const float4*)(base + (size_t)gw * D + j * 256 + lane * 4); }
    for (int lr = gw; lr < ML; lr += nw) {
        float* hrow = base + (size_t)lr * D;
        if (lr + nw < ML) {
#pragma unroll
            for (int j = 0; j < 4; ++j) nx[j] = *(const float4*)(hrow + (size_t)nw * D + j * 256 + lane * 4); }
        float ss = 0.f;
#pragma unroll
        for (int j = 0; j < 4; ++j) ss += v[j].x * v[j].x + v[j].y * v[j].y + v[j].z * v[j].z + v[j].w * v[j].w;
        ss = wave_sum(ss);
        const float rs = rsqrtf(ss * (1.f / 1024.f) + EPS);
#pragma unroll
        for (int j = 0; j < 4; ++j) { const int col = j * 256 + lane * 4; const float4 w = wv[j];
            *(float4*)(hrow + col) = make_float4(v[j].x * rs * w.x, v[j].y * rs * w.y, v[j].z * rs * w.z, v[j].w * rs * w.w); }
#pragma unroll
        for (int j = 0; j < 4; ++j) v[j] = nx[j];
    }
}

#define XB_TMO      128
#define XB_XCNT(j)  (256  + 64 * (j))
#define XB_XSUB(j)  (1280 + 64 * (j))
#define XB_XGEN(j)  (2304 + 64 * (j))
#define XB_TOP      3328
#define XB_TOPGEN   3392
#define XCD_BAR_WORDS 3456
#define XB_SPIN_CAP (1u << 20)
__device__ __forceinline__ unsigned xb_ld(unsigned* p)              { return __hip_atomic_load(p, __ATOMIC_RELAXED, __HIP_MEMORY_SCOPE_AGENT); }
__device__ __forceinline__ unsigned xb_add(unsigned* p, unsigned v) { return __hip_atomic_fetch_add(p, v, __ATOMIC_RELAXED, __HIP_MEMORY_SCOPE_AGENT); }
__device__ __forceinline__ unsigned xb_xcc_id() { return (unsigned)__builtin_amdgcn_s_getreg((3 << 11) | 20) & 0xFu; }
#define XB_SPIN(cond, bar) do { unsigned _sp = 0; while (cond) { __builtin_amdgcn_s_sleep(1); \
    if ((++_sp & 255u) == 0u) { if (xb_ld(&(bar)[XB_TMO])) break; if (_sp > XB_SPIN_CAP) { atomicAdd(&(bar)[XB_TMO], 1u); break; } } } } while (0)
struct XcdBarrier { unsigned* bar; unsigned x; volatile LAS unsigned* st; };
__device__ __forceinline__ XcdBarrier xcd_barrier_post(unsigned* bar, volatile LAS unsigned* st) {
    XcdBarrier b; b.bar = bar; b.x = xb_xcc_id(); b.st = st;
    if (threadIdx.x == 0) (void)xb_add(&bar[XB_XCNT(b.x)], 1u);
    return b;
}
__device__ __forceinline__ void xcd_barrier_complete(unsigned* bar, unsigned x, unsigned& nloc, unsigned& nx) {
    const unsigned G = gridDim.x * gridDim.y * gridDim.z;
    unsigned sum, cnt, mine, sp = 0u;
    for (;;) {
        sum = 0u; cnt = 0u; mine = 0u;
#pragma unroll
        for (unsigned j = 0; j < 16; ++j) { const unsigned c = xb_ld(&bar[XB_XCNT(j)]); sum += c; cnt += (c > 0u) ? 1u : 0u; mine = (j == x) ? c : mine; }
        if (sum == G) break;
        __builtin_amdgcn_s_sleep(1);
        if ((++sp & 255u) == 0u) { if (xb_ld(&bar[XB_TMO])) break; if (sp > XB_SPIN_CAP) { atomicAdd(&bar[XB_TMO], 1u); break; } }
    }
    nloc = mine > 0u ? mine : 1u; nx = cnt > 0u ? cnt : 1u;
}
__device__ __forceinline__ void xcd_barrier(const XcdBarrier& b) {
    asm volatile("s_waitcnt vmcnt(0)" ::: "memory");
    __syncthreads();
    if (threadIdx.x == 0) {
        unsigned* bar = b.bar;
        __builtin_amdgcn_s_waitcnt(0);
        unsigned nloc = b.st[0], nx = b.st[1];
        if (nloc == 0u) { xcd_barrier_complete(bar, b.x, nloc, nx); b.st[0] = nloc; b.st[1] = nx; }
        const unsigned old = xb_add(&bar[XB_XSUB(b.x)], 1u);
        const unsigned gen = old / nloc;
        if (old + 1u == (gen + 1u) * nloc) {
            __builtin_amdgcn_fence(__ATOMIC_RELEASE, "agent");
            asm volatile("s_waitcnt vmcnt(0)" ::: "memory");
            const unsigned og = xb_add(&bar[XB_TOP], 1u);
            const unsigned tg = og / nx;
            if (og + 1u == (tg + 1u) * nx) xb_add(&bar[XB_TOPGEN], 1u);
            else XB_SPIN(xb_ld(&bar[XB_TOPGEN]) == tg, bar);
            __builtin_amdgcn_fence(__ATOMIC_ACQUIRE, "agent");
            xb_add(&bar[XB_XGEN(b.x)], 1u);
            asm volatile("s_waitcnt vmcnt(0)" ::: "memory");
        } else {
            XB_SPIN(xb_ld(&bar[XB_XGEN(b.x)]) == gen, bar);
            __builtin_amdgcn_fence(__ATOMIC_ACQUIRE, "agent");
            asm volatile("s_waitcnt vmcnt(0)" ::: "memory");
        }
    }
    __syncthreads();
}
#define GSYNC() do { XcdBarrier xb_; xb_.bar = (unsigned*)(params_ptr()->ws + O_BAR); xb_.x = xb_xcc_id(); xb_.st = (volatile LAS unsigned*)&xb_words; xcd_barrier(xb_); if (PROBE_DUP == 20) xcd_barrier(xb_); } while (0)
__global__ void __launch_bounds__(512, 2) fwd_megakernel(Params p_unused) {
    extern __shared__ __attribute__((aligned(16))) unsigned char shm[];
    cg::grid_group grid = cg::this_grid();
    float* ldsf = (float*)shm; LAS unsigned char* ldsg = (LAS unsigned char*)shm;
    __shared__ uint4 xb_words;
    if (threadIdx.x == 0) xb_words = make_uint4(0u, 0u, 0u, 0u);
    __syncthreads();
    (void)xcd_barrier_post((unsigned*)(params_ptr()->ws + O_BAR), (volatile LAS unsigned*)&xb_words);
    DUP(1, phase_prep(params_ptr(), ldsf););
    grid.sync();
    for (int l = 0; l < 2; ++l) {
        const bool last = (l == 1);
        for (int g = 0; g < NG + (last ? 0 : 1); ++g) {
            const bool cchain = (g == NG);
            if (!cchain) {
                if (g == 0) {
                    DUP(2, phase_norm(params_ptr(), g, l, 0, M, false););
                    GSYNC();
                }
                DUP(3, { CP p = params_ptr(); unsigned char* ws = p->ws; const int G = gridDim.x, cb = blockIdx.x;
                  pg8::Gemm gm{(const bf16_t*)(ws + O_AN), (const bf16_t*)(ws + O_WIN + l * SZ_WIN), M, UC, D, 0, 0};
                  pg8::StaticOrder S; S.init(M, UC, G, cb, 1); EpiU E{(bf16_t*)(ws + O_U)}; pg8::gemm_phase(ldsg, gm, S, E); });
                GSYNC();
                DUP(12, phase_mixprep(params_ptr(), g, l, last, rep_ == 0););
                DUP(4, phase_vtrans(params_ptr(), (unsigned*)shm););
                GSYNC();
                DUP(5, phase_scan(params_ptr(), !last, shm););
                DUP(6, phase_attn(params_ptr(), g, l, !last, shm););
                GSYNC();
                DUP(7, phase_ssdfin(params_ptr(), g, l, last ? ML : M););
                GSYNC();
            }
            const int Mr = cchain ? NCTX : ML;
            DUP(8, { CP p = params_ptr(); unsigned char* ws = p->ws; const int G = gridDim.x, cb = blockIdx.x;
              pg8::Gemm gm{(const bf16_t*)(ws + (cchain ? O_YBRC : O_YBR)), (const bf16_t*)(ws + O_WBR + l * SZ_WBR), Mr, D, D, (size_t)(cchain ? NCTX : M) * D * 2, (size_t)D * D * 2};
              pg8::StaticOrder S; S.init(Mr, D, G, cb, 3);
              EpiMerge E{cchain ? (const bf16_t*)(ws + O_GATEC) : (const bf16_t*)(ws + O_U) + cGATE, cchain ? 3072 : UC, (bf16_t*)(ws + O_MRGB)}; pg8::gemm_phase(ldsg, gm, S, E); });
            GSYNC();
            DUP(9, { CP p = params_ptr(); unsigned char* ws = p->ws; const int G = gridDim.x, cb = blockIdx.x;
              const float* modl = (const float*)(ws + O_MOD) + (size_t)l * 33 * 6144;
              float* hl = p->out + (size_t)g * ML * D; float* hc = (float*)(ws + O_HC) + (cchain ? (size_t)0 : (size_t)g * MC * D);
              pg8::Gemm gm{(const bf16_t*)(ws + O_MRGB), (const bf16_t*)(ws + O_WOUT + l * SZ_WOUT), Mr, D, D, 0, 0};
              pg8::StaticOrder S; S.init(Mr, D, G, cb, 1); EpiRes E{hl, hc, modl + 2048, g, rep_ == 0 ? 1.f : 0.f, cchain ? 1 : 0, (l == 0 && rep_ == 0) ? (cchain ? (long)(p->ctx - hc) : (long)((p->x + (size_t)g * ML * D) - hl)) : 0L}; pg8::gemm_phase(ldsg, gm, S, E); });
            GSYNC();
            DUP(10, phase_norm(params_ptr(), g, l, 1, Mr, cchain););
            GSYNC();
            DUP(11, { CP p = params_ptr(); unsigned char* ws = p->ws; const int G = gridDim.x, cb = blockIdx.x;
              pg8::Gemm gm{(const bf16_t*)(ws + O_AN), (const bf16_t*)(ws + O_WFF1 + l * SZ_WFF), Mr, 4096, D, 0, 0};
              pg8::StaticOrder S; S.init(Mr, 4096, G, cb, 1); EpiFF1 E{(bf16_t*)(ws + O_U)}; pg8::gemm_phase(ldsg, gm, S, E); });
            GSYNC();
            DUP(13, { CP p = params_ptr(); unsigned char* ws = p->ws; const int G = gridDim.x, cb = blockIdx.x;
              const float* modl = (const float*)(ws + O_MOD) + (size_t)l * 33 * 6144;
              float* hl = p->out + (size_t)g * ML * D; float* hc = (float*)(ws + O_HC) + (cchain ? (size_t)0 : (size_t)g * MC * D);
              pg8::Gemm gm{(const bf16_t*)(ws + O_U), (const bf16_t*)(ws + O_WFF2 + l * SZ_WFF), Mr, D, 4096, 0, 0};
              pg8::StaticOrder S; S.init(Mr, D, G, cb, 1); EpiRes E{hl, hc, modl + 5120, g, rep_ == 0 ? 1.f : 0.f, cchain ? 1 : 0, 0L}; pg8::gemm_phase(ldsg, gm, S, E); });
            if (g + 1 < NG) phase_norm(params_ptr(), g + 1, l, 0, M, false);
            GSYNC();
        }
    }
    for (int g = 0; g < NG; ++g) phase_final(params_ptr(), g);
}

extern "C" void kernel_launch(void* const* d_in, const int* in_sizes, int n_in, void* d_out, int out_size, void* d_ws, size_t ws_size, hipStream_t stream) {
    constexpr size_t kDynLds = 155648;
    static_assert(ATT_LDS_END <= 155648, "attention LDS image too large");
    static int grid_blocks = 0;
    if (grid_blocks == 0) {
        if (n_in != 24 || ws_size < WS_END) { fprintf(stderr, "kernel_launch: need 24 inputs and %zu bytes of workspace, got %d / %zu\n", (size_t)WS_END, n_in, ws_size); grid_blocks = -1; return; }
        int dev = 0, cus = 0, per_cu = 0;
        (void)hipGetDevice(&dev);
        (void)hipDeviceGetAttribute(&cus, hipDeviceAttributeMultiprocessorCount, dev);
        (void)hipFuncSetAttribute((const void*)fwd_megakernel, hipFuncAttributeMaxDynamicSharedMemorySize, (int)kDynLds);
        (void)hipOccupancyMaxActiveBlocksPerMultiprocessor(&per_cu, (const void*)fwd_megakernel, 512, kDynLds);
        if (per_cu < 1) per_cu = 1;
        grid_blocks = cus * per_cu;
        (void)hipGetLastError();
    }
    if (grid_blocks < 0) return;
    Params p{};
    const float** pp = (const float**)&p;
    for (int i = 0; i < 24; ++i) pp[i] = (const float*)d_in[i];
    p.out = (float*)d_out; p.ws = (unsigned char*)d_ws;
    (void)hipMemsetAsync((unsigned char*)d_ws + O_BAR, 0, 16384, stream);
    void* args[] = {&p};
    hipError_t e = hipLaunchCooperativeKernel((void*)fwd_megakernel, dim3(grid_blocks), dim3(512), args, kDynLds, stream);
    if (e != hipSuccess) fprintf(stderr, "cooperative launch failed: %s (grid %d)\n", hipGetErrorString(e), grid_blocks);
}
```

```cpp
#include <hip/hip_runtime.h>
#include <hip/hip_cooperative_groups.h>
#include <cstdio>
namespace cg = cooperative_groups;
#ifndef PROBE_DUP
#define PROBE_DUP 0
#endif
#define DUP(n, ...) do { _Pragma("nounroll") for (int rep_ = 0; rep_ < ((PROBE_DUP == (n)) ? 2 : 1); ++rep_) { __VA_ARGS__ } } while (0)

#define LAS __attribute__((address_space(3)))
typedef unsigned short bf16_t;
typedef short bf16x8 __attribute__((ext_vector_type(8)));
typedef float f32x4 __attribute__((ext_vector_type(4)));
typedef unsigned u32x4_t __attribute__((ext_vector_type(4)));

constexpr int D = 1024, NB = 32, L = 2048, CTX = 256;
constexpr int GB = 8, NG = NB / GB, ML = GB * L, MC = GB * CTX, M = ML + MC;
constexpr int UC = 12032, IN_COLS = 11808;
constexpr int cCB = 0, cCC = 1024, cCX = 2048, cZ = 3072, cXBC = 4096, cQ = 5632, cK = 6656, cV = 7680, cGATE = 8704, cDT = 11776;
constexpr int XW = 1536, NCTX = NB * CTX;
constexpr float EPS = 1e-6f;

constexpr size_t SZ_WIN = (size_t)UC * D * 2, SZ_WBR = (size_t)3 * D * D * 2, SZ_WOUT = (size_t)D * D * 2, SZ_WFF = (size_t)4 * D * D * 2;
constexpr size_t O_WIN = 0;
constexpr size_t O_WBR = O_WIN + 2 * SZ_WIN;
constexpr size_t O_WOUT = O_WBR + 2 * SZ_WBR;
constexpr size_t O_WFF1 = O_WOUT + 2 * SZ_WOUT;
constexpr size_t O_WFF2 = O_WFF1 + 2 * SZ_WFF;
constexpr size_t O_HC = O_WFF2 + 2 * SZ_WFF;
constexpr size_t O_MOD = O_HC + (size_t)NB * CTX * D * 4;
constexpr size_t O_ROPE = O_MOD + (size_t)2 * 33 * 6144 * 4 + 256 * 3;
constexpr size_t O_AN = O_ROPE + (size_t)2048 * 64 * 4;
constexpr size_t O_U = O_AN + (size_t)M * D * 2;
constexpr size_t O_XBCS = O_U + (size_t)M * UC * 2;
constexpr size_t O_DTS = O_XBCS + (size_t)M * XW * 2;
constexpr size_t O_DECS = O_DTS + (size_t)M * 32 * 4;
constexpr size_t O_YDIR = O_DECS + (size_t)M * 32 * 4;
constexpr size_t O_YBR = O_YDIR + (size_t)2 * M * D * 2;
constexpr size_t O_MRGB = O_YBR + (size_t)3 * M * D * 2;
constexpr size_t O_VT = O_MRGB + (size_t)M * D * 2;
constexpr size_t O_BAR = O_VT + (size_t)GB * 1024 * 2304 * 2;
constexpr size_t O_YBRC = O_BAR + 16384;
constexpr size_t O_GATEC = O_YBRC + (size_t)3 * NB * CTX * D * 2;
constexpr size_t WS_END = O_GATEC + (size_t)NB * CTX * 3072 * 2;
static_assert(WS_END <= ((size_t)1 << 30), "workspace map exceeds 1 GiB");

struct Params {
    const float *x, *c, *ctx, *c_ctx, *w_ada, *b_ada, *norm1_w, *w_in, *conv_mix_w, *ssd_conv_w, *ssd_conv_b, *ssd_a_log, *ssd_dt_bias, *ssd_d, *ssd_norm_w,
        *na_rpb, *w_br_conv, *w_br_ssd, *w_br_na, *w_out, *norm2_w, *w_ff1, *w_ff2, *final_norm_w;
    float* out; unsigned char* ws;
};

typedef const __attribute__((address_space(4))) Params* CP;
__device__ __forceinline__ CP params_ptr() { unsigned long long k = (unsigned long long)__builtin_amdgcn_kernarg_segment_ptr(); asm volatile("" : "+s"(k)); return (CP)k; }
__device__ __forceinline__ int fresh_tid() { int t = threadIdx.x; asm volatile("" : "+v"(t)); return t; }
__device__ __forceinline__ float bflo(unsigned u) { return __uint_as_float(u << 16); }
__device__ __forceinline__ float bfhi(unsigned u) { return __uint_as_float(u & 0xffff0000u); }
__device__ __forceinline__ unsigned f2bf(float f) { unsigned u = __float_as_uint(f); u += 0x7FFFu + ((u >> 16) & 1u); return u >> 16; }
__device__ __forceinline__ unsigned pack2(float lo, float hi) { unsigned r; asm volatile("v_cvt_pk_bf16_f32 %0, %1, %2" : "=v"(r) : "v"(lo), "v"(hi)); return r; }
__device__ __forceinline__ void unpack8(const uint4 v, float (&f)[8]) { f[0] = bflo(v.x); f[1] = bfhi(v.x); f[2] = bflo(v.y); f[3] = bfhi(v.y); f[4] = bflo(v.z); f[5] = bfhi(v.z); f[6] = bflo(v.w); f[7] = bfhi(v.w); }
__device__ __forceinline__ uint4 pack8(const float (&f)[8]) { uint4 v; v.x = pack2(f[0], f[1]); v.y = pack2(f[2], f[3]); v.z = pack2(f[4], f[5]); v.w = pack2(f[6], f[7]); return v; }
__device__ __forceinline__ float silu_f(float v) { return v * __builtin_amdgcn_rcpf(1.f + __expf(-v)); }
__device__ __forceinline__ float sigmoid_f(float v) { return __builtin_amdgcn_rcpf(1.f + __expf(-v)); }
__device__ __forceinline__ float x32_max(float v) { const auto r = __builtin_amdgcn_permlane32_swap(__float_as_uint(v), __float_as_uint(v), false, false); return fmaxf(__uint_as_float(r[0]), __uint_as_float(r[1])); }
__device__ __forceinline__ float x16_max(float v) { const auto r = __builtin_amdgcn_permlane16_swap(__float_as_uint(v), __float_as_uint(v), false, false); return fmaxf(__uint_as_float(r[0]), __uint_as_float(r[1])); }
__device__ __forceinline__ float x32_sum(float v) { const auto r = __builtin_amdgcn_permlane32_swap(__float_as_uint(v), __float_as_uint(v), false, false); return __uint_as_float(r[0]) + __uint_as_float(r[1]); }
__device__ __forceinline__ float x16_sum(float v) { const auto r = __builtin_amdgcn_permlane16_swap(__float_as_uint(v), __float_as_uint(v), false, false); return __uint_as_float(r[0]) + __uint_as_float(r[1]); }
__device__ __forceinline__ float row16_sum(float v) {
    v += __int_as_float(__builtin_amdgcn_update_dpp(0, __float_as_int(v), 0xB1, 0xF, 0xF, true));
    v += __int_as_float(__builtin_amdgcn_update_dpp(0, __float_as_int(v), 0x4E, 0xF, 0xF, true));
    v += __int_as_float(__builtin_amdgcn_update_dpp(0, __float_as_int(v), 0x141, 0xF, 0xF, true));
    v += __int_as_float(__builtin_amdgcn_update_dpp(0, __float_as_int(v), 0x140, 0xF, 0xF, true));
    return v;
}
__device__ __forceinline__ float wave_sum(float v) { v = row16_sum(v); v = x16_sum(v); v = x32_sum(v); return v; }

namespace pg8 {
constexpr int BM = 256, BK = 64, HALF = 128, HTB = HALF * BK * 2, STAGE_BYTES = 8 * HTB, NXCD = 8, WGM = 8;
__device__ __forceinline__ int lds_byte(int r, int c) { const int st = (r >> 4) * 2 + (c >> 5), rr = r & 15, cc = c & 31, ob = rr * 64 + cc * 2; return st * 1024 + (ob ^ (((ob >> 9) & 1) << 5)); }
__device__ __forceinline__ void stage_rc(int b, int& R, int& C) { const int st = b / 1024, sb = b % 1024, swz = sb ^ (((sb >> 9) & 1) << 5); R = (st >> 1) * 16 + swz / 64; C = (st & 1) * 32 + (swz % 64) / 2; }
__device__ __forceinline__ int perm32(int rho) { const int n = rho >> 4, i = rho & 15; return 8 * (i >> 2) + 4 * n + (i & 3); }
struct Unit { int pm, pn, z; };
struct Gemm { const bf16_t* A; const bf16_t* Bt; int M, N, K; size_t azs, bzs; };
struct StaticOrder {
    int nM, nN, nwg, G, c, nz;
    __device__ void init(int M_, int N_, int G_, int c_, int nz_) { nM = M_ / BM; nN = N_ / BM; nwg = nM * nN; G = G_; c = c_; nz = nz_; }
    __device__ bool next(int i, Unit& u) const {
        const int ti = i / nz; u.z = i - ti * nz;
        const long Lx = (long)ti * G + c; if (Lx >= nwg) return false;
        int wgid = (int)Lx; { const int q = nwg / NXCD, r = nwg % NXCD, xcd = wgid % NXCD, off = wgid / NXCD; wgid = (xcd < r ? xcd * (q + 1) : r * (q + 1) + (xcd - r) * q) + off; }
        const int nig = WGM * nN, gid = wgid / nig, fm = gid * WGM, gsz = (nM - fm) < WGM ? (nM - fm) : WGM;
        u.pm = fm + ((wgid % nig) % gsz); u.pn = (wgid % nig) / gsz; return true;
    }
};
template <class Epi>
__device__ __forceinline__ void gemm_phase(LAS unsigned char* lds, const Gemm g, const StaticOrder& S, const Epi& E) {
    const int tid = fresh_tid(), wid = __builtin_amdgcn_readfirstlane(tid >> 6), lane = tid & 63, wr = wid >> 2, wc = wid & 3, fr = lane & 15, fq = lane >> 4;
    const int K = g.K, nt = K / BK;
    unsigned voffA[2], voffB[2];
#pragma unroll
    for (int i = 0; i < 2; ++i) { int R, C; stage_rc(tid * 16 + i * 8192, R, C); const int Rb = Epi::PERM ? ((R & ~31) + perm32(R & 31)) : R;
        voffA[i] = (unsigned)(R * K + C) * 2u; voffB[i] = (unsigned)(Rb * K + C) * 2u; }
    const size_t kstep = (size_t)(BK * 2);
    const size_t hstep = (size_t)HALF * K * 2;
    const size_t tstep = 2 * hstep;
    const unsigned ldsw = (unsigned)wid * 1024u;
    const int aoff = lds_byte(wr * 64 + fr, fq * 8), boff = lds_byte(wc * 32 + fr, fq * 8);
#define PG8_SA(b, h) (((b) * 2 + (h)) * HTB)
#define PG8_SB(b, h) ((4 + (b) * 2 + (h)) * HTB)
#define PG8_STAGE(bufoff, gbase, voff) do { _Pragma("unroll") for (int _i = 0; _i < 2; ++_i) \
        __builtin_amdgcn_global_load_lds((const unsigned*)((const char*)(gbase) + (voff)[_i]), (LAS unsigned*)(lds + (bufoff) + ldsw + _i * 8192), 16, 0, 0); } while (0)
#define PG8_LDA(dst, b, h) do { _Pragma("unroll") for (int m = 0; m < 4; ++m) _Pragma("unroll") for (int k = 0; k < 2; ++k) dst[m][k] = *(const LAS bf16x8*)(lds + PG8_SA(b, h) + aoff + m * 2048 + k * 1024); } while (0)
#define PG8_LDB(dst, b, h) do { _Pragma("unroll") for (int n = 0; n < 2; ++n) _Pragma("unroll") for (int k = 0; k < 2; ++k) dst[n][k] = *(const LAS bf16x8*)(lds + PG8_SB(b, h) + boff + n * 2048 + k * 1024); } while (0)
#define PG8_MMA(ai, bj, At, Bt) do { __builtin_amdgcn_s_setprio(1); _Pragma("unroll") for (int m = 0; m < 4; ++m) _Pragma("unroll") for (int n = 0; n < 2; ++n) _Pragma("unroll") for (int k = 0; k < 2; ++k) \
        acc[ai][bj][m][n] = __builtin_amdgcn_mfma_f32_16x16x32_bf16(Bt[n][k], At[m][k], acc[ai][bj][m][n], 0, 0, 0); __builtin_amdgcn_s_setprio(0); } while (0)
#define PG8_WAIT_V(n) asm volatile("s_waitcnt vmcnt(" #n ")" ::: "memory")
#define PG8_WAIT_L(n) asm volatile("s_waitcnt lgkmcnt(" #n ")" ::: "memory")
#define PG8_BAR __builtin_amdgcn_s_barrier()
#define PG8_SCHED __builtin_amdgcn_sched_barrier(0)
    Unit cur, nxt; int ui = 0;
    if (!S.next(0, cur)) return;
    f32x4 acc[2][2][4][2];
#pragma unroll
    for (int a = 0; a < 2; ++a)
#pragma unroll
        for (int b = 0; b < 2; ++b)
#pragma unroll
            for (int m = 0; m < 4; ++m)
#pragma unroll
                for (int n = 0; n < 2; ++n) acc[a][b][m][n] = (f32x4){0.f, 0.f, 0.f, 0.f};
    bf16x8 At[4][2], B0[2][2], B1[2][2];
    const char* cA = (const char*)g.A + (size_t)cur.z * g.azs + (size_t)cur.pm * tstep; const char* cB = (const char*)g.Bt + (size_t)cur.z * g.bzs + (size_t)cur.pn * tstep;
    PG8_STAGE(PG8_SB(0, 0), cB, voffB); PG8_STAGE(PG8_SA(0, 0), cA, voffA); PG8_STAGE(PG8_SB(0, 1), cB + hstep, voffB); PG8_STAGE(PG8_SA(0, 1), cA + hstep, voffA);
    if (wr == 1) PG8_BAR;
    PG8_WAIT_V(4); PG8_BAR;
    PG8_STAGE(PG8_SB(1, 0), cB + kstep, voffB); PG8_STAGE(PG8_SA(1, 0), cA + kstep, voffA); PG8_STAGE(PG8_SB(1, 1), cB + hstep + kstep, voffB);
    PG8_WAIT_V(6); PG8_BAR;
    for (;;) {
        const bool has_next = S.next(ui + 1, nxt);
        const char* nA = has_next ? (const char*)g.A + (size_t)nxt.z * g.azs + (size_t)nxt.pm * tstep : cA; const char* nB = has_next ? (const char*)g.Bt + (size_t)nxt.z * g.bzs + (size_t)nxt.pn * tstep : cB;
        for (int t = 0; t < nt; t += 2) {
            const bool last = (t == nt - 2);
            const char* a1 = cA + (size_t)(t + 1) * kstep;
            const char* a2 = last ? nA : cA + (size_t)(t + 2) * kstep; const char* b2 = last ? nB : cB + (size_t)(t + 2) * kstep;
            const char* a3 = a2 + kstep; const char* b3 = b2 + kstep;
            PG8_LDB(B0, 0, 0); PG8_SCHED; PG8_LDA(At, 0, 0); PG8_STAGE(PG8_SA(1, 1), a1 + hstep, voffA);
            PG8_WAIT_L(8); PG8_BAR; PG8_WAIT_L(0); PG8_MMA(0, 0, At, B0); PG8_BAR; PG8_SCHED;
            PG8_LDB(B1, 0, 1); PG8_STAGE(PG8_SB(0, 0), b2, voffB);
            PG8_BAR; PG8_WAIT_L(0); PG8_MMA(0, 1, At, B1); PG8_BAR;
            PG8_LDA(At, 0, 1); PG8_STAGE(PG8_SA(0, 0), a2, voffA);
            PG8_BAR; PG8_WAIT_L(0); PG8_MMA(1, 0, At, B0); PG8_BAR; PG8_SCHED;
            PG8_STAGE(PG8_SB(0, 1), b2 + hstep, voffB);
            PG8_WAIT_V(6); PG8_BAR; PG8_MMA(1, 1, At, B1); PG8_BAR;
            PG8_LDB(B0, 1, 0); PG8_SCHED; PG8_LDA(At, 1, 0); PG8_STAGE(PG8_SA(0, 1), a2 + hstep, voffA);
            PG8_WAIT_L(8); PG8_BAR; PG8_WAIT_L(0); PG8_MMA(0, 0, At, B0); PG8_BAR; PG8_SCHED;
            PG8_LDB(B1, 1, 1); PG8_STAGE(PG8_SB(1, 0), b3, voffB);
            PG8_BAR; PG8_WAIT_L(0); PG8_MMA(0, 1, At, B1); PG8_BAR;
            PG8_LDA(At, 1, 1); PG8_STAGE(PG8_SA(1, 0), a3, voffA);
            PG8_BAR; PG8_WAIT_L(0); PG8_MMA(1, 0, At, B0); PG8_BAR; PG8_SCHED;
            PG8_STAGE(PG8_SB(1, 1), b3 + hstep, voffB);
            PG8_WAIT_V(6); PG8_BAR; PG8_MMA(1, 1, At, B1); PG8_BAR;
        }
        E(acc, cur, wr, wc, fr, fq);
        if (!has_next) break;
        if (!E.keep(cur))
#pragma unroll
        for (int a = 0; a < 2; ++a)
#pragma unroll
            for (int b = 0; b < 2; ++b)
#pragma unroll
                for (int m = 0; m < 4; ++m)
#pragma unroll
                    for (int n = 0; n < 2; ++n) acc[a][b][m][n] = (f32x4){0.f, 0.f, 0.f, 0.f};
        cur = nxt; cA = nA; cB = nB; ++ui;
    }
    PG8_WAIT_V(0);
    if (wr == 0) PG8_BAR;
    PG8_BAR;
#undef PG8_SA
#undef PG8_SB
#undef PG8_STAGE
#undef PG8_LDA
#undef PG8_LDB
#undef PG8_MMA
#undef PG8_WAIT_V
#undef PG8_WAIT_L
#undef PG8_BAR
#undef PG8_SCHED
}
}
using pg8::Unit;

struct EpiU {
    static constexpr bool PERM = true;
    __device__ __forceinline__ bool keep(const Unit&) const { return false; }
    bf16_t* U;
    __device__ __forceinline__ void operator()(f32x4 (&acc)[2][2][4][2], const Unit& u, int wr, int wc, int fr, int fq) const {
        const int row0 = u.pm * 256 + wr * 64 + fr, col0 = u.pn * 256 + wc * 32 + 8 * fq;
        const bool sg = (u.pn >= cGATE / 256) && (u.pn < cDT / 256);
#pragma unroll
        for (int ai = 0; ai < 2; ++ai)
#pragma unroll
            for (int m = 0; m < 4; ++m) { bf16_t* rowp = U + (size_t)(row0 + ai * 128 + m * 16) * UC + col0;
#pragma unroll
                for (int bj = 0; bj < 2; ++bj) { f32x4 v0 = acc[ai][bj][m][0], v1 = acc[ai][bj][m][1];
                    if (sg) {
#pragma unroll
                        for (int j = 0; j < 4; ++j) { v0[j] = sigmoid_f(v0[j]); v1[j] = sigmoid_f(v1[j]); } }
                    uint4 o; o.x = pack2(v0[0], v0[1]); o.y = pack2(v0[2], v0[3]); o.z = pack2(v1[0], v1[1]); o.w = pack2(v1[2], v1[3]);
                    *(uint4*)(rowp + bj * 128) = o; } }
    }
};
struct EpiMerge {
    static constexpr bool PERM = true;
    const bf16_t* G; int gld; bf16_t* MB;
    __device__ __forceinline__ bool keep(const Unit& u) const { return u.z < 2; }
    __device__ __forceinline__ void operator()(f32x4 (&acc)[2][2][4][2], const Unit& u, int wr, int wc, int fr, int fq) const {
        const int row0 = u.pm * 256 + wr * 64 + fr, col0 = u.pn * 256 + wc * 32 + 8 * fq;
#pragma unroll
        for (int ai = 0; ai < 2; ++ai) {
            uint4 g0[4][2], g1[4][2];
#pragma unroll
            for (int m = 0; m < 4; ++m)
#pragma unroll
                for (int bj = 0; bj < 2; ++bj) { const bf16_t* gp = G + (size_t)(row0 + ai * 128 + m * 16) * gld + u.z * 1024 + col0 + bj * 128;
                    g0[m][bj] = *(const uint4*)gp; g1[m][bj] = (u.z < 2) ? *(const uint4*)(gp + 1024) : g0[m][bj]; }
#pragma unroll
            for (int m = 0; m < 4; ++m) { const size_t row = (size_t)(row0 + ai * 128 + m * 16);
#pragma unroll
                for (int bj = 0; bj < 2; ++bj) { const int col = col0 + bj * 128;
                    float gz[8]; unpack8(g0[m][bj], gz);
                    if (u.z < 2) { float gn[8]; unpack8(g1[m][bj], gn);
#pragma unroll
                        for (int j = 0; j < 8; ++j) { const float rt = fmaxf(gz[j], 1e-20f) * __builtin_amdgcn_rcpf(fmaxf(gn[j], 1e-20f)); acc[ai][bj][m][j >> 2][j & 3] *= rt; } }
                    else { f32x4 v0 = acc[ai][bj][m][0], v1 = acc[ai][bj][m][1];
#pragma unroll
                        for (int j = 0; j < 4; ++j) { v0[j] *= fmaxf(gz[j], 1e-20f); v1[j] *= fmaxf(gz[4 + j], 1e-20f); }
                        uint4 o; o.x = pack2(v0[0], v0[1]); o.y = pack2(v0[2], v0[3]); o.z = pack2(v1[0], v1[1]); o.w = pack2(v1[2], v1[3]); *(uint4*)(MB + row * D + col) = o; } } }
        }
    }
};
struct EpiRes {
    static constexpr bool PERM = false;
    __device__ __forceinline__ bool keep(const Unit&) const { return false; }
    float* hl; float* hc; const float* gate;
    int g; float gs; int allctx; long rdel;
    __device__ __forceinline__ void operator()(f32x4 (&acc)[2][2][4][2], const Unit& u, int wr, int wc, int fr, int fq) const {
        const int lr0 = u.pm * 256; const bool isctx = allctx || lr0 >= ML;
        float* base = allctx ? hc + (size_t)lr0 * D : (isctx ? hc + (size_t)(lr0 - ML) * D : hl + (size_t)lr0 * D);
        const float* rbase = base + rdel;
        const float* gp = gate + (size_t)(isctx ? 32 : g * GB + (lr0 >> 11)) * 6144;
        const int r0 = wr * 64 + fr, col0 = u.pn * 256 + wc * 32 + 4 * fq;
        f32x4 gv[2][2];
#pragma unroll
        for (int bj = 0; bj < 2; ++bj)
#pragma unroll
            for (int n = 0; n < 2; ++n) gv[bj][n] = *(const f32x4*)(gp + col0 + bj * 128 + n * 16) * gs;
#pragma unroll
        for (int ai = 0; ai < 2; ++ai) {
            f32x4 hv[4][2][2];
#pragma unroll
            for (int m = 0; m < 4; ++m)
#pragma unroll
                for (int bj = 0; bj < 2; ++bj)
#pragma unroll
                    for (int n = 0; n < 2; ++n) hv[m][bj][n] = *(const f32x4*)(rbase + (size_t)(r0 + ai * 128 + m * 16) * D + col0 + bj * 128 + n * 16);
#pragma unroll
            for (int m = 0; m < 4; ++m)
#pragma unroll
                for (int bj = 0; bj < 2; ++bj)
#pragma unroll
                    for (int n = 0; n < 2; ++n) *(f32x4*)(base + (size_t)(r0 + ai * 128 + m * 16) * D + col0 + bj * 128 + n * 16) = hv[m][bj][n] + gv[bj][n] * acc[ai][bj][m][n];
        }
    }
};
struct EpiFF1 {
    static constexpr bool PERM = true;
    __device__ __forceinline__ bool keep(const Unit&) const { return false; }
    bf16_t* H;
    __device__ __forceinline__ void operator()(f32x4 (&acc)[2][2][4][2], const Unit& u, int wr, int wc, int fr, int fq) const {
        const int row0 = u.pm * 256 + wr * 64 + fr, col0 = u.pn * 256 + wc * 32 + 8 * fq;
#pragma unroll
        for (int ai = 0; ai < 2; ++ai)
#pragma unroll
            for (int m = 0; m < 4; ++m) { bf16_t* rowp = H + (size_t)(row0 + ai * 128 + m * 16) * 4096 + col0;
#pragma unroll
                for (int bj = 0; bj < 2; ++bj) { f32x4 v0 = acc[ai][bj][m][0], v1 = acc[ai][bj][m][1];
#pragma unroll
                    for (int j = 0; j < 4; ++j) { const float a = fmaxf(v0[j], 0.f), b = fmaxf(v1[j], 0.f); v0[j] = a * a; v1[j] = b * b; }
                    uint4 o; o.x = pack2(v0[0], v0[1]); o.y = pack2(v0[2], v0[3]); o.z = pack2(v1[0], v1[1]); o.w = pack2(v1[2], v1[3]);
                    *(uint4*)(rowp + bj * 128) = o; } }
    }
};

__device__ __forceinline__ int w_in_src_col(int j) { return j < 5632 ? j : (j < 11776 ? j + 32 : (j < 11808 ? j - 11776 + 5632 : -1)); }

__device__ void transpose_weight(const float* __restrict__ W, int ld, int Kd, int Nout, bool mapped, bf16_t* __restrict__ Wt, float* lds) {
    const int tid = fresh_tid(); const int tn = Nout / 256, tk = Kd / 64;
    constexpr int P = 257;
    for (int t = blockIdx.x; t < tn * tk; t += gridDim.x) {
        const int n0 = (t % tn) * 256, k0 = (t / tn) * 64;
        __syncthreads();
#pragma unroll
        for (int i = 0; i < 8; ++i) { const int idx = i * 512 + tid, kk = idx >> 6, nn = (idx & 63) * 4; const int sc = mapped ? w_in_src_col(n0 + nn) : n0 + nn;
            const float4 v = sc >= 0 ? *(const float4*)(W + (size_t)(k0 + kk) * ld + sc) : make_float4(0.f, 0.f, 0.f, 0.f);
            float* d = lds + kk * P + nn; d[0] = v.x; d[1] = v.y; d[2] = v.z; d[3] = v.w; }
        __syncthreads();
#pragma unroll
        for (int i = 0; i < 4; ++i) { const int idx = i * 512 + tid, nn = idx >> 3, kp = (idx & 7) * 8;
            float f[8];
#pragma unroll
            for (int j = 0; j < 8; ++j) f[j] = lds[(kp + j) * P + nn];
            *(uint4*)(Wt + (size_t)(n0 + nn) * Kd + k0 + kp) = pack8(f); }
    }
}

__device__ void phase_prep(CP p, float* lds) {
    unsigned char* ws = p->ws; const int tid = fresh_tid();
    for (int l = 0; l < 2; ++l) {
        transpose_weight(p->w_in + (size_t)l * D * IN_COLS, IN_COLS, D, UC, true, (bf16_t*)(ws + O_WIN + l * SZ_WIN), lds);
        transpose_weight(p->w_br_conv + (size_t)l * D * D, D, D, D, false, (bf16_t*)(ws + O_WBR + l * SZ_WBR), lds);
        transpose_weight(p->w_br_ssd + (size_t)l * D * D, D, D, D, false, (bf16_t*)(ws + O_WBR + l * SZ_WBR) + (size_t)D * D, lds);
        transpose_weight(p->w_br_na + (size_t)l * D * D, D, D, D, false, (bf16_t*)(ws + O_WBR + l * SZ_WBR) + (size_t)2 * D * D, lds);
        transpose_weight(p->w_out + (size_t)l * D * D, D, D, D, false, (bf16_t*)(ws + O_WOUT + l * SZ_WOUT), lds);
        transpose_weight(p->w_ff1 + (size_t)l * D * 4096, 4096, D, 4096, false, (bf16_t*)(ws + O_WFF1 + l * SZ_WFF), lds);
        transpose_weight(p->w_ff2 + (size_t)l * 4096 * D, D, 4096, D, false, (bf16_t*)(ws + O_WFF2 + l * SZ_WFF), lds);
    }
    {
        float* tab = (float*)(ws + O_ROPE);
        for (int i = blockIdx.x * 512 + tid; i < 2048 * 32; i += gridDim.x * 512) {
            const int t = i >> 5, j = i & 31, ii = j & 15; const int pos = (j < 16) ? (t >> 6) : (t & 63);
            const float inv = powf(10000.0f, -(float)(2 * ii) / 32.0f); const float ang = (float)pos * inv;
            tab[t * 64 + j] = cosf(ang); tab[t * 64 + 32 + j] = sinf(ang);
        }
    }
    float* mod = (float*)(ws + O_MOD);
    for (int job = blockIdx.x; job < 2 * 96; job += gridDim.x) {
        const int l = job / 96, j0 = (job % 96) * 64;
        __syncthreads();
        for (int i = tid; i < 32 * 1024; i += 512) lds[i] = silu_f(p->c[i]);
        __syncthreads();
        const int col = tid & 63, kp = tid >> 6;
        float acc[33];
#pragma unroll
        for (int r = 0; r < 33; ++r) acc[r] = 0.f;
        const float* wp = p->w_ada + (size_t)l * D * 6144 + j0 + col;
        for (int k = kp * 128; k < kp * 128 + 128; ++k) {
            const float wv = wp[(size_t)k * 6144];
#pragma unroll
            for (int r = 0; r < 32; ++r) acc[r] += lds[r * 1024 + k] * wv;
            acc[32] += silu_f(p->c_ctx[k]) * wv;
        }
        __syncthreads();
#pragma unroll
        for (int r = 0; r < 33; ++r) lds[(kp * 33 + r) * 64 + col] = acc[r];
        __syncthreads();
        for (int i = tid; i < 33 * 64; i += 512) { const int r = i >> 6, cc = i & 63; float s = 0.f;
#pragma unroll
            for (int q = 0; q < 8; ++q) s += lds[(q * 33 + r) * 64 + cc];
            mod[((size_t)l * 33 + r) * 6144 + j0 + cc] = s + p->b_ada[l * 6144 + j0 + cc]; }
    }
}

__device__ void phase_norm(CP p, int g, int l, int which, int Mrows, bool ctxall) {
    unsigned char* ws = p->ws; const int tid_ = fresh_tid(); const int lane = tid_ & 63, gw = blockIdx.x * 8 + (tid_ >> 6), nw = gridDim.x * 8;
    const bool first = (l == 0 && which == 0);
    const float* nwt = (which ? p->norm2_w : p->norm1_w) + l * D;
    const float* mod = (const float*)(ws + O_MOD) + (size_t)l * 33 * 6144 + which * 3072;
    bf16_t* AN = (bf16_t*)(ws + O_AN);
    float4 wv[4];
#pragma unroll
    for (int j = 0; j < 4; ++j) wv[j] = *(const float4*)(nwt + j * 256 + lane * 4);
    auto src_of = [&](int lr) -> const float* {
        const bool isctx = ctxall || lr >= ML;
        const size_t grow = ctxall ? (size_t)lr : (isctx ? (size_t)g * MC + (lr - ML) : (size_t)g * ML + lr);
        return (first ? (isctx ? p->ctx : p->x) : (isctx ? (const float*)(ws + O_HC) : (const float*)p->out)) + grow * D;
    };
    float4 v[4], nx[4];
    if (gw < Mrows) { const float* src = src_of(gw);
#pragma unroll
        for (int j = 0; j < 4; ++j) v[j] = *(const float4*)(src + j * 256 + lane * 4); }
    for (int lr = gw; lr < Mrows; lr += nw) {
        if (lr + nw < Mrows) { const float* src = src_of(lr + nw);
#pragma unroll
            for (int j = 0; j < 4; ++j) nx[j] = *(const float4*)(src + j * 256 + lane * 4); }
        const bool isctx = ctxall || lr >= ML;
        const float* mr = mod + (size_t)(isctx ? 32 : g * GB + (lr >> 11)) * 6144;
        float ss = 0.f;
#pragma unroll
        for (int j = 0; j < 4; ++j) ss += v[j].x * v[j].x + v[j].y * v[j].y + v[j].z * v[j].z + v[j].w * v[j].w;
        ss = wave_sum(ss);
        const float rs = rsqrtf(ss * (1.f / 1024.f) + EPS);
#pragma unroll
        for (int j = 0; j < 4; ++j) {
            const int col = j * 256 + lane * 4;
            const float4 w = wv[j], sh = *(const float4*)(mr + col), sc = *(const float4*)(mr + 1024 + col);
            uint2 o; o.x = pack2(v[j].x * rs * w.x * (1.f + sc.x) + sh.x, v[j].y * rs * w.y * (1.f + sc.y) + sh.y);
            o.y = pack2(v[j].z * rs * w.z * (1.f + sc.z) + sh.z, v[j].w * rs * w.w * (1.f + sc.w) + sh.w);
            *(uint2*)(AN + (size_t)lr * D + col) = o;
        }
#pragma unroll
        for (int j = 0; j < 4; ++j) v[j] = nx[j];
    }
}

__device__ void phase_mixprep(CP p, int g, int l, bool last, bool do_qk) {
    unsigned char* ws = p->ws; const int tid_ = fresh_tid(); const int lane = tid_ & 63, gw = blockIdx.x * 8 + (tid_ >> 6), nw = gridDim.x * 8;
    bf16_t* U = (bf16_t*)(ws + O_U); bf16_t* XB = (bf16_t*)(ws + O_XBCS); float* DTS = (float*)(ws + O_DTS); float* DECS = (float*)(ws + O_DECS);
    bf16_t* YC = (bf16_t*)(ws + O_YBR); const float* tab = (const float*)(ws + O_ROPE);
    const float* cw = p->conv_mix_w + (size_t)l * 3 * D; const float* sw = p->ssd_conv_w + (size_t)l * 3 * XW; const float* sb = p->ssd_conv_b + (size_t)l * XW;
    const int RP = (M + nw - 1) / nw; const int lr0 = gw * RP, lr1 = min(lr0 + RP, M);
    {
        float wv[2][3][8], pcx[2][8], ccx[2][8], ncx[2][8];
#pragma unroll
        for (int j = 0; j < 2; ++j)
#pragma unroll
            for (int k = 0; k < 3; ++k)
#pragma unroll
                for (int i = 0; i < 8; ++i) wv[j][k][i] = cw[k * D + (lane + 64 * j) * 8 + i];
        auto load_cx = [&](int lr, float (&cx)[2][8]) {
            if (lr < 0 || lr >= M) {
#pragma unroll
                for (int i = 0; i < 8; ++i) { cx[0][i] = 0.f; cx[1][i] = 0.f; }
                return; }
            const bf16_t* u = U + (size_t)lr * UC;
#pragma unroll
            for (int j = 0; j < 2; ++j) { const int ch = (lane + 64 * j) * 8; float c8[8], x8[8]; unpack8(*(const uint4*)(u + cCC + ch), c8); unpack8(*(const uint4*)(u + cCX + ch), x8);
#pragma unroll
                for (int i = 0; i < 8; ++i) cx[j][i] = c8[i] * x8[i]; }
        };
        if (lr0 < M) { load_cx(lr0 - 1, pcx); load_cx(lr0, ccx); }
        for (int lr = lr0; lr < lr1; ++lr) {
            load_cx(lr + 1, ncx);
            const bool isctx = lr >= ML; const int t = isctx ? ((lr - ML) & 255) : (lr & 2047); const int Ls = isctx ? 256 : 2048;
            const float mp = t > 0 ? 1.f : 0.f, mn = t < Ls - 1 ? 1.f : 0.f;
            if (!(isctx && last)) {
                const bf16_t* u0 = U + (size_t)lr * UC;
#pragma unroll
                for (int j = 0; j < 2; ++j) { const int ch = (lane + 64 * j) * 8;
                    float cb[8]; unpack8(*(const uint4*)(u0 + cCB + ch), cb);
                    float o[8];
#pragma unroll
                    for (int i = 0; i < 8; ++i) o[i] = cb[i] * (wv[j][0][i] * (pcx[j][i] * mp) + wv[j][1][i] * ccx[j][i] + wv[j][2][i] * (ncx[j][i] * mn));
                    bf16_t* yo = isctx ? (bf16_t*)(ws + O_YBRC) + ((size_t)g * MC + (lr - ML)) * D : YC + (size_t)lr * D;
                    *(uint4*)(yo + ch) = pack8(o); }
            }
#pragma unroll
            for (int i = 0; i < 8; ++i)
#pragma unroll
                for (int j = 0; j < 2; ++j) { pcx[j][i] = ccx[j][i]; ccx[j][i] = ncx[j][i]; }
        }
    }
    float sv[3][4][8], pxb[3][8], cxb[3][8], nxb[3][8];
#pragma unroll
    for (int j = 0; j < 3; ++j)
#pragma unroll
        for (int i = 0; i < 8; ++i) { const int ch = (lane + 64 * j) * 8 + i; sv[j][0][i] = sw[ch]; sv[j][1][i] = sw[XW + ch]; sv[j][2][i] = sw[2 * XW + ch]; sv[j][3][i] = sb[ch]; }
    auto load_xb = [&](int lr, float (&xb)[3][8]) {
        if (lr < 0 || lr >= M) {
#pragma unroll
            for (int i = 0; i < 8; ++i) { xb[0][i] = 0.f; xb[1][i] = 0.f; xb[2][i] = 0.f; }
            return; }
        const bf16_t* u = U + (size_t)lr * UC;
#pragma unroll
        for (int j = 0; j < 3; ++j) unpack8(*(const uint4*)(u + cXBC + (lane + 64 * j) * 8), xb[j]);
    };
    if (lr0 < M) { load_xb(lr0 - 1, pxb); load_xb(lr0, cxb); }
    for (int lr = lr0; lr < lr1; ++lr) {
        load_xb(lr + 1, nxb);
        const bool isctx = lr >= ML; const int t = isctx ? ((lr - ML) & 255) : (lr & 2047); const int Ls = isctx ? 256 : 2048;
        const float mp = t > 0 ? 1.f : 0.f, mn = t < Ls - 1 ? 1.f : 0.f;
        bf16_t* u0 = U + (size_t)lr * UC;
#pragma unroll
        for (int j = 0; j < 3; ++j) { const int ch = (lane + 64 * j) * 8; float o[8];
#pragma unroll
            for (int i = 0; i < 8; ++i) o[i] = silu_f(sv[j][3][i] + sv[j][0][i] * (pxb[j][i] * mp) + sv[j][1][i] * cxb[j][i] + sv[j][2][i] * (nxb[j][i] * mn));
            *(uint4*)(XB + (size_t)lr * XW + ch) = pack8(o); }
#pragma unroll
        for (int i = 0; i < 8; ++i)
#pragma unroll
            for (int j = 0; j < 3; ++j) { pxb[j][i] = cxb[j][i]; cxb[j][i] = nxb[j][i]; }
        if (lane < 32) {
            const float raw = bflo((unsigned)u0[cDT + lane]) + p->ssd_dt_bias[l * 32 + lane];
            const float dt = fmaxf(raw, 0.f) + log1pf(__expf(-fabsf(raw)));
            const float A = -__expf(p->ssd_a_log[l * 32 + lane]);
            DTS[(size_t)lr * 32 + lane] = dt; DECS[(size_t)lr * 32 + lane] = dt * A;
        }
        if (do_qk) {
            const int hd = lane >> 2, i0 = (lane & 3) * 4;
            float cr[4], cc[4], sr[4], sc[4];
#pragma unroll
            for (int i = 0; i < 4; ++i) { cr[i] = 1.f; cc[i] = 1.f; sr[i] = 0.f; sc[i] = 0.f; }
            if (!isctx) { const float* tb = tab + t * 64;
#pragma unroll
                for (int i = 0; i < 4; ++i) { cr[i] = tb[i0 + i]; cc[i] = tb[16 + i0 + i]; sr[i] = tb[32 + i0 + i]; sc[i] = tb[48 + i0 + i]; } }
#pragma unroll
            for (int qk = 0; qk < 2; ++qk) {
                if (qk == 1 && isctx) break;
                bf16_t* base = u0 + (qk ? cK : cQ) + hd * 64 + i0; const float scl = qk ? 1.f : 0.125f;
                const uint2 v0 = *(const uint2*)(base), v1 = *(const uint2*)(base + 16), v2 = *(const uint2*)(base + 32), v3 = *(const uint2*)(base + 48);
                const float a[4] = {bflo(v0.x), bfhi(v0.x), bflo(v0.y), bfhi(v0.y)}, b[4] = {bflo(v1.x), bfhi(v1.x), bflo(v1.y), bfhi(v1.y)};
                const float c2[4] = {bflo(v2.x), bfhi(v2.x), bflo(v2.y), bfhi(v2.y)}, d2[4] = {bflo(v3.x), bfhi(v3.x), bflo(v3.y), bfhi(v3.y)};
                float oa[4], ob[4], oc[4], od[4];
#pragma unroll
                for (int i = 0; i < 4; ++i) { oa[i] = (a[i] * cr[i] - b[i] * sr[i]) * scl; ob[i] = (b[i] * cr[i] + a[i] * sr[i]) * scl;
                    oc[i] = (c2[i] * cc[i] - d2[i] * sc[i]) * scl; od[i] = (d2[i] * cc[i] + c2[i] * sc[i]) * scl; }
                *(uint2*)(base) = make_uint2(pack2(oa[0], oa[1]), pack2(oa[2], oa[3])); *(uint2*)(base + 16) = make_uint2(pack2(ob[0], ob[1]), pack2(ob[2], ob[3]));
                *(uint2*)(base + 32) = make_uint2(pack2(oc[0], oc[1]), pack2(oc[2], oc[3])); *(uint2*)(base + 48) = make_uint2(pack2(od[0], od[1]), pack2(od[2], od[3]));
            }
        }
    }
}

__device__ void phase_scan(CP p, bool ctx_out, unsigned char* ldsb) {
    unsigned char* ws = p->ws; const int tid = fresh_tid(); const int lane = tid & 63, w = tid >> 6, fr = lane & 15, fq = lane >> 4;
    const int lt = w < 4 ? w : 11 - w;
    const bf16_t* XB = (const bf16_t*)(ws + O_XBCS); const float* DTS = (const float*)(ws + O_DTS); const float* AS = (const float*)(ws + O_DECS);
    bf16_t* YD = (bf16_t*)(ws + O_YDIR);
    constexpr int PT = 136;
    bf16_t* XT = (bf16_t*)ldsb; bf16_t* BT = XT + 64 * PT; bf16_t* HL = BT + 128 * PT; bf16_t* BR = HL + 64 * PT; float* CUM = (float*)(BR + 128 * PT);
    typedef unsigned u32x4 __attribute__((ext_vector_type(4)));
    for (int item = blockIdx.x; item < GB * 32; item += gridDim.x) {
        const int dir = item & 1, head = (item >> 1) & 15, bl = item >> 5, grp = head >> 3;
        auto row_of = [&](int s) -> int { return s < 256 ? (ML + bl * 256 + (dir ? 255 - s : s)) : (bl * 2048 + (dir ? 2047 - (s - 256) : (s - 256))); };
        f32x4 hacc[4];
#pragma unroll
        for (int i = 0; i < 4; ++i) hacc[i] = (f32x4){0.f, 0.f, 0.f, 0.f};
        __syncthreads();
        for (int i = tid; i < 64 * PT / 2; i += 512) ((unsigned*)HL)[i] = 0u;
        uint4 rx[2], rb[4]; float rdt[2], ra[2];
        auto load_chunk = [&](int ch) {
#pragma unroll
            for (int q = 0; q < 2; ++q) { const int lr = row_of(ch * 128 + 2 * lane + q); const bf16_t* row = XB + (size_t)lr * XW;
                rx[q] = *(const uint4*)(row + head * 64 + w * 8); rb[2 * q] = *(const uint4*)(row + 1024 + grp * 128 + w * 16); rb[2 * q + 1] = *(const uint4*)(row + 1024 + grp * 128 + w * 16 + 8);
                rdt[q] = DTS[(size_t)lr * 32 + dir * 16 + head]; ra[q] = AS[(size_t)lr * 32 + dir * 16 + head]; }
        };
        load_chunk(0);
        for (int ch = 0; ch < 18; ++ch) {
            const bool doy = ctx_out || ch >= 2;
            const int lrl = row_of(ch * 128 + 16 * lt + fr);
            bf16x8 cf[4];
            if (doy) { const bf16_t* cp = XB + (size_t)lrl * XW + 1280 + grp * 128 + fq * 8;
#pragma unroll
                for (int k = 0; k < 4; ++k) cf[k] = *(const bf16x8*)(cp + k * 32); }
            const float ps = ra[0] + ra[1]; float incl = ps;
            incl += __int_as_float(__builtin_amdgcn_update_dpp(0, __float_as_int(incl), 0x111, 0xF, 0xF, true));
            incl += __int_as_float(__builtin_amdgcn_update_dpp(0, __float_as_int(incl), 0x112, 0xF, 0xF, true));
            incl += __int_as_float(__builtin_amdgcn_update_dpp(0, __float_as_int(incl), 0x114, 0xF, 0xF, true));
            incl += __int_as_float(__builtin_amdgcn_update_dpp(0, __float_as_int(incl), 0x118, 0xF, 0xF, true));
            incl += __int_as_float(__builtin_amdgcn_update_dpp(0, __float_as_int(incl), 0x142, 0xA, 0xF, false));
            incl += __int_as_float(__builtin_amdgcn_update_dpp(0, __float_as_int(incl), 0x143, 0xC, 0xF, false));
            const float c0 = incl - ra[1], c1 = incl, total = __int_as_float(__builtin_amdgcn_readlane(__float_as_int(incl), 63));
            const float w0 = __expf(total - c0), w1 = __expf(total - c1), dec_total = __expf(total);
            if (w == 0) { CUM[2 * lane] = c0; CUM[2 * lane + 1] = c1; }
            { float x0[8], x1[8]; unpack8(rx[0], x0); unpack8(rx[1], x1);
#pragma unroll
              for (int i = 0; i < 8; ++i) ((unsigned*)(XT + (w * 8 + i) * PT))[lane] = pack2(x0[i] * rdt[0], x1[i] * rdt[1]); }
#pragma unroll
            for (int q = 0; q < 2; ++q) { *(uint4*)(BR + (2 * lane + q) * PT + w * 16) = rb[2 * q]; *(uint4*)(BR + (2 * lane + q) * PT + w * 16 + 8) = rb[2 * q + 1]; }
#pragma unroll
            for (int hh = 0; hh < 2; ++hh) { float b0[8], b1[8]; unpack8(rb[hh], b0); unpack8(rb[2 + hh], b1);
#pragma unroll
                for (int i = 0; i < 8; ++i) ((unsigned*)(BT + (w * 16 + hh * 8 + i) * PT))[lane] = pack2(b0[i] * w0, b1[i] * w1); }
            __syncthreads();
            if (ch + 1 < 18) load_chunk(ch + 1);
            if (doy) {
                const float cl = CUM[16 * lt + fr]; const float ecl = __expf(cl);
                f32x4 yacc[4];
#pragma unroll
                for (int pt = 0; pt < 4; ++pt) { f32x4 acc = (f32x4){0.f, 0.f, 0.f, 0.f};
#pragma unroll
                    for (int k = 0; k < 4; ++k) acc = __builtin_amdgcn_mfma_f32_16x16x32_bf16(*(const bf16x8*)(HL + (pt * 16 + fr) * PT + k * 32 + fq * 8), cf[k], acc, 0, 0, 0);
                    yacc[pt] = acc * ecl; }
                const int lidx = 16 * lt + fr;
#pragma unroll
                for (int sb = 0; sb < 4; ++sb) if (sb <= (lt >> 1)) {
                    f32x4 gt[2];
#pragma unroll
                    for (int t = 0; t < 2; ++t) { const int srow = sb * 32 + (fr >> 2) * 8 + t * 4 + (fr & 3);
                        const bf16_t* bp = BR + srow * PT + fq * 8; f32x4 acc = (f32x4){0.f, 0.f, 0.f, 0.f};
#pragma unroll
                        for (int k = 0; k < 4; ++k) acc = __builtin_amdgcn_mfma_f32_16x16x32_bf16(*(const bf16x8*)(bp + k * 32), cf[k], acc, 0, 0, 0);
                        gt[t] = acc; }
                    const float4 cs0 = *(const float4*)(CUM + sb * 32 + fq * 8), cs1 = *(const float4*)(CUM + sb * 32 + fq * 8 + 4);
                    const float csv[8] = {cs0.x, cs0.y, cs0.z, cs0.w, cs1.x, cs1.y, cs1.z, cs1.w};
                    float e[8];
#pragma unroll
                    for (int i = 0; i < 8; ++i) { const int sidx = sb * 32 + fq * 8 + i; e[i] = sidx <= lidx ? gt[i >> 2][i & 3] * __expf(fminf(cl - csv[i], 0.f)) : 0.f; }
                    const u32x4 pk = {pack2(e[0], e[1]), pack2(e[2], e[3]), pack2(e[4], e[5]), pack2(e[6], e[7])};
                    const bf16x8 pb = __builtin_bit_cast(bf16x8, pk);
#pragma unroll
                    for (int pt = 0; pt < 4; ++pt) yacc[pt] = __builtin_amdgcn_mfma_f32_16x16x32_bf16(*(const bf16x8*)(XT + (pt * 16 + fr) * PT + sb * 32 + fq * 8), pb, yacc[pt], 0, 0, 0);
                }
                bf16_t* op = YD + ((size_t)dir * M + lrl) * D + head * 64 + fq * 4;
#pragma unroll
                for (int pt = 0; pt < 4; ++pt) *(uint2*)(op + pt * 16) = make_uint2(pack2(yacc[pt][0], yacc[pt][1]), pack2(yacc[pt][2], yacc[pt][3]));
            }
#pragma unroll
            for (int pt = 0; pt < 4; ++pt) hacc[pt] *= dec_total;
#pragma unroll
            for (int k = 0; k < 4; ++k) { const bf16x8 bfr = *(const bf16x8*)(BT + (16 * w + fr) * PT + k * 32 + fq * 8);
#pragma unroll
                for (int pt = 0; pt < 4; ++pt) hacc[pt] = __builtin_amdgcn_mfma_f32_16x16x32_bf16(*(const bf16x8*)(XT + (pt * 16 + fr) * PT + k * 32 + fq * 8), bfr, hacc[pt], 0, 0, 0); }
            __syncthreads();
#pragma unroll
            for (int pt = 0; pt < 4; ++pt)
#pragma unroll
                for (int j = 0; j < 4; ++j) HL[(pt * 16 + fq * 4 + j) * PT + 16 * w + fr] = (bf16_t)f2bf(hacc[pt][j]);
        }
    }
}

__device__ void phase_vtrans(CP p, unsigned* lds) {
    unsigned char* ws = p->ws; const int tid = fresh_tid();
    const bf16_t* U = (const bf16_t*)(ws + O_U); bf16_t* VT = (bf16_t*)(ws + O_VT);
    constexpr int P = 130;
    uint4 tv[4];
    auto tile_load = [&](int tile) {
        const int cg4 = tile & 3, tt = (tile >> 2) % 36, bl = tile / 144;
        const int row0 = tt < 32 ? bl * 2048 + tt * 64 : ML + bl * 256 + (tt - 32) * 64;
#pragma unroll
        for (int i = 0; i < 4; ++i) { const int idx = i * 512 + tid, rr = idx >> 5, ck = idx & 31; tv[i] = *(const uint4*)(U + (size_t)(row0 + rr) * UC + cV + cg4 * 256 + ck * 8); }
    };
    if ((int)blockIdx.x < GB * 36 * 4) tile_load(blockIdx.x);
    for (int tile = blockIdx.x; tile < GB * 36 * 4; tile += gridDim.x) {
        const int cg4 = tile & 3, tt = (tile >> 2) % 36, bl = tile / 144;
        __syncthreads();
#pragma unroll
        for (int i = 0; i < 4; ++i) { const int idx = i * 512 + tid, rr = idx >> 5, ck = idx & 31; const uint4 v = tv[i];
            *(uint2*)(lds + rr * P + ck * 4) = make_uint2(v.x, v.y); *(uint2*)(lds + rr * P + ck * 4 + 2) = make_uint2(v.z, v.w); }
        __syncthreads();
        if (tile + (int)gridDim.x < GB * 36 * 4) tile_load(tile + gridDim.x);
        const unsigned short* l16 = (const unsigned short*)lds;
#pragma unroll
        for (int k = 0; k < 4; ++k) { const int col = (tid >> 3) + 64 * k, tg = tid & 7;
            unsigned w[4];
#pragma unroll
            for (int i = 0; i < 4; ++i) { const unsigned lo = l16[(tg * 8 + 2 * i) * (2 * P) + col], hi = l16[(tg * 8 + 2 * i + 1) * (2 * P) + col]; w[i] = lo | (hi << 16); }
            const int head = cg4 * 4 + (col >> 6), d = col & 63;
            *(uint4*)(VT + ((size_t)((bl * 16 + head) * 64 + d)) * 2304 + tt * 64 + tg * 8) = make_uint4(w[0], w[1], w[2], w[3]); }
    }
}

constexpr int ATT_KP = 72, ATT_VP = 264;
constexpr int ATT_LK = 0, ATT_LV = ATT_LK + 256 * ATT_KP * 2, ATT_LB = ATT_LV + 64 * ATT_VP * 2;
constexpr int ATT_KB = 72704;
constexpr int ATT_LDS_END = ATT_KB + 9 * 64 * 128;
__device__ __forceinline__ int att_kb_off(int key, int c) { const int f = ((key >> 1) & 1) | (((key >> 3) & 3) << 1); return key * 128 + ((c ^ f) << 4); }

template <bool MASK>
__device__ __forceinline__ void attn_chunk(const bf16x8 (&kc)[2][2][2], const bf16x8 (&vv)[2][4], const bf16x8 q0, const bf16x8 q1, f32x4 (&oacc)[4], float& mrun, float& lrun,
                                           const float* rpl, int dr0, int w0, int c, int cs, int fq) {
    f32x4 sc[2][2];
#pragma unroll
    for (int b = 0; b < 2; ++b) {
#pragma unroll
        for (int t = 0; t < 2; ++t) { f32x4 a = (f32x4){0.f, 0.f, 0.f, 0.f};
            a = __builtin_amdgcn_mfma_f32_16x16x32_bf16(kc[b][t][0], q0, a, 0, 0, 0);
            a = __builtin_amdgcn_mfma_f32_16x16x32_bf16(kc[b][t][1], q1, a, 0, 0, 0);
            sc[b][t] = a; }
        if (MASK) {
            const int dr = dr0 + b * 31;
#pragma unroll
            for (int t = 0; t < 2; ++t)
#pragma unroll
                for (int j = 0; j < 4; ++j) { const int kcol = w0 + fq * 8 + t * 4 + j; const bool ok = (unsigned)(kcol - cs) < 16u; const int dci = ok ? kcol - c + 15 : 15;
                    const float bias = rpl[dr + dci]; sc[b][t][j] = ok ? sc[b][t][j] + bias : -1e30f; }
        }
    }
    float mx = -1e30f;
#pragma unroll
    for (int b = 0; b < 2; ++b)
#pragma unroll
        for (int t = 0; t < 2; ++t)
#pragma unroll
            for (int j = 0; j < 4; ++j) mx = fmaxf(mx, sc[b][t][j]);
    mx = x16_max(mx); mx = x32_max(mx);
    const float mnew = fmaxf(mrun, mx), corr = __expf(mrun - mnew);
    lrun *= corr; mrun = mnew;
#pragma unroll
    for (int i = 0; i < 4; ++i) oacc[i] *= corr;
#pragma unroll
    for (int b = 0; b < 2; ++b) {
        float e[8];
#pragma unroll
        for (int t = 0; t < 2; ++t)
#pragma unroll
            for (int j = 0; j < 4; ++j) { e[t * 4 + j] = __expf(sc[b][t][j] - mnew); lrun += e[t * 4 + j]; }
        const u32x4_t pk = {pack2(e[0], e[1]), pack2(e[2], e[3]), pack2(e[4], e[5]), pack2(e[6], e[7])};
        const bf16x8 pb = __builtin_bit_cast(bf16x8, pk);
#pragma unroll
        for (int dt = 0; dt < 4; ++dt) oacc[dt] = __builtin_amdgcn_mfma_f32_16x16x32_bf16(vv[b][dt], pb, oacc[dt], 0, 0, 0);
    }
}

template <bool LAT>
__device__ __forceinline__ void attn_wave_item(const bf16_t* __restrict__ U, const bf16_t* __restrict__ VT, bf16_t* __restrict__ YN, const unsigned char* ldsb,
                                               int bl, int head, int r, int jq, int lane, int rb0) {
    const int fr = lane & 15, fq = lane >> 4;
    const float* rpl = (const float*)(ldsb + ATT_LB);
    int lrq0, r0 = 0, w0 = 0, c = 0, cs = 0;
    if (LAT) { lrq0 = bl * 2048 + r * 64 + jq * 16; r0 = min(max(r - 4, 0), 24); w0 = jq == 0 ? 0 : (jq == 1 ? 8 : (jq == 2 ? 24 : 32)); c = jq * 16 + fr; cs = min(max(c - 8, 0), 48); }
    else lrq0 = ML + bl * 256 + jq * 16;
    const bf16_t* qp = U + (size_t)(lrq0 + fr) * UC + cQ + head * 64 + fq * 8;
    const bf16x8 q0 = *(const bf16x8*)qp, q1 = *(const bf16x8*)(qp + 32);
    f32x4 oacc[4];
#pragma unroll
    for (int i = 0; i < 4; ++i) oacc[i] = (f32x4){0.f, 0.f, 0.f, 0.f};
    float mrun = -1e30f, lrun = 0.f;
    const int kapl = (fr >> 2) * 8 + (fr & 3);
    bf16x8 kc[2][2][2], vv[2][4];
    if (LAT) {
        const bf16_t* Vh = VT + (size_t)(bl * 16 + head) * 64 * 2304;
        unsigned vov[4];
#pragma unroll
        for (int dt = 0; dt < 4; ++dt) vov[dt] = (unsigned)((fr + 16 * dt) * 2304 + fq * 8);
        unsigned vto = (unsigned)(r0 * 64 + w0);
        const unsigned vstep = 64u;
        const unsigned char* KB = ldsb + ATT_KB;
#pragma unroll 1
        for (int ch = 0; ch < 4; ++ch) {
#pragma unroll
            for (int b = 0; b < 2; ++b)
#pragma unroll
                for (int dt = 0; dt < 4; ++dt) vv[b][dt] = *(const bf16x8*)(Vh + (vto + b * vstep + vov[dt]));
            vto += 2 * vstep;
#pragma unroll
            for (int b = 0; b < 2; ++b)
#pragma unroll
                for (int t = 0; t < 2; ++t) { const int key = (r0 - rb0 + ch * 2 + b) * 64 + w0 + kapl + 4 * t;
                    kc[b][t][0] = *(const bf16x8*)(KB + att_kb_off(key, fq)); kc[b][t][1] = *(const bf16x8*)(KB + att_kb_off(key, fq + 4)); }
            attn_chunk<true>(kc, vv, q0, q1, oacc, mrun, lrun, rpl, (r0 + ch * 2 - r + 7) * 31, w0, c, cs, fq);
        }
    }
    const bf16_t* LK = (const bf16_t*)(ldsb + ATT_LK) + kapl * ATT_KP + fq * 8;
    const bf16_t* LV = (const bf16_t*)(ldsb + ATT_LV) + fr * ATT_VP + fq * 8;
#pragma unroll 1
    for (int ch = 0; ch < 4; ++ch) {
#pragma unroll
        for (int b = 0; b < 2; ++b) {
#pragma unroll
            for (int t = 0; t < 2; ++t) { const bf16_t* kp = LK + ((ch * 2 + b) * 32 + 4 * t) * ATT_KP; kc[b][t][0] = *(const bf16x8*)kp; kc[b][t][1] = *(const bf16x8*)(kp + 32); }
#pragma unroll
            for (int dt = 0; dt < 4; ++dt) vv[b][dt] = *(const bf16x8*)(LV + dt * 16 * ATT_VP + (ch * 2 + b) * 32);
        }
        attn_chunk<false>(kc, vv, q0, q1, oacc, mrun, lrun, rpl, 0, 0, 0, 0, fq);
    }
    lrun = x16_sum(lrun); lrun = x32_sum(lrun);
    const float inv = 1.f / lrun;
    bf16_t* op = YN + (size_t)(lrq0 + fr) * D + head * 64 + fq * 4;
#pragma unroll
    for (int dt = 0; dt < 4; ++dt) *(uint2*)(op + dt * 16) = make_uint2(pack2(oacc[dt][0] * inv, oacc[dt][1] * inv), pack2(oacc[dt][2] * inv, oacc[dt][3] * inv));
}

__device__ void phase_attn(CP p, int g, int l, bool do_ctx, unsigned char* ldsb) {
    unsigned char* ws = p->ws; const int tid = fresh_tid(); const int lane = tid & 63, wid = tid >> 6;
    const bf16_t* U = (const bf16_t*)(ws + O_U); const bf16_t* VT = (const bf16_t*)(ws + O_VT); bf16_t* YN = (bf16_t*)(ws + O_YBR) + (size_t)2 * M * D;
    const int G = gridDim.x, cb = blockIdx.x;
    const int nlat = GB * 16 * 16, nctx = do_ctx ? GB * 16 * 2 : 0;
    const int perl = (nlat + G - 1) / G, perc = (nctx + G - 1) / G;
    int cur = -1;
    for (int k = 0; k < perl + perc; ++k) {
        const bool lat = k < perl;
        const int item = lat ? cb * perl + k : cb * perc + (k - perl);
        if (item >= (lat ? nlat : nctx)) continue;
        const int bh = lat ? (item >> 4) : (item >> 1);
        const int bl = bh >> 4, head = bh & 15;
        if (bh != cur) {
            cur = bh;
            __syncthreads();
#pragma unroll
            for (int i = 0; i < 4; ++i) { const int idx = i * 512 + tid;
                { const int key = idx >> 3, part = idx & 7;
                  *(uint4*)((bf16_t*)(ldsb + ATT_LK) + key * ATT_KP + part * 8) = *(const uint4*)(U + (size_t)(ML + bl * 256 + key) * UC + cK + head * 64 + part * 8); }
                { const int d = idx >> 5, part = idx & 31;
                  *(uint4*)((bf16_t*)(ldsb + ATT_LV) + d * ATT_VP + part * 8) = *(const uint4*)(VT + ((size_t)(bh * 64 + d)) * 2304 + 2048 + part * 8); } }
            if (tid < 465) ((float*)(ldsb + ATT_LB))[tid] = p->na_rpb[(size_t)(l * 16 + head) * 465 + tid];
            __syncthreads();
        }
        if (lat) {
            const int rp = item & 15, rb0 = min(max(2 * rp - 4, 0), 24);
            __syncthreads();
#pragma unroll
            for (int i = 0; i < 9; ++i) { const int idx = i * 512 + tid, key = idx >> 3, cc = idx & 7; const int brow = rb0 + (key >> 6);
                if (brow < 32) *(uint4*)(ldsb + ATT_KB + att_kb_off(key, cc)) = *(const uint4*)(U + (size_t)(bl * 2048 + brow * 64 + (key & 63)) * UC + cK + head * 64 + cc * 8); }
            __syncthreads();
            attn_wave_item<true>(U, VT, YN, ldsb, bl, head, rp * 2 + (wid >> 2), wid & 3, lane, rb0);
        }
        else attn_wave_item<false>(U, VT, (bf16_t*)(ws + O_YBRC) + ((size_t)2 * NCTX + (size_t)g * MC) * D - (size_t)ML * D, ldsb, bl, head, 0, (item & 1) * 8 + wid, lane, 0);
    }
}

__device__ void phase_ssdfin(CP p, int g, int l, int Mrows) {
    unsigned char* ws = p->ws; const int tid_ = fresh_tid(); const int lane = tid_ & 63, gw = blockIdx.x * 8 + (tid_ >> 6), nw = gridDim.x * 8;
    const bf16_t* U = (const bf16_t*)(ws + O_U); const bf16_t* XB = (const bf16_t*)(ws + O_XBCS); const bf16_t* YD = (const bf16_t*)(ws + O_YDIR);
    bf16_t* YS = (bf16_t*)(ws + O_YBR) + (size_t)M * D;
    const int head = lane >> 2; const float dsum = p->ssd_d[l * 32 + head] + p->ssd_d[l * 32 + 16 + head];
    float nwr[16];
#pragma unroll
    for (int i = 0; i < 16; ++i) nwr[i] = p->ssd_norm_w[l * D + lane * 16 + i];
    uint4 cu[2][4], nx[2][4];
    auto load_in = [&](int lr, uint4 (&d)[2][4]) {
#pragma unroll
        for (int j = 0; j < 2; ++j) { const int ch = lane * 16 + j * 8;
            d[j][0] = *(const uint4*)(YD + (size_t)lr * D + ch); d[j][1] = *(const uint4*)(YD + ((size_t)M + lr) * D + ch);
            d[j][2] = *(const uint4*)(XB + (size_t)lr * XW + ch); d[j][3] = *(const uint4*)(U + (size_t)lr * UC + cZ + ch); }
    };
    if (gw < Mrows) load_in(gw, cu);
    for (int lr = gw; lr < Mrows; lr += nw) {
        if (lr + nw < Mrows) load_in(lr + nw, nx);
        float v[16]; float ss = 0.f;
#pragma unroll
        for (int j = 0; j < 2; ++j) {
            float y0[8], y1[8], xs[8], z[8];
            unpack8(cu[j][0], y0); unpack8(cu[j][1], y1); unpack8(cu[j][2], xs); unpack8(cu[j][3], z);
#pragma unroll
            for (int i = 0; i < 8; ++i) { const float t = (y0[i] + y1[i] + xs[i] * dsum) * silu_f(z[i]); v[j * 8 + i] = t; ss += t * t; } }
        ss = row16_sum(ss); ss = x16_sum(ss);
        const float rs = rsqrtf(ss * (1.f / 512.f) + EPS);
#pragma unroll
        for (int j = 0; j < 2; ++j) { const int ch = lane * 16 + j * 8; float o8[8];
#pragma unroll
            for (int i = 0; i < 8; ++i) o8[i] = v[j * 8 + i] * rs * nwr[j * 8 + i];
            bf16_t* yo = lr >= ML ? (bf16_t*)(ws + O_YBRC) + ((size_t)NCTX + (size_t)g * MC + (lr - ML)) * D : YS + (size_t)lr * D;
            *(uint4*)(yo + ch) = pack8(o8); }
        if (lr >= ML) {
            const bf16_t* gs_ = U + (size_t)lr * UC + cGATE; bf16_t* gd = (bf16_t*)(ws + O_GATEC) + ((size_t)g * MC + (lr - ML)) * 3072;
#pragma unroll
            for (int j = 0; j < 6; ++j) *(uint4*)(gd + (j * 64 + lane) * 8) = *(const uint4*)(gs_ + (j * 64 + lane) * 8);
        }
#pragma unroll
        for (int j = 0; j < 2; ++j)
#pragma unroll
            for (int k = 0; k < 4; ++k) cu[j][k] = nx[j][k];
    }
}

__device__ void phase_final(CP p, int g) {
    const int tid_ = fresh_tid(); const int lane = tid_ & 63, gw = blockIdx.x * 8 + (tid_ >> 6), nw = gridDim.x * 8;
    float4 wv[4], v[4], nx[4];
#pragma unroll
    for (int j = 0; j < 4; ++j) wv[j] = *(const float4*)(p->final_norm_w + j * 256 + lane * 4);
    float* base = p->out + (size_t)g * ML * D;
    if (gw < ML) {
#pragma unroll
        for (int j = 0; j < 4; ++j) v[j] = *(const float4*)(base + (size_t)gw * D + j * 256 + lane * 4); }
    for (int lr = gw; lr < ML; lr += nw) {
        float* hrow = base + (size_t)lr * D;
        if (lr + nw < ML) {
#pragma unroll
            for (int j = 0; j < 4; ++j) nx[j] = *(const float4*)(hrow + (size_t)nw * D + j * 256 + lane * 4); }
        float ss = 0.f;
#pragma unroll
        for (int j = 0; j < 4; ++j) ss += v[j].x * v[j].x + v[j].y * v[j].y + v[j].z * v[j].z + v[j].w * v[j].w;
        ss = wave_sum(ss);
        const float rs = rsqrtf(ss * (1.f / 1024.f) + EPS);
#pragma unroll
        for (int j = 0; j < 4; ++j) { const int col = j * 256 + lane * 4; const float4 w = wv[j];
            *(float4*)(hrow + col) = make_float4(v[j].x * rs * w.x, v[j].y * rs * w.y, v[j].z * rs * w.z, v[j].w * rs * w.w); }
#pragma unroll
        for (int j = 0; j < 4; ++j) v[j] = nx[j];
    }
}

#define XB_TMO      128
#define XB_XCNT(j)  (256  + 64 * (j))
#define XB_XSUB(j)  (1280 + 64 * (j))
#define XB_XGEN(j)  (2304 + 64 * (j))
#define XB_TOP      3328
#define XB_TOPGEN   3392
#define XCD_BAR_WORDS 3456
#define XB_SPIN_CAP (1u << 20)
__device__ __forceinline__ unsigned xb_ld(unsigned* p)              { return __hip_atomic_load(p, __ATOMIC_RELAXED, __HIP_MEMORY_SCOPE_AGENT); }
__device__ __forceinline__ unsigned xb_add(unsigned* p, unsigned v) { return __hip_atomic_fetch_add(p, v, __ATOMIC_RELAXED, __HIP_MEMORY_SCOPE_AGENT); }
__device__ __forceinline__ unsigned xb_xcc_id() { return (unsigned)__builtin_amdgcn_s_getreg((3 << 11) | 20) & 0xFu; }
#define XB_SPIN(cond, bar) do { unsigned _sp = 0; while (cond) { __builtin_amdgcn_s_sleep(1); \
    if ((++_sp & 255u) == 0u) { if (xb_ld(&(bar)[XB_TMO])) break; if (_sp > XB_SPIN_CAP) { atomicAdd(&(bar)[XB_TMO], 1u); break; } } } } while (0)
struct XcdBarrier { unsigned* bar; unsigned x; volatile LAS unsigned* st; };
__device__ __forceinline__ XcdBarrier xcd_barrier_post(unsigned* bar, volatile LAS unsigned* st) {
    XcdBarrier b; b.bar = bar; b.x = xb_xcc_id(); b.st = st;
    if (threadIdx.x == 0) (void)xb_add(&bar[XB_XCNT(b.x)], 1u);
    return b;
}
__device__ __forceinline__ void xcd_barrier_complete(unsigned* bar, unsigned x, unsigned& nloc, unsigned& nx) {
    const unsigned G = gridDim.x * gridDim.y * gridDim.z;
    unsigned sum, cnt, mine, sp = 0u;
    for (;;) {
        sum = 0u; cnt = 0u; mine = 0u;
#pragma unroll
        for (unsigned j = 0; j < 16; ++j) { const unsigned c = xb_ld(&bar[XB_XCNT(j)]); sum += c; cnt += (c > 0u) ? 1u : 0u; mine = (j == x) ? c : mine; }
        if (sum == G) break;
        __builtin_amdgcn_s_sleep(1);
        if ((++sp & 255u) == 0u) { if (xb_ld(&bar[XB_TMO])) break; if (sp > XB_SPIN_CAP) { atomicAdd(&bar[XB_TMO], 1u); break; } }
    }
    nloc = mine > 0u ? mine : 1u; nx = cnt > 0u ? cnt : 1u;
}
__device__ __forceinline__ void xcd_barrier(const XcdBarrier& b) {
    asm volatile("s_waitcnt vmcnt(0)" ::: "memory");
    __syncthreads();
    if (threadIdx.x == 0) {
        unsigned* bar = b.bar;
        __builtin_amdgcn_s_waitcnt(0);
        unsigned nloc = b.st[0], nx = b.st[1];
        if (nloc == 0u) { xcd_barrier_complete(bar, b.x, nloc, nx); b.st[0] = nloc; b.st[1] = nx; }
        const unsigned old = xb_add(&bar[XB_XSUB(b.x)], 1u);
        const unsigned gen = old / nloc;
        if (old + 1u == (gen + 1u) * nloc) {
            __builtin_amdgcn_fence(__ATOMIC_RELEASE, "agent");
            asm volatile("s_waitcnt vmcnt(0)" ::: "memory");
            const unsigned og = xb_add(&bar[XB_TOP], 1u);
            const unsigned tg = og / nx;
            if (og + 1u == (tg + 1u) * nx) xb_add(&bar[XB_TOPGEN], 1u);
            else XB_SPIN(xb_ld(&bar[XB_TOPGEN]) == tg, bar);
            __builtin_amdgcn_fence(__ATOMIC_ACQUIRE, "agent");
            xb_add(&bar[XB_XGEN(b.x)], 1u);
            asm volatile("s_waitcnt vmcnt(0)" ::: "memory");
        } else {
            XB_SPIN(xb_ld(&bar[XB_XGEN(b.x)]) == gen, bar);
            __builtin_amdgcn_fence(__ATOMIC_ACQUIRE, "agent");
            asm volatile("s_waitcnt vmcnt(0)" ::: "memory");
        }
    }
    __syncthreads();
}
#define GSYNC() do { XcdBarrier xb_; xb_.bar = (unsigned*)(params_ptr()->ws + O_BAR); xb_.x = xb_xcc_id(); xb_.st = (volatile LAS unsigned*)&xb_words; xcd_barrier(xb_); if (PROBE_DUP == 20) xcd_barrier(xb_); } while (0)
__global__ void __launch_bounds__(512, 2) fwd_megakernel(Params p_unused) {
    extern __shared__ __attribute__((aligned(16))) unsigned char shm[];
    cg::grid_group grid = cg::this_grid();
    float* ldsf = (float*)shm; LAS unsigned char* ldsg = (LAS unsigned char*)shm;
    __shared__ uint4 xb_words;
    if (threadIdx.x == 0) xb_words = make_uint4(0u, 0u, 0u, 0u);
    __syncthreads();
    (void)xcd_barrier_post((unsigned*)(params_ptr()->ws + O_BAR), (volatile LAS unsigned*)&xb_words);
    DUP(1, phase_prep(params_ptr(), ldsf););
    grid.sync();
    for (int l = 0; l < 2; ++l) {
        const bool last = (l == 1);
        for (int g = 0; g < NG + (last ? 0 : 1); ++g) {
            const bool cchain = (g == NG);
            if (!cchain) {
                if (g == 0) {
                    DUP(2, phase_norm(params_ptr(), g, l, 0, M, false););
                    GSYNC();
                }
                DUP(3, { CP p = params_ptr(); unsigned char* ws = p->ws; const int G = gridDim.x, cb = blockIdx.x;
                  pg8::Gemm gm{(const bf16_t*)(ws + O_AN), (const bf16_t*)(ws + O_WIN + l * SZ_WIN), M, UC, D, 0, 0};
                  pg8::StaticOrder S; S.init(M, UC, G, cb, 1); EpiU E{(bf16_t*)(ws + O_U)}; pg8::gemm_phase(ldsg, gm, S, E); });
                GSYNC();
                DUP(12, phase_mixprep(params_ptr(), g, l, last, rep_ == 0););
                DUP(4, phase_vtrans(params_ptr(), (unsigned*)shm););
                GSYNC();
                DUP(5, phase_scan(params_ptr(), !last, shm););
                DUP(6, phase_attn(params_ptr(), g, l, !last, shm););
                GSYNC();
                DUP(7, phase_ssdfin(params_ptr(), g, l, last ? ML : M););
                GSYNC();
            }
            const int Mr = cchain ? NCTX : ML;
            DUP(8, { CP p = params_ptr(); unsigned char* ws = p->ws; const int G = gridDim.x, cb = blockIdx.x;
              pg8::Gemm gm{(const bf16_t*)(ws + (cchain ? O_YBRC : O_YBR)), (const bf16_t*)(ws + O_WBR + l * SZ_WBR), Mr, D, D, (size_t)(cchain ? NCTX : M) * D * 2, (size_t)D * D * 2};
              pg8::StaticOrder S; S.init(Mr, D, G, cb, 3);
              EpiMerge E{cchain ? (const bf16_t*)(ws + O_GATEC) : (const bf16_t*)(ws + O_U) + cGATE, cchain ? 3072 : UC, (bf16_t*)(ws + O_MRGB)}; pg8::gemm_phase(ldsg, gm, S, E); });
            GSYNC();
            DUP(9, { CP p = params_ptr(); unsigned char* ws = p->ws; const int G = gridDim.x, cb = blockIdx.x;
              const float* modl = (const float*)(ws + O_MOD) + (size_t)l * 33 * 6144;
              float* hl = p->out + (size_t)g * ML * D; float* hc = (float*)(ws + O_HC) + (cchain ? (size_t)0 : (size_t)g * MC * D);
              pg8::Gemm gm{(const bf16_t*)(ws + O_MRGB), (const bf16_t*)(ws + O_WOUT + l * SZ_WOUT), Mr, D, D, 0, 0};
              pg8::StaticOrder S; S.init(Mr, D, G, cb, 1); EpiRes E{hl, hc, modl + 2048, g, rep_ == 0 ? 1.f : 0.f, cchain ? 1 : 0, (l == 0 && rep_ == 0) ? (cchain ? (long)(p->ctx - hc) : (long)((p->x + (size_t)g * ML * D) - hl)) : 0L}; pg8::gemm_phase(ldsg, gm, S, E); });
            GSYNC();
            DUP(10, phase_norm(params_ptr(), g, l, 1, Mr, cchain););
            GSYNC();
            DUP(11, { CP p = params_ptr(); unsigned char* ws = p->ws; const int G = gridDim.x, cb = blockIdx.x;
              pg8::Gemm gm{(const bf16_t*)(ws + O_AN), (const bf16_t*)(ws + O_WFF1 + l * SZ_WFF), Mr, 4096, D, 0, 0};
              pg8::StaticOrder S; S.init(Mr, 4096, G, cb, 1); EpiFF1 E{(bf16_t*)(ws + O_U)}; pg8::gemm_phase(ldsg, gm, S, E); });
            GSYNC();
            DUP(13, { CP p = params_ptr(); unsigned char* ws = p->ws; const int G = gridDim.x, cb = blockIdx.x;
              const float* modl = (const float*)(ws + O_MOD) + (size_t)l * 33 * 6144;
              float* hl = p->out + (size_t)g * ML * D; float* hc = (float*)(ws + O_HC) + (cchain ? (size_t)0 : (size_t)g * MC * D);
              pg8::Gemm gm{(const bf16_t*)(ws + O_U), (const bf16_t*)(ws + O_WFF2 + l * SZ_WFF), Mr, D, 4096, 0, 0};
              pg8::StaticOrder S; S.init(Mr, D, G, cb, 1); EpiRes E{hl, hc, modl + 5120, g, rep_ == 0 ? 1.f : 0.f, cchain ? 1 : 0, 0L}; pg8::gemm_phase(ldsg, gm, S, E); });
            if (g + 1 < NG) phase_norm(params_ptr(), g + 1, l, 0, M, false);
            GSYNC();
        }
    }
    for (int g = 0; g < NG; ++g) phase_final(params_ptr(), g);
}

extern "C" void kernel_launch(void* const* d_in, const int* in_sizes, int n_in, void* d_out, int out_size, void* d_ws, size_t ws_size, hipStream_t stream) {
    constexpr size_t kDynLds = 155648;
    static_assert(ATT_LDS_END <= 155648, "attention LDS image too large");
    static int grid_blocks = 0;
    if (grid_blocks == 0) {
        if (n_in != 24 || ws_size < WS_END) { fprintf(stderr, "kernel_launch: need 24 inputs and %zu bytes of workspace, got %d / %zu\n", (size_t)WS_END, n_in, ws_size); grid_blocks = -1; return; }
        int dev = 0, cus = 0, per_cu = 0;
        (void)hipGetDevice(&dev);
        (void)hipDeviceGetAttribute(&cus, hipDeviceAttributeMultiprocessorCount, dev);
        (void)hipFuncSetAttribute((const void*)fwd_megakernel, hipFuncAttributeMaxDynamicSharedMemorySize, (int)kDynLds);
        (void)hipOccupancyMaxActiveBlocksPerMultiprocessor(&per_cu, (const void*)fwd_megakernel, 512, kDynLds);
        if (per_cu < 1) per_cu = 1;
        grid_blocks = cus * per_cu;
        (void)hipGetLastError();
    }
    if (grid_blocks < 0) return;
    Params p{};
    const float** pp = (const float**)&p;
    for (int i = 0; i < 24; ++i) pp[i] = (const float*)d_in[i];
    p.out = (float*)d_out; p.ws = (unsigned char*)d_ws;
    (void)hipMemsetAsync((unsigned char*)d_ws + O_BAR, 0, 16384, stream);
    void* args[] = {&p};
    hipError_t e = hipLaunchCooperativeKernel((void*)fwd_megakernel, dim3(grid_blocks), dim3(512), args, kDynLds, stream);
    if (e != hipSuccess) fprintf(stderr, "cooperative launch failed: %s (grid %d)\n", hipGetErrorString(e), grid_blocks);
}
```
